# Optimizing an MI355X kernel written in HIP

```python
import jax, jax.numpy as jnp
from jax import lax
import numpy as np

D_MODEL = 1024
BATCH = 16
SEQ = 4096
DEPTH = 4
DEC_BATCH = 32
DEC_SEQ = 16
PAST_LEN = 4096

CHUNK = 64
N_MEM = 256
EPS = 1e-6
GDN_HEADS = 4
GDN_DK = 128
GDN_DV = 128
GDN_CONV = 4
GDN_QK = GDN_HEADS * GDN_DK
GDN_V = GDN_HEADS * GDN_DV
GDN_CONV_DIM = 2 * GDN_QK + GDN_V
SC_DIM = 256
SC_GROUPS = 4
SC_CONV = 3
SB_HEADS = 4
SB_DH = 64
SB_W = SB_HEADS * SB_DH
SB_BLOCK = 128
D_MIX = GDN_V + SC_DIM + SB_W
IN_SIZES = (GDN_QK, GDN_QK, GDN_V, GDN_V, GDN_HEADS, GDN_HEADS,
            SC_DIM, SC_DIM, SC_DIM, SB_W, SB_W, SB_W)
D_IN = 2 * GDN_QK + 2 * GDN_V + 2 * GDN_HEADS + 3 * SC_DIM + 3 * SB_W
MEM_HEADS = 4
MEM_DH = 128
MEM_W = MEM_HEADS * MEM_DH
D_FF = 2816
FFN_CONV = 3

kernel_name = "hybrid_streaming_encoder_step"

F32 = jnp.float32


def rmsnorm(x, g):
    xf = x.astype(F32)
    y = xf * lax.rsqrt(jnp.mean(xf * xf, axis=-1, keepdims=True) + EPS)
    return (y * g.astype(F32)).astype(x.dtype)


def group_rmsnorm(y, n_groups, g):
    B, T, C = y.shape
    yf = y.astype(F32).reshape(B, T, n_groups, C // n_groups)
    yf = yf * lax.rsqrt(jnp.mean(yf * yf, axis=-1, keepdims=True) + EPS)
    return yf.reshape(B, T, C) * g.astype(F32)


def l2norm(x):
    return x * lax.rsqrt(jnp.sum(x * x, axis=-1, keepdims=True) + EPS)


def causal_dwconv(x, buf, w):
    W = w.shape[0]
    T = x.shape[1]
    xp = jnp.concatenate([buf.astype(x.dtype), x], axis=1)
    y = xp[:, 0:T] * w[0]
    for i in range(1, W):
        y = y + xp[:, i:i + T] * w[i]
    return y, xp[:, T:]


def split_cols(p):
    out, start = [], 0
    for s in IN_SIZES:
        out.append(p[..., start:start + s])
        start += s
    return out


def to_heads(a, d):
    B, T, _ = a.shape
    return a.reshape(B, T, -1, d).transpose(0, 2, 1, 3)


def gdn_chunk(S, q, k, v, g, beta):
    T = q.shape[2]
    gc = jnp.cumsum(g, axis=-1)
    idx = jnp.arange(T)
    causal = idx[:, None] >= idx[None, :]
    strict = idx[:, None] > idx[None, :]
    diff = gc[..., :, None] - gc[..., None, :]
    decay = jnp.exp(jnp.where(causal, diff, -jnp.inf))
    kk = jnp.einsum('bhtd,bhsd->bhts', k, k)
    L = jnp.where(strict, beta[..., None] * kk * decay, 0.0)
    A = L + jnp.eye(T, dtype=L.dtype)
    rhs = jnp.concatenate([v * beta[..., None],
                           k * (beta * jnp.exp(gc))[..., None]], axis=-1)
    sol = lax.linalg.triangular_solve(A, rhs, left_side=True, lower=True,
                                      unit_diagonal=True)
    u, w = sol[..., :GDN_DV], sol[..., GDN_DV:]
    v_new = u - jnp.einsum('bhtk,bhkv->bhtv', w, S)
    qk = jnp.einsum('bhtd,bhsd->bhts', q, k) * decay
    o = (jnp.einsum('bhtk,bhkv->bhtv', q * jnp.exp(gc)[..., None], S)
         + jnp.einsum('bhts,bhsv->bhtv', qk, v_new))
    g_last = gc[..., -1]
    S_new = (S * jnp.exp(g_last)[..., None, None]
             + jnp.einsum('bhtk,bhtv->bhkv',
                          k * jnp.exp(g_last[..., None] - gc)[..., None], v_new))
    return S_new, o


def gdn_prompt(q, k, v, g, beta):
    B, H, T, _ = q.shape
    nc = T // CHUNK

    def split(a):
        return jnp.moveaxis(a.reshape(a.shape[:2] + (nc, CHUNK) + a.shape[3:]), 2, 0)

    S0 = jnp.zeros((B, H, GDN_DK, GDN_DV), F32)
    S, o = lax.scan(lambda S, xs: gdn_chunk(S, *xs), S0,
                    (split(q), split(k), split(v), split(g), split(beta)))
    o = jnp.moveaxis(o, 0, 2).reshape(B, H, T, GDN_DV)
    return o, S


def stick_breaking(q, k, v, q_pos, k_pos):
    z = jnp.einsum('bhtd,bhsd->bhts', q.astype(F32), k.astype(F32)) * (SB_DH ** -0.5)
    strict = k_pos[None, :] < q_pos[:, None]
    log_1mb = jnp.where(strict, jax.nn.log_sigmoid(-z), 0.0)
    rc = lax.cumsum(log_1mb, axis=3, reverse=True) - log_1mb
    logA = jnp.where(strict, jax.nn.log_sigmoid(z) + rc, -jnp.inf)
    return jnp.einsum('bhts,bhsd->bhtd', jnp.exp(logA), v.astype(F32))


def sb_prompt(q, k, v):
    B, H, T, D = q.shape
    nb = T // SB_BLOCK
    qb = jnp.moveaxis(q.reshape(B, H, nb, SB_BLOCK, D), 2, 0)
    pos_b = jnp.arange(T, dtype=jnp.int32).reshape(nb, SB_BLOCK)
    k_pos = jnp.arange(T, dtype=jnp.int32)
    o = lax.map(lambda xs: stick_breaking(xs[0], k, v, xs[1], k_pos), (qb, pos_b))
    return jnp.moveaxis(o, 0, 2).reshape(B, H, T, D)


def memory_kv(mem, mem_in_norm_g, w_mk, w_mv, mk_norm_g):
    B, N, _ = mem.shape
    m = rmsnorm(mem, mem_in_norm_g)
    k = rmsnorm((m @ w_mk).reshape(B, N, MEM_HEADS, MEM_DH), mk_norm_g)
    v = (m @ w_mv).reshape(B, N, MEM_HEADS, MEM_DH)
    return k, v


def hybrid_layer(x, mem_k, mem_v, gdn_S, gdn_buf, sc_buf, sb_past_k, sb_past_v, ffn_buf, lw):
    (norm_mix_g, w_in, gdn_conv_w, gdn_A_log, gdn_dt_bias, gdn_norm_g,
     sc_conv_w, sc_norm_g, sb_norm_g, w_mix_out,
     norm_mem_g, w_mq, mq_norm_g, w_mo,
     norm_ffn_g, w_gate, w_up, ffn_conv_w, w_down) = lw
    B, T, _ = x.shape
    dt = x.dtype

    h = rmsnorm(x, norm_mix_g)
    gq, gk, gv, gz, gb, ga, sB, sC, sx, cq, ck, cv = split_cols(h @ w_in)

    qkv, gdn_buf_new = causal_dwconv(jnp.concatenate([gq, gk, gv], axis=-1), gdn_buf, gdn_conv_w)
    qkv = jax.nn.silu(qkv.astype(F32))
    q = l2norm(to_heads(qkv[..., :GDN_QK], GDN_DK)) * (GDN_DK ** -0.5)
    k = l2norm(to_heads(qkv[..., GDN_QK:2 * GDN_QK], GDN_DK))
    v = to_heads(qkv[..., 2 * GDN_QK:], GDN_DV)
    beta = jax.nn.sigmoid(gb.astype(F32)).transpose(0, 2, 1)
    g = (-jnp.exp(gdn_A_log.astype(F32))
         * jax.nn.softplus(ga.astype(F32) + gdn_dt_bias.astype(F32))).transpose(0, 2, 1)
    if gdn_S is None:
        o_a, S_new = gdn_prompt(q, k, v, g, beta)
    else:
        S_new, o_a = gdn_chunk(gdn_S.astype(F32), q, k, v, g, beta)
    o_a = o_a.transpose(0, 2, 1, 3)
    zh = gz.reshape(B, T, GDN_HEADS, GDN_DV).astype(F32)
    y_a = (rmsnorm(o_a, gdn_norm_g) * jax.nn.silu(zh)).reshape(B, T, GDN_V).astype(dt)

    u, sc_buf_new = causal_dwconv(sC * sx, sc_buf, sc_conv_w)
    y_b = group_rmsnorm(sB * u, SC_GROUPS, sc_norm_g).astype(dt)

    qc, kc, vc = to_heads(cq, SB_DH), to_heads(ck, SB_DH), to_heads(cv, SB_DH)
    if sb_past_k is None:
        o_c = sb_prompt(qc, kc, vc)
    else:
        P = sb_past_k.shape[1]
        k_all = jnp.concatenate([sb_past_k.astype(dt).transpose(0, 2, 1, 3), kc], axis=2)
        v_all = jnp.concatenate([sb_past_v.astype(dt).transpose(0, 2, 1, 3), vc], axis=2)
        q_pos = P + jnp.arange(T, dtype=jnp.int32)
        k_pos = jnp.arange(P + T, dtype=jnp.int32)
        o_c = stick_breaking(qc, k_all, v_all, q_pos, k_pos)
    y_c = group_rmsnorm(o_c.transpose(0, 2, 1, 3).reshape(B, T, SB_W), SB_HEADS, sb_norm_g).astype(dt)
    sb_k_new = ck.reshape(B, T, SB_HEADS, SB_DH)
    sb_v_new = cv.reshape(B, T, SB_HEADS, SB_DH)

    x = x + jnp.concatenate([y_a, y_b, y_c], axis=-1) @ w_mix_out

    h = rmsnorm(x, norm_mem_g)
    qm = rmsnorm((h @ w_mq).reshape(B, T, MEM_HEADS, MEM_DH), mq_norm_g)
    s = jnp.einsum('bthd,bnhd->bhtn', qm.astype(F32), mem_k.astype(F32)) * (MEM_DH ** -0.5)
    p = jax.nn.softmax(s, axis=-1)
    om = jnp.einsum('bhtn,bnhd->bthd', p, mem_v.astype(F32)).reshape(B, T, MEM_W).astype(dt)
    x = x + om @ w_mo

    h = rmsnorm(x, norm_ffn_g)
    gt, ffn_buf_new = causal_dwconv(h @ w_gate, ffn_buf, ffn_conv_w)
    x = x + (jax.nn.silu(gt) * (h @ w_up)) @ w_down

    return x, S_new, gdn_buf_new, sc_buf_new, sb_k_new, sb_v_new, ffn_buf_new


def setup_inputs(seed: int = 0) -> dict:
    key = jax.random.key(seed)
    ks = iter(jax.random.split(key, 48))

    def nrm(shape, scale=1.0):
        return jax.random.normal(next(ks), shape, F32) * scale

    def gain(shape):
        return 1.0 + 0.02 * jax.random.normal(next(ks), shape, F32)

    dt_init = jax.random.uniform(next(ks), (DEPTH, GDN_HEADS), F32, 0.001, 0.1)
    return {
        "x_prompt": nrm((BATCH, SEQ, D_MODEL)),
        "x_sample": nrm((DEC_BATCH, DEC_SEQ, D_MODEL)),
        "mem_prompt": nrm((BATCH, N_MEM, D_MODEL)),
        "state_gdn": nrm((DEPTH, DEC_BATCH, GDN_HEADS, GDN_DK, GDN_DV), 0.05),
        "cache_gdn_conv": nrm((DEPTH, DEC_BATCH, GDN_CONV - 1, GDN_CONV_DIM)),
        "cache_sc_conv": nrm((DEPTH, DEC_BATCH, SC_CONV - 1, SC_DIM)),
        "cache_sb_k": nrm((DEPTH, DEC_BATCH, PAST_LEN, SB_HEADS, SB_DH)),
        "cache_sb_v": nrm((DEPTH, DEC_BATCH, PAST_LEN, SB_HEADS, SB_DH)),
        "cache_mem_k": nrm((DEPTH, DEC_BATCH, N_MEM, MEM_HEADS, MEM_DH)),
        "cache_mem_v": nrm((DEPTH, DEC_BATCH, N_MEM, MEM_HEADS, MEM_DH)),
        "cache_ffn_conv": nrm((DEPTH, DEC_BATCH, FFN_CONV - 1, D_FF)),
        "norm_mix_g": gain((DEPTH, D_MODEL)),
        "w_in": nrm((DEPTH, D_MODEL, D_IN), D_MODEL ** -0.5),
        "gdn_conv_w": nrm((DEPTH, GDN_CONV, GDN_CONV_DIM), GDN_CONV ** -0.5),
        "gdn_A_log": jnp.log(jax.random.uniform(next(ks), (DEPTH, GDN_HEADS), F32, 1.0, 16.0)),
        "gdn_dt_bias": jnp.log(jnp.expm1(dt_init)),
        "gdn_norm_g": gain((DEPTH, GDN_DV)),
        "sc_conv_w": nrm((DEPTH, SC_CONV, SC_DIM), SC_CONV ** -0.5),
        "sc_norm_g": gain((DEPTH, SC_DIM)),
        "sb_norm_g": gain((DEPTH, SB_W)),
        "w_mix_out": nrm((DEPTH, D_MIX, D_MODEL), 0.5 * D_MIX ** -0.5),
        "norm_mem_g": gain((DEPTH, D_MODEL)),
        "mem_in_norm_g": gain((DEPTH, D_MODEL)),
        "w_mq": nrm((DEPTH, D_MODEL, MEM_W), D_MODEL ** -0.5),
        "w_mk": nrm((DEPTH, D_MODEL, MEM_W), D_MODEL ** -0.5),
        "w_mv": nrm((DEPTH, D_MODEL, MEM_W), D_MODEL ** -0.5),
        "mq_norm_g": gain((DEPTH, MEM_DH)),
        "mk_norm_g": gain((DEPTH, MEM_DH)),
        "w_mo": nrm((DEPTH, MEM_W, D_MODEL), 0.5 * MEM_W ** -0.5),
        "norm_ffn_g": gain((DEPTH, D_MODEL)),
        "w_gate": nrm((DEPTH, D_MODEL, D_FF), D_MODEL ** -0.5),
        "w_up": nrm((DEPTH, D_MODEL, D_FF), D_MODEL ** -0.5),
        "ffn_conv_w": nrm((DEPTH, FFN_CONV, D_FF), FFN_CONV ** -0.5),
        "w_down": nrm((DEPTH, D_FF, D_MODEL), 0.5 * D_FF ** -0.5),
    }


def reference(x_prompt, x_sample, mem_prompt, state_gdn, cache_gdn_conv, cache_sc_conv,
              cache_sb_k, cache_sb_v, cache_mem_k, cache_mem_v, cache_ffn_conv,
              norm_mix_g, w_in, gdn_conv_w, gdn_A_log, gdn_dt_bias, gdn_norm_g,
              sc_conv_w, sc_norm_g, sb_norm_g, w_mix_out,
              norm_mem_g, mem_in_norm_g, w_mq, w_mk, w_mv, mq_norm_g, mk_norm_g, w_mo,
              norm_ffn_g, w_gate, w_up, ffn_conv_w, w_down):
    xp, xs = x_prompt, x_sample
    Bp = xp.shape[0]
    P_S, P_GC, P_SC, P_K, P_V, P_MK, P_MV, P_FC = [], [], [], [], [], [], [], []
    S_S, S_GC, S_SC, S_K, S_V, S_FC = [], [], [], [], [], []
    for l in range(DEPTH):
        lw = (norm_mix_g[l], w_in[l], gdn_conv_w[l], gdn_A_log[l], gdn_dt_bias[l], gdn_norm_g[l],
              sc_conv_w[l], sc_norm_g[l], sb_norm_g[l], w_mix_out[l],
              norm_mem_g[l], w_mq[l], mq_norm_g[l], w_mo[l],
              norm_ffn_g[l], w_gate[l], w_up[l], ffn_conv_w[l], w_down[l])
        mk, mv = memory_kv(mem_prompt, mem_in_norm_g[l], w_mk[l], w_mv[l], mk_norm_g[l])
        xp, S_n, gc_n, sc_n, k_n, v_n, fc_n = hybrid_layer(
            xp, mk, mv, None,
            jnp.zeros((Bp, GDN_CONV - 1, GDN_CONV_DIM), xp.dtype),
            jnp.zeros((Bp, SC_CONV - 1, SC_DIM), xp.dtype),
            None, None,
            jnp.zeros((Bp, FFN_CONV - 1, D_FF), xp.dtype), lw)
        P_S.append(S_n); P_GC.append(gc_n); P_SC.append(sc_n); P_K.append(k_n)
        P_V.append(v_n); P_MK.append(mk); P_MV.append(mv); P_FC.append(fc_n)
        xs, S_n, gc_n, sc_n, k_n, v_n, fc_n = hybrid_layer(
            xs, cache_mem_k[l], cache_mem_v[l], state_gdn[l], cache_gdn_conv[l],
            cache_sc_conv[l], cache_sb_k[l], cache_sb_v[l], cache_ffn_conv[l], lw)
        S_S.append(S_n); S_GC.append(gc_n); S_SC.append(sc_n)
        S_K.append(k_n); S_V.append(v_n); S_FC.append(fc_n)
    return (xp, xs,
            jnp.stack(P_S), jnp.stack(P_GC), jnp.stack(P_SC), jnp.stack(P_K), jnp.stack(P_V),
            jnp.stack(P_MK), jnp.stack(P_MV), jnp.stack(P_FC),
            jnp.stack(S_S), jnp.stack(S_GC), jnp.stack(S_SC), jnp.stack(S_K), jnp.stack(S_V),
            jnp.stack(S_FC))
```

```cpp
#include <hip/hip_runtime.h>
#include <cstdio>
#include <cstdint>

#define DI __device__ __forceinline__
#define GAS __attribute__((address_space(1)))
#define LAS __attribute__((address_space(3)))

typedef unsigned short bf16_t;
typedef short bf16x8 __attribute__((ext_vector_type(8)));
typedef short bf16x4 __attribute__((ext_vector_type(4)));
typedef float f32x4 __attribute__((ext_vector_type(4)));
typedef float f32x2 __attribute__((ext_vector_type(2)));
typedef float f32x16 __attribute__((ext_vector_type(16)));
typedef unsigned u32x4 __attribute__((ext_vector_type(4)));
typedef unsigned u32x2 __attribute__((ext_vector_type(2)));
typedef __bf16 bf16x2_t __attribute__((ext_vector_type(2)));

constexpr int DM = 1024, BP = 16, TP = 4096, NL = 4, BS = 32, TS = 16, PAST = 4096, NMEM = 256;
constexpr int MP = BP * TP, MS = BS * TS, MALL = MP + MS;
constexpr int NZ = 3584;
constexpr int ZQ = 0, ZK = 512, ZV = 1024, ZG = 1536, ZSB = 2048, ZSC = 2304, ZSX = 2560, ZCQ = 2816, ZCK = 3072, ZCV = 3328;
constexpr int DFF = 2816, NGU = 2 * DFF;
constexpr int DIN = 3592;
constexpr float EPS = 1e-6f;
constexpr int NCH = BP * 64 * 4 + BS * 4;
constexpr int PCH = 36864;
constexpr int PW = 0, PQE = 8192, PUT = 16384, PKDT = 24576, PQK = 32768;

constexpr size_t O_YP = 0, O_YS = O_YP + (size_t)MP * DM, O_PGS = O_YS + (size_t)MS * DM, O_PGC = O_PGS + (size_t)NL * BP * 4 * 128 * 128,
    O_PSC = O_PGC + (size_t)NL * BP * 3 * 1536, O_PSK = O_PSC + (size_t)NL * BP * 2 * 256, O_PSV = O_PSK + (size_t)NL * MP * 256, O_PMK = O_PSV + (size_t)NL * MP * 256,
    O_PMV = O_PMK + (size_t)NL * BP * NMEM * 512, O_PFC = O_PMV + (size_t)NL * BP * NMEM * 512, O_SGS = O_PFC + (size_t)NL * BP * 2 * DFF,
    O_SGC = O_SGS + (size_t)NL * BS * 4 * 128 * 128, O_SSC = O_SGC + (size_t)NL * BS * 3 * 1536, O_SSK = O_SSC + (size_t)NL * BS * 2 * 256,
    O_SSV = O_SSK + (size_t)NL * MS * 256, O_SFC = O_SSV + (size_t)NL * MS * 256, O_END = O_SFC + (size_t)NL * BS * 2 * DFF;
static_assert(O_END == 234323968ull, "output size");

constexpr size_t al256(size_t x) { return (x + 255) & ~(size_t)255; }
constexpr size_t WS_CTL = 0, CTL_BYTES = 1u << 20;
constexpr size_t SZ_WIN = (size_t)NZ * DM * 2, SZ_WG8 = 16 * DM * 2, SZ_WMIX = (size_t)DM * DM * 2, SZ_WMQ = 512 * DM * 2, SZ_WMO = (size_t)DM * 512 * 2,
    SZ_WGU = (size_t)NGU * DM * 2, SZ_WDN = (size_t)DM * DFF * 2;
constexpr size_t WS_WIN = WS_CTL + CTL_BYTES, WS_WG8 = WS_WIN + NL * SZ_WIN, WS_WMIX = WS_WG8 + NL * SZ_WG8, WS_WMQ = WS_WMIX + NL * SZ_WMIX, WS_WMO = WS_WMQ + NL * SZ_WMQ,
    WS_WGU = WS_WMO + NL * SZ_WMO, WS_WDN = WS_WGU + NL * SZ_WGU, WS_WMKV = WS_WDN + NL * SZ_WDN;
constexpr size_t WS_XB = WS_WMKV + (size_t)4096 * DM * 2;
constexpr size_t WS_SSQ = WS_XB + (size_t)(MALL + 256) * DM * 2;
constexpr size_t WS_MEMB = WS_SSQ + (size_t)MALL * 16 * 8;
constexpr size_t WS_SSQM = WS_MEMB + (size_t)4096 * DM * 2;
constexpr size_t WS_RAWKV = WS_SSQM + 4096 * 4;
constexpr size_t WS_MK = WS_RAWKV + (size_t)4096 * 4096 * 4;
constexpr size_t WS_MVT = WS_MK + (size_t)NL * BP * 4 * 256 * 128 * 2;
constexpr size_t WS_SMK = WS_MVT + (size_t)NL * BP * 4 * 256 * 128 * 2;
constexpr size_t WS_SMVT = WS_SMK + (size_t)NL * BS * 4 * 256 * 128 * 2;
constexpr size_t WS_Z = WS_SMVT + (size_t)NL * BS * 4 * 256 * 128 * 2;
constexpr size_t WS_PREP = WS_Z + (size_t)MALL * NZ * 2;
constexpr size_t WS_GU = WS_Z;
constexpr size_t WS_EG = WS_PREP + (size_t)NCH * PCH * 2;
constexpr size_t WS_Y = al256(WS_EG + (size_t)NCH * 4);
constexpr size_t WS_QM = WS_Y + (size_t)MALL * DM * 2;
constexpr size_t WS_OM = WS_QM + (size_t)MALL * 512 * 2;
constexpr size_t WS_ACT = WS_OM + (size_t)MALL * 512 * 2;
constexpr size_t WS_END = WS_ACT + (size_t)MALL * DFF * 2;
static_assert(WS_GU + (size_t)MALL * NGU * 2 <= WS_EG, "GU overlay fits in Z | PREP");
static_assert(WS_END <= 2147483648ull, "workspace map exceeds the guaranteed 2 GiB");

constexpr int LDS_BYTES = 147456;
constexpr int MISC_OFF = 139264;
constexpr int NWAVES = 8, NTHR = 512;

DI unsigned pk2(float lo, float hi) { f32x2 v = {lo, hi}; bf16x2_t b = __builtin_convertvector(v, bf16x2_t); return __builtin_bit_cast(unsigned, b); }
DI float bflo(unsigned u) { return __uint_as_float(u << 16); }
DI float bfhi(unsigned u) { return __uint_as_float(u & 0xffff0000u); }
DI float bf2f(bf16_t u) { return __uint_as_float((unsigned)u << 16); }
DI bf16_t f2bf(float f) { return (bf16_t)(pk2(f, 0.f) & 0xffffu); }
DI u32x4 pk8(const float* v) { u32x4 r; r.x = pk2(v[0], v[1]); r.y = pk2(v[2], v[3]); r.z = pk2(v[4], v[5]); r.w = pk2(v[6], v[7]); return r; }
DI void unpk8(u32x4 r, float* v) { v[0] = bflo(r.x); v[1] = bfhi(r.x); v[2] = bflo(r.y); v[3] = bfhi(r.y); v[4] = bflo(r.z); v[5] = bfhi(r.z); v[6] = bflo(r.w); v[7] = bfhi(r.w); }
DI u32x2 pk4(f32x4 v) { u32x2 r; r.x = pk2(v[0], v[1]); r.y = pk2(v[2], v[3]); return r; }
DI f32x4 unpk4(u32x2 r) { f32x4 v; v[0] = bflo(r.x); v[1] = bfhi(r.x); v[2] = bflo(r.y); v[3] = bfhi(r.y); return v; }
DI float wave_sum(float v) {
#pragma unroll
    for (int o = 1; o < 64; o <<= 1) v += __shfl_xor(v, o);
    return v;
}
DI float fexp(float x) { return __builtin_amdgcn_exp2f(x * 1.4426950408889634f); }
DI float flog(float x) { return __builtin_amdgcn_logf(x) * 0.6931471805599453f; }
DI float sigmoidf_(float x) { return __builtin_amdgcn_rcpf(1.0f + __builtin_amdgcn_exp2f(-1.4426950408889634f * x)); }
DI float siluf_(float x) { return x * __builtin_amdgcn_rcpf(1.0f + __builtin_amdgcn_exp2f(-1.4426950408889634f * x)); }
DI float softplusf_(float x) { return fmaxf(x, 0.f) + log1pf(__expf(-fabsf(x))); }
#define MFMA16(a, b, c) __builtin_amdgcn_mfma_f32_16x16x32_bf16((a), (b), (c), 0, 0, 0)
#define MFMA16K16(a, b, c) __builtin_amdgcn_mfma_f32_16x16x16bf16_1k((a), (b), (c), 0, 0, 0)
#define MFMA32(a, b, c) __builtin_amdgcn_mfma_f32_32x32x16_bf16((a), (b), (c), 0, 0, 0)
#define LDS_WAIT() asm volatile("s_waitcnt lgkmcnt(0)" ::: "memory")
#define VM_WAIT() asm volatile("s_waitcnt vmcnt(0)" ::: "memory")
DI int otid() { int t = threadIdx.x; asm volatile("" : "+v"(t)); return t; }
DI int obid() { int b = blockIdx.x; asm volatile("" : "+s"(b)); return b; }
DI int ogrid() { int g = gridDim.x; asm volatile("" : "+s"(g)); return g; }
#define LBAR() do { asm volatile("s_waitcnt lgkmcnt(0)" ::: "memory"); __builtin_amdgcn_s_barrier(); asm volatile("" ::: "memory"); } while (0)
#define MK_ONE_LAUNCH 1
namespace pg8 {
#define PG8_LAS __attribute__((address_space(3)))
constexpr int BM = 256, BK = 64, HALF = 128, HTB = HALF * BK * 2  , STAGE_BYTES = 8 * HTB, NXCD = 8, WGM = 4;
__host__ __device__ __forceinline__ int lds_byte(int r, int c) { const int st = (r >> 4) * 2 + (c >> 5), rr = r & 15, cc = c & 31, ob = rr * 64 + cc * 2; return st * 1024 + (ob ^ (((ob >> 9) & 1) << 5)); }
__host__ __device__ __forceinline__ void stage_rc(int b, int& R, int& C) { const int st = b / 1024, sb = b % 1024, swz = sb ^ (((sb >> 9) & 1) << 5); R = (st >> 1) * 16 + swz / 64; C = (st & 1) * 32 + (swz % 64) / 2; }
__host__ __device__ __forceinline__ int perm32(int rho) { const int n = rho >> 4, i = rho & 15; return 8 * (i >> 2) + 4 * n + (i & 3); }

struct Unit { int pm, pn; };
struct Gemm { const bf16_t* A; const bf16_t* Bt; int M, N, K; };

struct StaticOrder {
    int nM, nN, nwg, G, c; int rev = 0;
    __host__ __device__ void init(int M, int N, int G_, int c_) { nM = M / BM; nN = N / BM; nwg = nM * nN; G = G_; c = c_; }
    __host__ __device__ void init_tiles(int nM_, int nN_, int G_, int c_) { nM = nM_; nN = nN_; nwg = nM * nN; G = G_; c = c_; }
    __host__ __device__ bool next(int i, Unit& u) const {
        const long L = (long)i * G + c; if (L >= nwg) return false;
        int wgid = (int)L; { const int q = nwg / NXCD, r = nwg % NXCD, xcd = wgid % NXCD, off = wgid / NXCD; wgid = (xcd < r ? xcd * (q + 1) : r * (q + 1) + (xcd - r) * q) + off; }
        if (rev) wgid = nwg - 1 - wgid;
        const int nig = WGM * nN, gid = wgid / nig, fm = gid * WGM, gsz = (nM - fm) < WGM ? (nM - fm) : WGM;
        u.pm = fm + ((wgid % nig) % gsz); u.pn = (wgid % nig) / gsz; return true;
    }
    __device__ __forceinline__ void a_ready(const Unit&) const {}
    __device__ __forceinline__ void done(const Unit&) const {}
};
template <class Epi, class Sched, bool ALIGN_EPI = false, bool SP2 = false>
__device__ __forceinline__ void gemm_phase(PG8_LAS unsigned char* lds, const Gemm g, const Sched& S, const Epi& E) {
    const int tid = otid(), wid = __builtin_amdgcn_readfirstlane(tid >> 6), lane = tid & 63, wr = wid >> 2, wc = wid & 3, fr = lane & 15, fq = lane >> 4;
    const int K = g.K, nt = K / BK;
    int voffA[2], voffB[2];
#pragma unroll
    for (int i = 0; i < 2; ++i) { int R, C; stage_rc(tid * 16 + i * 8192, R, C); const int Rb = Epi::PERM ? ((R & ~31) + perm32(R & 31)) : R;
        const int Ra = Epi::ROWMAP ? (62 * (R >> 6) - 2 + (R & 63)) : R;
        voffA[i] = (Ra * K + C) * 2; voffB[i] = (Rb * K + C) * 2; }
    const size_t kstep = (size_t)(BK * 2);
    const size_t hstep = (size_t)HALF * K * 2;
    const size_t tstep = 2 * hstep;
    const size_t hstepA = Epi::ROWMAP ? (size_t)124 * K * 2 : hstep, tstepA = 2 * hstepA;
    const unsigned ldsw = (unsigned)wid * 1024u;
    const int aoff = lds_byte(wr * 64 + fr, fq * 8), boff = lds_byte(wc * 32 + fr, fq * 8);
#define PG8_SA(b, h) (((b) * 2 + (h)) * HTB)
#define PG8_SB(b, h) ((4 + (b) * 2 + (h)) * HTB)
#define PG8_STAGE(bufoff, gbase, voff) do { _Pragma("unroll") for (int _i = 0; _i < 2; ++_i) \
        __builtin_amdgcn_global_load_lds((const unsigned*)((const char*)(gbase) + (voff)[_i]), (PG8_LAS unsigned*)(lds + (bufoff) + ldsw + _i * 8192), 16, 0, 0); } while (0)
#define PG8_LDA(dst, b, h) do { _Pragma("unroll") for (int m = 0; m < 4; ++m) _Pragma("unroll") for (int k = 0; k < 2; ++k) dst[m][k] = *(const PG8_LAS bf16x8*)(lds + PG8_SA(b, h) + aoff + m * 2048 + k * 1024); } while (0)
#define PG8_LDB(dst, b, h) do { _Pragma("unroll") for (int n = 0; n < 2; ++n) _Pragma("unroll") for (int k = 0; k < 2; ++k) dst[n][k] = *(const PG8_LAS bf16x8*)(lds + PG8_SB(b, h) + boff + n * 2048 + k * 1024); } while (0)
#define PG8_MMA(ai, bj, At, Bt) do { __builtin_amdgcn_s_setprio(1); _Pragma("unroll") for (int m = 0; m < 4; ++m) _Pragma("unroll") for (int n = 0; n < 2; ++n) _Pragma("unroll") for (int k = 0; k < 2; ++k) \
        acc[ai][bj][m][n] = __builtin_amdgcn_mfma_f32_16x16x32_bf16(Bt[n][k], At[m][k], acc[ai][bj][m][n], 0, 0, 0); __builtin_amdgcn_s_setprio(0); } while (0)
#define PG8_WAIT_V(n) asm volatile("s_waitcnt vmcnt(" #n ")" ::: "memory")
#define PG8_WAIT_L(n) asm volatile("s_waitcnt lgkmcnt(" #n ")" ::: "memory")
#define PG8_BAR __builtin_amdgcn_s_barrier()
#define PG8_SCHED __builtin_amdgcn_sched_barrier(0)
    Unit cur, nxt; int ui = 0;
    if (!S.next(0, cur)) return;
    f32x4 acc[2][2][4][2];
#pragma unroll
    for (int a = 0; a < 2; ++a)
#pragma unroll
        for (int b = 0; b < 2; ++b)
#pragma unroll
            for (int m = 0; m < 4; ++m)
#pragma unroll
                for (int n = 0; n < 2; ++n) acc[a][b][m][n] = (f32x4){0.f, 0.f, 0.f, 0.f};
    bf16x8 At[4][2], B0[2][2], B1[2][2];
    const char* cA = (const char*)g.A + (size_t)cur.pm * tstepA; const char* cB = (const char*)g.Bt + (size_t)cur.pn * tstep;
    S.a_ready(cur);
    PG8_LAS float* RS = (PG8_LAS float*)(lds + MISC_OFF + 1024);
    u32x2 raw0 = {0u, 0u}; if constexpr (Epi::STAGE) raw0 = E.st_issue(cur, tid);
    if constexpr (SP2) {
        PG8_STAGE(PG8_SB(0, 0), cB, voffB); PG8_STAGE(PG8_SB(0, 1), cB + hstep, voffB); PG8_STAGE(PG8_SA(0, 0), cA, voffA); PG8_STAGE(PG8_SA(0, 1), cA + hstepA, voffA);
        if (wr == 1) PG8_BAR;
        PG8_WAIT_V(2); PG8_BAR;
        PG8_STAGE(PG8_SB(1, 0), cB + kstep, voffB); PG8_STAGE(PG8_SA(1, 0), cA + kstep, voffA); PG8_STAGE(PG8_SB(1, 1), cB + hstep + kstep, voffB);
        PG8_WAIT_V(6); PG8_BAR;
    } else {
        PG8_STAGE(PG8_SB(0, 0), cB, voffB); PG8_STAGE(PG8_SA(0, 0), cA, voffA); PG8_STAGE(PG8_SB(0, 1), cB + hstep, voffB); PG8_STAGE(PG8_SA(0, 1), cA + hstepA, voffA);
        if (wr == 1) PG8_BAR;
        PG8_WAIT_V(4); PG8_BAR;
        PG8_STAGE(PG8_SB(1, 0), cB + kstep, voffB); PG8_STAGE(PG8_SA(1, 0), cA + kstep, voffA); PG8_STAGE(PG8_SB(1, 1), cB + hstep + kstep, voffB);
        PG8_WAIT_V(6); PG8_BAR;
    }
    if constexpr (Epi::STAGE) E.st_commit(raw0, cur, RS, tid);
    for (;;) {
        const bool has_next = S.next(ui + 1, nxt);
        const char* nA = has_next ? (const char*)g.A + (size_t)nxt.pm * tstepA : cA; const char* nB = has_next ? (const char*)g.Bt + (size_t)nxt.pn * tstep : cB;
        for (int t = 0; t < nt; t += 2) {
            const bool last = (t == nt - 2);
            const char* a1 = cA + (size_t)(t + 1) * kstep;
            const char* a2 = last ? nA : cA + (size_t)(t + 2) * kstep; const char* b2 = last ? nB : cB + (size_t)(t + 2) * kstep;
            const char* a3 = a2 + kstep; const char* b3 = b2 + kstep;
            if (last && has_next) S.a_ready(nxt);
            if constexpr (SP2) {
            PG8_LDB(B0, 0, 0); PG8_LDB(B1, 0, 1); PG8_SCHED; PG8_LDA(At, 0, 0); PG8_STAGE(PG8_SA(1, 1), a1 + hstepA, voffA);
            PG8_WAIT_V(8); PG8_WAIT_L(0); PG8_BAR; PG8_MMA(0, 0, At, B0); PG8_MMA(0, 1, At, B1); PG8_BAR; PG8_SCHED;
            PG8_LDA(At, 0, 1); PG8_STAGE(PG8_SB(0, 0), b2, voffB); PG8_STAGE(PG8_SB(0, 1), b2 + hstep, voffB); PG8_STAGE(PG8_SA(0, 0), a2, voffA);
            PG8_WAIT_V(8); PG8_WAIT_L(0); PG8_BAR; PG8_MMA(1, 0, At, B0); PG8_MMA(1, 1, At, B1); PG8_BAR; PG8_SCHED;
            PG8_LDB(B0, 1, 0); PG8_LDB(B1, 1, 1); PG8_SCHED; PG8_LDA(At, 1, 0); PG8_STAGE(PG8_SA(0, 1), a2 + hstepA, voffA);
            PG8_WAIT_V(8); PG8_WAIT_L(0); PG8_BAR; PG8_MMA(0, 0, At, B0); PG8_MMA(0, 1, At, B1); PG8_BAR; PG8_SCHED;
            PG8_LDA(At, 1, 1); PG8_STAGE(PG8_SB(1, 0), b3, voffB); PG8_STAGE(PG8_SB(1, 1), b3 + hstep, voffB); PG8_STAGE(PG8_SA(1, 0), a3, voffA);
            PG8_WAIT_V(8); PG8_WAIT_L(0); PG8_BAR; PG8_MMA(1, 0, At, B0); PG8_MMA(1, 1, At, B1); PG8_BAR; PG8_SCHED;
            } else {
            PG8_LDB(B0, 0, 0); PG8_SCHED; PG8_LDA(At, 0, 0); PG8_STAGE(PG8_SA(1, 1), a1 + hstepA, voffA);
            PG8_WAIT_L(8); PG8_BAR; PG8_WAIT_L(0); PG8_MMA(0, 0, At, B0); PG8_BAR; PG8_SCHED;
            PG8_LDB(B1, 0, 1); PG8_STAGE(PG8_SB(0, 0), b2, voffB);
            PG8_BAR; PG8_WAIT_L(0); PG8_MMA(0, 1, At, B1); PG8_BAR;
            PG8_LDA(At, 0, 1); PG8_STAGE(PG8_SA(0, 0), a2, voffA);
            PG8_BAR; PG8_WAIT_L(0); PG8_MMA(1, 0, At, B0); PG8_BAR; PG8_SCHED;
            PG8_STAGE(PG8_SB(0, 1), b2 + hstep, voffB);
            PG8_WAIT_V(6); PG8_BAR; PG8_MMA(1, 1, At, B1); PG8_BAR;
            PG8_LDB(B0, 1, 0); PG8_SCHED; PG8_LDA(At, 1, 0); PG8_STAGE(PG8_SA(0, 1), a2 + hstepA, voffA);
            PG8_WAIT_L(8); PG8_BAR; PG8_WAIT_L(0); PG8_MMA(0, 0, At, B0); PG8_BAR; PG8_SCHED;
            PG8_LDB(B1, 1, 1); PG8_STAGE(PG8_SB(1, 0), b3, voffB);
            PG8_BAR; PG8_WAIT_L(0); PG8_MMA(0, 1, At, B1); PG8_BAR;
            PG8_LDA(At, 1, 1); PG8_STAGE(PG8_SA(1, 0), a3, voffA);
            PG8_BAR; PG8_WAIT_L(0); PG8_MMA(1, 0, At, B0); PG8_BAR; PG8_SCHED;
            PG8_STAGE(PG8_SB(1, 1), b3 + hstep, voffB);
            PG8_WAIT_V(6); PG8_BAR; PG8_MMA(1, 1, At, B1); PG8_BAR;
            }
        }
        if constexpr (ALIGN_EPI) { if (wr == 0) PG8_BAR; }
        if constexpr (!Epi::AFTER_DRAIN) {
            if constexpr (Epi::STAGE) {
                const Unit& nu = has_next ? nxt : cur; const u32x2 raw = E.st_issue(nu, tid);
                E(acc, cur, wr, wc, fr, fq, RS + (ui & 1) * 640);
                E.st_commit(raw, nu, RS + ((ui + 1) & 1) * 640, tid);
            } else E(acc, cur, wr, wc, fr, fq);
            S.done(cur); }
        if (!has_next) break;
#pragma unroll
        for (int a = 0; a < 2; ++a)
#pragma unroll
            for (int b = 0; b < 2; ++b)
#pragma unroll
                for (int m = 0; m < 4; ++m)
#pragma unroll
                    for (int n = 0; n < 2; ++n) acc[a][b][m][n] = (f32x4){0.f, 0.f, 0.f, 0.f};
        cur = nxt; cA = nA; cB = nB; ++ui;
        if constexpr (ALIGN_EPI) { if (wr == 1) PG8_BAR; }
    }
    PG8_WAIT_V(0);
    if constexpr (!ALIGN_EPI) { if (wr == 0) PG8_BAR; }
    PG8_BAR;
    if constexpr (Epi::AFTER_DRAIN) { E.fused(acc, cur, wr, wc, fr, fq, lds, wid, lane); S.done(cur); }
#undef PG8_SA
#undef PG8_SB
#undef PG8_STAGE
#undef PG8_LDA
#undef PG8_LDB
#undef PG8_MMA
#undef PG8_WAIT_V
#undef PG8_WAIT_L
#undef PG8_BAR
#undef PG8_SCHED
}
}
#define XB_TMO      128
#define XB_XCNT(j)  (256  + 64 * (j))
#define XB_XSUB(j)  (1280 + 64 * (j))
#define XB_XGEN(j)  (2304 + 64 * (j))
#define XB_TOP      3328
#define XB_TOPGEN   3392
#define XCD_BAR_WORDS 3456
#define XB_SPIN_CAP (1u << 18)

__device__ __forceinline__ unsigned xb_ld(unsigned* p)              { return __hip_atomic_load(p, __ATOMIC_RELAXED, __HIP_MEMORY_SCOPE_AGENT); }
__device__ __forceinline__ unsigned xb_add(unsigned* p, unsigned v) { return __hip_atomic_fetch_add(p, v, __ATOMIC_RELAXED, __HIP_MEMORY_SCOPE_AGENT); }
__device__ __forceinline__ unsigned xb_xcc_id() { return (unsigned)__builtin_amdgcn_s_getreg((3 << 11) | 20) & 0xFu; }
#define XB_SPIN(cond, bar) do { unsigned _sp = 0; while (cond) { __builtin_amdgcn_s_sleep(16); \
    if ((++_sp & 255u) == 0u) { if (xb_ld(&(bar)[XB_TMO])) break; if (_sp > XB_SPIN_CAP) { atomicAdd(&(bar)[XB_TMO], 1u); break; } } } } while (0)

struct XcdBarrier {
    unsigned* bar; unsigned x;
    volatile LAS unsigned* st;
};

__device__ __forceinline__ XcdBarrier xcd_barrier_post(unsigned* bar, volatile LAS unsigned* st) {
    XcdBarrier b; b.bar = bar; b.x = xb_xcc_id(); b.st = st;
    if (threadIdx.x == 0) (void)xb_add(&bar[XB_XCNT(b.x)], 1u);
    return b;
}
__device__ __forceinline__ void xcd_barrier_complete(unsigned* bar, unsigned x, unsigned& nloc, unsigned& nx) {
    const unsigned G = gridDim.x * gridDim.y * gridDim.z;
    unsigned sum, cnt, mine, sp = 0u;
    for (;;) {
        sum = 0u; cnt = 0u; mine = 0u;
#pragma unroll
        for (unsigned j = 0; j < 16; ++j) { const unsigned c = xb_ld(&bar[XB_XCNT(j)]); sum += c; cnt += (c > 0u) ? 1u : 0u; mine = (j == x) ? c : mine; }
        if (sum == G) break;
        __builtin_amdgcn_s_sleep(1);
        if ((++sp & 255u) == 0u) { if (xb_ld(&bar[XB_TMO])) break; if (sp > XB_SPIN_CAP) { atomicAdd(&bar[XB_TMO], 1u); break; } }
    }
    nloc = mine > 0u ? mine : 1u; nx = cnt > 0u ? cnt : 1u;
}

__device__ __forceinline__ void xcd_barrier(const XcdBarrier& b) {
    asm volatile("s_waitcnt vmcnt(0)" ::: "memory");
    __syncthreads();
    if (threadIdx.x == 0) {
        unsigned* bar = b.bar;
        __builtin_amdgcn_s_waitcnt(0);
        unsigned nloc = b.st[0], nx = b.st[1];
        if (nloc == 0u) { xcd_barrier_complete(bar, b.x, nloc, nx); b.st[0] = nloc; b.st[1] = nx; }
        const unsigned old = xb_add(&bar[XB_XSUB(b.x)], 1u);
        const unsigned gen = old / nloc;
        if (old + 1u == (gen + 1u) * nloc) {
            __builtin_amdgcn_fence(__ATOMIC_RELEASE, "agent");
            asm volatile("s_waitcnt vmcnt(0)" ::: "memory");
            const unsigned og = xb_add(&bar[XB_TOP], 1u);
            const unsigned tg = og / nx;
            if (og + 1u == (tg + 1u) * nx) xb_add(&bar[XB_TOPGEN], 1u);
            else XB_SPIN(xb_ld(&bar[XB_TOPGEN]) == tg, bar);
            __builtin_amdgcn_fence(__ATOMIC_ACQUIRE, "agent");
            xb_add(&bar[XB_XGEN(b.x)], 1u);
            asm volatile("s_waitcnt vmcnt(0)" ::: "memory");
        } else {
            XB_SPIN(xb_ld(&bar[XB_XGEN(b.x)]) == gen, bar);
            __builtin_amdgcn_fence(__ATOMIC_ACQUIRE, "agent");
            asm volatile("s_waitcnt vmcnt(0)" ::: "memory");
        }
    }
    __syncthreads();
}
struct Args { const float* in[34]; float* out; unsigned char* ws; int ph_lo, ph_hi; };
enum { I_XP = 0, I_XS, I_MEM, I_STATE, I_CGC, I_CSC, I_CSBK, I_CSBV, I_CMK, I_CMV, I_CFC, I_NMIXG, I_WIN, I_GCW, I_ALOG, I_DTB, I_GNG, I_SCW, I_SCG, I_SBG, I_WMIX,
       I_NMEMG, I_MEMING, I_WMQ, I_WMK, I_WMV, I_MQG, I_MKG, I_WMO, I_NFFNG, I_WGATE, I_WUP, I_FCW, I_WDN };
constexpr int CW_BAR = 4096;

typedef unsigned long long u64_t;
constexpr float SSQ_FIX = 1048576.0f;
DI float ssq_ld(const u64_t* ssq, int row) { return (float)ssq[row] * (1.0f / SSQ_FIX); }
DI float row_rstd(const u64_t* ssq, int row) { return rsqrtf(ssq_ld(ssq, row) * (1.0f / DM) + EPS); }
struct EpiScaleBf16 {
    static constexpr bool PERM = true, AFTER_DRAIN = false, ROWMAP = false, STAGE = true;
    bf16_t* O; int ldc; const u64_t* ssq; int tk, tv; float* fkp; float* fks; float* fvp; float* fvs;
    DI u32x2 st_issue(const pg8::Unit& n, int tid) const { return *(const u32x2*)(ssq + n.pm * 256 + (tid & 255)); }
    DI void st_commit(u32x2 raw, const pg8::Unit&, LAS float* RSn, int tid) const {
        const u64_t v = ((u64_t)raw.y << 32) | raw.x; if (tid < 256) RSn[tid] = rsqrtf((float)v * (1.0f / (SSQ_FIX * DM)) + EPS); }
    DI void operator()(const f32x4 (&acc)[2][2][4][2], const pg8::Unit& u, int wr, int wc, int fr, int fq, const LAS float* RS) const {
        const int row0 = u.pm * 256 + wr * 64 + fr, col0 = u.pn * 256 + wc * 32 + 8 * fq;
        const bool side = (u.pn == tk) || (u.pn == tv);
#pragma unroll
        for (int ai = 0; ai < 2; ++ai)
#pragma unroll
            for (int m = 0; m < 4; ++m) {
                const int row = row0 + ai * 128 + m * 16;
                const float rs = RS[wr * 64 + ai * 128 + m * 16 + fr];
                bf16_t* rowp = O + (size_t)row * ldc + col0;
#pragma unroll
                for (int bj = 0; bj < 2; ++bj) {
                    const f32x4 v0 = acc[ai][bj][m][0] * rs, v1 = acc[ai][bj][m][1] * rs;
                    u32x4 w; w.x = pk2(v0[0], v0[1]); w.y = pk2(v0[2], v0[3]); w.z = pk2(v1[0], v1[1]); w.w = pk2(v1[2], v1[3]);
                    *(u32x4*)(rowp + bj * 128) = w;
                    if (side) {
                        float* f = (u.pn == tk) ? (row < MP ? fkp + (size_t)row * 256 : fks + (size_t)(row - MP) * 256) : (row < MP ? fvp + (size_t)row * 256 : fvs + (size_t)(row - MP) * 256);
                        f += wc * 32 + 8 * fq + bj * 128;
                        *(f32x4*)f = v0; *(f32x4*)(f + 4) = v1;
                    }
                }
            }
    }
};
struct EpiScaleF32 {
    static constexpr bool PERM = true, AFTER_DRAIN = false, ROWMAP = false, STAGE = false;
    float* O; int ldc; const float* ssq1;
    DI void operator()(const f32x4 (&acc)[2][2][4][2], const pg8::Unit& u, int wr, int wc, int fr, int fq) const {
        const int row0 = u.pm * 256 + wr * 64 + fr, col0 = u.pn * 256 + wc * 32 + 8 * fq;
#pragma unroll
        for (int ai = 0; ai < 2; ++ai)
#pragma unroll
            for (int m = 0; m < 4; ++m) {
                const int row = row0 + ai * 128 + m * 16;
                const float rs = rsqrtf(ssq1[row] * (1.0f / DM) + EPS);
                float* rowp = O + (size_t)row * ldc + col0;
#pragma unroll
                for (int bj = 0; bj < 2; ++bj) { *(f32x4*)(rowp + bj * 128) = acc[ai][bj][m][0] * rs; *(f32x4*)(rowp + bj * 128 + 4) = acc[ai][bj][m][1] * rs; }
            }
    }
};
struct EpiResid {
    static constexpr bool PERM = true, AFTER_DRAIN = false, ROWMAP = false, STAGE = false;
    float* XF; bf16_t* XB; u64_t* ssq; int fin;
    DI void operator()(const f32x4 (&acc)[2][2][4][2], const pg8::Unit& u, int wr, int wc, int fr, int fq) const {
        const int row0 = u.pm * 256 + wr * 64 + fr, col0 = u.pn * 256 + wc * 32 + 8 * fq;
        u32x4 rv[4][2];
#pragma unroll
        for (int i = 0; i < 4; ++i) { const bf16_t* rp = XB + (size_t)(row0 + i * 16) * DM + col0; rv[i][0] = *(const u32x4*)rp; rv[i][1] = *(const u32x4*)(rp + 128); }
#pragma unroll
        for (int i = 0; i < 8; ++i) {
            const int ai = i >> 2, m = i & 3, row = row0 + ai * 128 + m * 16;
            const u32x4 r0 = rv[i & 3][0], r1 = rv[i & 3][1];
            if (i + 4 < 8) { const bf16_t* rp = XB + (size_t)(row0 + 128 + (i & 3) * 16) * DM + col0; rv[i & 3][0] = *(const u32x4*)rp; rv[i & 3][1] = *(const u32x4*)(rp + 128); }
            float* xo = XF + (size_t)row * DM + col0; bf16_t* xb = XB + (size_t)row * DM + col0;
            float s = 0.f;
#pragma unroll
            for (int bj = 0; bj < 2; ++bj) {
                float r8[8]; unpk8(bj == 0 ? r0 : r1, r8);
                const f32x4 v0 = acc[ai][bj][m][0] + (f32x4){r8[0], r8[1], r8[2], r8[3]}, v1 = acc[ai][bj][m][1] + (f32x4){r8[4], r8[5], r8[6], r8[7]};
                if (fin) { *(f32x4*)(xo + bj * 128) = v0; *(f32x4*)(xo + bj * 128 + 4) = v1; }
                else { u32x4 w; w.x = pk2(v0[0], v0[1]); w.y = pk2(v0[2], v0[3]); w.z = pk2(v1[0], v1[1]); w.w = pk2(v1[2], v1[3]);
                    *(u32x4*)(xb + bj * 128) = w; }
                s += (v0[0] * v0[0] + v0[1] * v0[1]) + (v0[2] * v0[2] + v0[3] * v0[3]) + (v1[0] * v1[0] + v1[1] * v1[1]) + (v1[2] * v1[2] + v1[3] * v1[3]);
            }
            s += __shfl_xor(s, 16); s += __shfl_xor(s, 32);
            if (fq == 0 && !fin) atomicAdd(ssq + row, (u64_t)(s * SSQ_FIX));
        }
    }
};

DI float dpp_ror1(float v) { return __builtin_bit_cast(float, __builtin_amdgcn_update_dpp(0, __builtin_bit_cast(int, v), 0x121, 0xf, 0xf, false)); }
DI float dpp_ror2(float v) { return __builtin_bit_cast(float, __builtin_amdgcn_update_dpp(0, __builtin_bit_cast(int, v), 0x122, 0xf, 0xf, false)); }
struct EpiAct {
    static constexpr bool PERM = true, AFTER_DRAIN = false, ROWMAP = true, STAGE = true;
    bf16_t* ACT; const u64_t* ssq; const float* cw; const float* cache; float* pfc; float* sfc;
    DI u32x2 st_issue(const pg8::Unit& n, int tid) const {
        int tok = 248 * n.pm + 62 * (tid >> 6) - 2 + (tid & 63); tok = tok < 0 ? 0 : (tok < MALL ? tok : MALL - 1);
        int c = tid - 256; c = c < 0 ? 0 : (c < 192 ? c : 191);
        const unsigned* p = tid < 256 ? (const unsigned*)(ssq + tok) : (const unsigned*)(cw + (c >> 6) * DFF + n.pn * 128 + 2 * (c & 63));
        return *(const u32x2*)p;
    }
    DI void st_commit(u32x2 raw, const pg8::Unit& n, LAS float* RSn, int tid) const {
        if (tid < 256) { const int tok = 248 * n.pm + 62 * (tid >> 6) - 2 + (tid & 63); const u64_t v = ((u64_t)raw.y << 32) | raw.x;
            RSn[tid] = (tok >= 0 && tok < MALL) ? rsqrtf((float)v * (1.0f / (SSQ_FIX * DM)) + EPS) : 0.f; }
        else if (tid < 448) { const int c = tid - 256; *(LAS u32x2*)(RSn + 256 + (c >> 6) * 128 + 2 * (c & 63)) = raw; }
    }
    DI void operator()(f32x4 (&acc)[2][2][4][2], const pg8::Unit& u, int wr, int wc, int fr, int fq, const LAS float* RS) const {
        const int ch0 = u.pn * 128 + wc * 32 + 8 * fq;
        f32x4 w[3][2];
#pragma unroll
        for (int i = 0; i < 3; ++i)
#pragma unroll
            for (int n = 0; n < 2; ++n) w[i][n] = *(const LAS f32x4*)(RS + 256 + i * 128 + wc * 32 + 8 * fq + 4 * n);
#pragma unroll
        for (int ai = 0; ai < 2; ++ai) {
            const int tok0 = 248 * u.pm + 62 * (2 * ai + wr) - 2 + fr;
#pragma unroll
            for (int m = 0; m < 4; ++m) {
                const float rs = RS[(2 * ai + wr) * 64 + 16 * m + fr];
#pragma unroll
                for (int bj = 0; bj < 2; ++bj)
#pragma unroll
                    for (int n = 0; n < 2; ++n) acc[ai][bj][m][n] = acc[ai][bj][m][n] * rs;
            }
            f32x4 p1[2], p2[2];
#pragma unroll
            for (int n = 0; n < 2; ++n) { p1[n] = (f32x4){0.f, 0.f, 0.f, 0.f}; p2[n] = p1[n]; }
#pragma unroll
            for (int m = 0; m < 4; ++m) {
                const int tok = tok0 + 16 * m;
                f32x4 g1[2], g2[2];
#pragma unroll
                for (int n = 0; n < 2; ++n)
#pragma unroll
                    for (int e = 0; e < 4; ++e) {
                        const float a1 = dpp_ror1(acc[ai][0][m][n][e]), a2 = dpp_ror2(acc[ai][0][m][n][e]);
                        g1[n][e] = fr >= 1 ? a1 : p1[n][e]; g2[n][e] = fr >= 2 ? a2 : p2[n][e];
                        p1[n][e] = a1; p2[n][e] = a2;
                    }
                const bool outrow = (16 * m + fr >= 2) && tok < MALL;
                const bool smp = tok >= MP;
                const int t = smp ? ((tok - MP) & (TS - 1)) : (tok & (TP - 1)), bb = smp ? ((tok - MP) >> 4) : (tok >> 12), T = smp ? TS : TP;
                if (outrow && t < 2) {
                    f32x4 h0[2], h1[2];
#pragma unroll
                    for (int n = 0; n < 2; ++n) { h0[n] = (f32x4){0.f, 0.f, 0.f, 0.f}; h1[n] = h0[n]; }
                    if (smp) { const float* cp = cache + (size_t)bb * 2 * DFF + ch0;
#pragma unroll
                        for (int n = 0; n < 2; ++n) { h0[n] = *(const f32x4*)(cp + 4 * n); h1[n] = *(const f32x4*)(cp + DFF + 4 * n); } }
#pragma unroll
                    for (int n = 0; n < 2; ++n) { if (t == 0) { g2[n] = h0[n]; g1[n] = h1[n]; } else g2[n] = h1[n]; }
                }
                if (outrow) {
                    float y[8];
#pragma unroll
                    for (int n = 0; n < 2; ++n)
#pragma unroll
                        for (int e = 0; e < 4; ++e) { const float gt = w[0][n][e] * g2[n][e] + w[1][n][e] * g1[n][e] + w[2][n][e] * acc[ai][0][m][n][e]; y[4 * n + e] = siluf_(gt) * acc[ai][1][m][n][e]; }
                    *(u32x4*)(ACT + (size_t)tok * DFF + ch0) = pk8(y);
                    if (t >= T - 2) { float* dst = (smp ? sfc : pfc) + ((size_t)bb * 2 + (t - (T - 2))) * DFF + ch0; *(f32x4*)dst = acc[ai][0][m][0]; *(f32x4*)(dst + 4) = acc[ai][0][m][1]; }
                }
            }
        }
    }
};

DI void transpose_item(const float* W, int K, int N, int n_src0, const float* gain, bf16_t* WT, int row_dst0, int kb, LAS float* scr, int lane) {
    const int k0 = 64 * kb, q = lane & 15, r4 = lane >> 4;
    f32x4 v[16];
#pragma unroll
    for (int i = 0; i < 16; ++i) v[i] = *(const f32x4*)(W + (size_t)(k0 + 4 * i + r4) * N + n_src0 + 4 * q);
#pragma unroll
    for (int i = 0; i < 16; ++i) { const int kk = 4 * i + r4; const float g = gain ? gain[k0 + kk] : 1.f; LAS float* s = scr + kk * 65 + 4 * q;
        s[0] = v[i][0] * g; s[1] = v[i][1] * g; s[2] = v[i][2] * g; s[3] = v[i][3] * g; }
    LDS_WAIT(); asm volatile("" ::: "memory");
    const int c = lane & 7;
#pragma unroll
    for (int j = 0; j < 8; ++j) { const int n = (lane >> 3) + 8 * j; const LAS float* s = scr + (8 * c) * 65 + n;
        u32x4 o; o.x = pk2(s[0 * 65], s[1 * 65]); o.y = pk2(s[2 * 65], s[3 * 65]); o.z = pk2(s[4 * 65], s[5 * 65]); o.w = pk2(s[6 * 65], s[7 * 65]);
        *(u32x4*)(WT + (size_t)(row_dst0 + n) * K + k0 + 8 * c) = o; }
    LDS_WAIT(); asm volatile("" ::: "memory");
}
DI float row_to_bf16(const float* xrow, bf16_t* orow, int lane) {
    const f32x4* xr = (const f32x4*)xrow + lane; float s = 0.f;
    unsigned long long* o8 = (unsigned long long*)orow + lane;
#pragma unroll
    for (int j = 0; j < 4; ++j) { const f32x4 v = xr[64 * j]; s += (v[0] * v[0] + v[1] * v[1]) + (v[2] * v[2] + v[3] * v[3]);
        o8[64 * j] = (unsigned long long)pk2(v[0], v[1]) | ((unsigned long long)pk2(v[2], v[3]) << 32); }
    return wave_sum(s);
}
DI void transpose_v_tile(const float* src, size_t pitch, bf16_t* dst, LAS unsigned char* lds, int tid) {
    LAS bf16_t* tile = (LAS bf16_t*)lds;
#pragma unroll 4
    for (int i = 0; i < 64; ++i) { const int idx = tid + 512 * i, n = idx >> 7, d = idx & 127; tile[d * 264 + n] = f2bf(src[(size_t)n * pitch + d]); }
    __syncthreads();
#pragma unroll
    for (int i = 0; i < 8; ++i) { const int v = tid + 512 * i, d = v >> 5, n8 = v & 31; *(u32x4*)(dst + (size_t)d * 256 + 8 * n8) = *(const LAS u32x4*)(tile + d * 264 + 8 * n8); }
    __syncthreads();
}

DI void phase_convert(const Args& A, LAS unsigned char* lds) {
    const int tid = otid(), lane = tid & 63, wave = tid >> 6, G = gridDim.x;
    const int gw = blockIdx.x * NWAVES + wave, NGW = G * NWAVES;
    unsigned char* ws = A.ws;
    LAS float* scr = (LAS float*)(lds + wave * 16640);
    constexpr int NI = 3776;
    for (int it = gw; it < NL * NI; it += NGW) {
        const int l = it / NI; int r = it % NI;
        if (r < 896) { const int kb = r / 56, nb = r % 56, nd = 64 * nb; transpose_item(A.in[I_WIN] + (size_t)l * DM * DIN, DM, DIN, nd + (nd >= 2048 ? 8 : 0), A.in[I_NMIXG] + l * DM, (bf16_t*)(ws + WS_WIN + l * SZ_WIN), nd, kb, scr, lane); continue; } r -= 896;
        if (r < 256) { transpose_item(A.in[I_WMIX] + (size_t)l * DM * DM, DM, DM, 64 * (r % 16), nullptr, (bf16_t*)(ws + WS_WMIX + l * SZ_WMIX), 64 * (r % 16), r / 16, scr, lane); continue; } r -= 256;
        if (r < 128) { transpose_item(A.in[I_WMQ] + (size_t)l * DM * 512, DM, 512, 64 * (r % 8), A.in[I_NMEMG] + l * DM, (bf16_t*)(ws + WS_WMQ + l * SZ_WMQ), 64 * (r % 8), r / 8, scr, lane); continue; } r -= 128;
        if (r < 128) { transpose_item(A.in[I_WMK] + (size_t)l * DM * 512, DM, 512, 64 * (r % 8), A.in[I_MEMING] + l * DM, (bf16_t*)(ws + WS_WMKV), l * 1024 + 64 * (r % 8), r / 8, scr, lane); continue; } r -= 128;
        if (r < 128) { transpose_item(A.in[I_WMV] + (size_t)l * DM * 512, DM, 512, 64 * (r % 8), A.in[I_MEMING] + l * DM, (bf16_t*)(ws + WS_WMKV), l * 1024 + 512 + 64 * (r % 8), r / 8, scr, lane); continue; } r -= 128;
        if (r < 128) { transpose_item(A.in[I_WMO] + (size_t)l * 512 * DM, 512, DM, 64 * (r % 16), nullptr, (bf16_t*)(ws + WS_WMO + l * SZ_WMO), 64 * (r % 16), r / 16, scr, lane); continue; } r -= 128;
        if (r < 704) { const int nb = r % 44; transpose_item(A.in[I_WGATE] + (size_t)l * DM * DFF, DM, DFF, 64 * nb, A.in[I_NFFNG] + l * DM, (bf16_t*)(ws + WS_WGU + l * SZ_WGU), 256 * (nb >> 1) + 64 * (nb & 1), r / 44, scr, lane); continue; } r -= 704;
        if (r < 704) { const int nb = r % 44; transpose_item(A.in[I_WUP] + (size_t)l * DM * DFF, DM, DFF, 64 * nb, A.in[I_NFFNG] + l * DM, (bf16_t*)(ws + WS_WGU + l * SZ_WGU), 256 * (nb >> 1) + 128 + 64 * (nb & 1), r / 44, scr, lane); continue; } r -= 704;
        transpose_item(A.in[I_WDN] + (size_t)l * DFF * DM, DFF, DM, 64 * (r % 16), nullptr, (bf16_t*)(ws + WS_WDN + l * SZ_WDN), 64 * (r % 16), r / 16, scr, lane);
    }
    for (int e = blockIdx.x * NTHR + tid; e < NL * 16 * DM; e += G * NTHR) {
        const int l = e / (16 * DM), j = (e / DM) & 15, k = e % DM;
        const float v = j < 8 ? A.in[I_WIN][(size_t)l * DM * DIN + (size_t)k * DIN + 2048 + j] * A.in[I_NMIXG][l * DM + k] : 0.f;
        ((bf16_t*)(ws + WS_WG8 + l * SZ_WG8))[j * DM + k] = f2bf(v);
    }
    bf16_t* XB = (bf16_t*)(ws + WS_XB); u64_t* SSQ = (u64_t*)(ws + WS_SSQ);
    for (int row = gw; row < MALL + 4096; row += NGW) {
        if (row < MALL) {
            const float* src = row < MP ? A.in[I_XP] + (size_t)row * DM : A.in[I_XS] + (size_t)(row - MP) * DM;
            const float s = row_to_bf16(src, XB + (size_t)row * DM, lane);
            if (lane == 0) SSQ[row] = (u64_t)(s * SSQ_FIX);
        } else {
            const int r = row - MALL;
            const float s = row_to_bf16(A.in[I_MEM] + (size_t)r * DM, (bf16_t*)(ws + WS_MEMB) + (size_t)r * DM, lane);
            if (lane == 0) ((float*)(ws + WS_SSQM))[r] = s;
        }
    }
    for (int e = blockIdx.x * NTHR + tid; e < 256 * DM / 8; e += G * NTHR) ((u32x4*)(XB + (size_t)MALL * DM))[e] = (u32x4){0u, 0u, 0u, 0u};
    {
        bf16_t* SMK = (bf16_t*)(ws + WS_SMK);
        const int NV = NL * BS * 4 * 256 * 16;
        for (int v = blockIdx.x * NTHR + tid; v < NV; v += G * NTHR) {
            const int d8 = v & 15, n = (v >> 4) & 255, h = (v >> 12) & 3, sb = (v >> 14) & 31, l = v >> 19;
            const float* src = A.in[I_CMK] + ((((size_t)(l * BS + sb) * 256 + n) * 4 + h) * 128 + 8 * d8);
            const float* g = A.in[I_MQG] + l * 128 + 8 * d8;
            const f32x4 a = *(const f32x4*)src, b = *(const f32x4*)(src + 4), ga = *(const f32x4*)g, gb = *(const f32x4*)(g + 4);
            u32x4 o; o.x = pk2(a[0] * ga[0], a[1] * ga[1]); o.y = pk2(a[2] * ga[2], a[3] * ga[3]); o.z = pk2(b[0] * gb[0], b[1] * gb[1]); o.w = pk2(b[2] * gb[2], b[3] * gb[3]);
            *(u32x4*)(SMK + (size_t)v * 8) = o;
        }
    }
    __syncthreads();
    for (int t = blockIdx.x; t < NL * BS * 4; t += G) {
        const int h = t & 3, sb = (t >> 2) & 31, l = t >> 7;
        transpose_v_tile(A.in[I_CMV] + ((size_t)(l * BS + sb) * 256 * 4 + h) * 128, 512, (bf16_t*)(ws + WS_SMVT) + (size_t)t * 128 * 256, lds, tid);
    }
}

DI void phase_memkv_post(const Args& A, LAS unsigned char* lds) {
    const int tid = otid(), lane = tid & 63, wave = tid >> 6, G = gridDim.x;
    const float* RAW = (const float*)(A.ws + WS_RAWKV);
    for (int u = blockIdx.x; u < NL * BP * 4; u += G) {
        const int h = u & 3, b = (u >> 2) & 15, l = u >> 6;
        const float mkg0 = A.in[I_MKG][l * 128 + 2 * lane], mkg1 = A.in[I_MKG][l * 128 + 2 * lane + 1];
        const float mqg0 = A.in[I_MQG][l * 128 + 2 * lane], mqg1 = A.in[I_MQG][l * 128 + 2 * lane + 1];
        bf16_t* MK = (bf16_t*)(A.ws + WS_MK) + (size_t)((l * BP + b) * 4 + h) * 256 * 128;
        for (int n = wave; n < 256; n += NWAVES) {
            const float* src = RAW + (size_t)(b * 256 + n) * 4096 + l * 1024 + h * 128;
            const f32x2 k = *(const f32x2*)(src + 2 * lane), v = *(const f32x2*)(src + 512 + 2 * lane);
            const float ss = wave_sum(k[0] * k[0] + k[1] * k[1]);
            const float rs = rsqrtf(ss * (1.0f / 128.0f) + EPS);
            const float k0 = k[0] * rs * mkg0, k1 = k[1] * rs * mkg1;
            const size_t oo = (((size_t)(l * BP + b) * 256 + n) * 4 + h) * 128 + 2 * lane;
            *(f32x2*)(A.out + O_PMK + oo) = (f32x2){k0, k1};
            *(f32x2*)(A.out + O_PMV + oo) = v;
            *(unsigned*)(MK + (size_t)n * 128 + 2 * lane) = pk2(k0 * mqg0, k1 * mqg1);
        }
        __syncthreads();
        transpose_v_tile(RAW + (size_t)(b * 256) * 4096 + l * 1024 + 512 + h * 128, 4096, (bf16_t*)(A.ws + WS_MVT) + (size_t)((l * BP + b) * 4 + h) * 128 * 256, lds, tid);
    }
}
constexpr int P_K = 0, P_Q = 17408, P_VB = 34816, P_KB = 52224, P_KD = 69632, P_LD = 87040, P_LB = 91136, P_DI = 100352, P_GR = 102400, P_BETA = 106496, P_GC = 107520,
    P_CW = 108544, P_WST = 114688, P_END = 132096;
DI void prep_load_cw(const float* cw, int h, LAS float* CW, int t0, int nt) {
    for (int v = t0; v < 4 * 3 * 32; v += nt) { const int c4 = v & 31, x = (v >> 5) % 3, i = v / 96; *(LAS f32x4*)(CW + (i * 3 + x) * 128 + 4 * c4) = *(const f32x4*)(cw + i * 1536 + x * 512 + h * 128 + 4 * c4); }
}
DI void prep_unit(const Args& A, LAS unsigned char* lds, int l, int u) {
    const int tid = otid(), lane = tid & 63, wave = __builtin_amdgcn_readfirstlane(tid >> 6), fr = lane & 15, fq = lane >> 4;
    const bool smp = u >= 1024;
    const int b = smp ? (u - 1024) : (u >> 6), c = smp ? 0 : (u & 63);
    const int row0 = smp ? MP + 16 * b : b * TP + 64 * c;
    const int chbase = smp ? 4096 + 4 * b : b * 256 + c, chstep = smp ? 1 : 64;
    const bf16_t* Z = (const bf16_t*)(A.ws + WS_Z); const bf16_t* XB = (const bf16_t*)(A.ws + WS_XB); const u64_t* SSQ = (const u64_t*)(A.ws + WS_SSQ) + (size_t)(3 * l) * MALL;
    bf16_t* PREP = (bf16_t*)(A.ws + WS_PREP); float* EG = (float*)(A.ws + WS_EG);
    LAS bf16_t* Ksh = (LAS bf16_t*)(lds + P_K); LAS bf16_t* Qsh = (LAS bf16_t*)(lds + P_Q); LAS bf16_t* VB = (LAS bf16_t*)(lds + P_VB); LAS bf16_t* KB = (LAS bf16_t*)(lds + P_KB);
    LAS bf16_t* KD = (LAS bf16_t*)(lds + P_KD); LAS float* LD = (LAS float*)(lds + P_LD); LAS bf16_t* LB = (LAS bf16_t*)(lds + P_LB); LAS bf16_t* DI_ = (LAS bf16_t*)(lds + P_DI);
    LAS float* GR = (LAS float*)(lds + P_WST);       LAS float* BETA = (LAS float*)(lds + P_BETA); LAS float* GC = (LAS float*)(lds + P_GC);
    LAS float* CW = (LAS float*)(lds + P_CW); LAS bf16_t* WST = (LAS bf16_t*)(lds + P_WST);
    const float* cw = A.in[I_GCW] + (size_t)l * 4 * 1536;
    {
        const int tw = wave & 3, kh = wave >> 2;
        const bf16_t* wg = (const bf16_t*)(A.ws + WS_WG8 + l * SZ_WG8) + (size_t)fr * DM + 8 * fq + 512 * kh;
        int tr = 16 * tw + fr; if (smp && tr >= 16) tr = 15;
        const bf16_t* xa = XB + (size_t)(row0 + tr) * DM + 8 * fq + 512 * kh;
        f32x4 acc = {0.f, 0.f, 0.f, 0.f};
#pragma unroll
        for (int ks = 0; ks < 16; ++ks) acc = MFMA16(*(const bf16x8*)(xa + 32 * ks), *(const bf16x8*)(wg + 32 * ks), acc);
#pragma unroll
        for (int e = 0; e < 4; ++e) GR[kh * 1024 + (16 * tw + 4 * fq + e) * 16 + fr] = acc[e];
    }
    prep_load_cw(cw, 0, CW, tid, NTHR);
    LBAR();
    if (tid < 256) {
        const int t = tid >> 2, h = tid & 3;
        int tr = t; if (smp && tr >= 16) tr = 15;
        const float rs = row_rstd(SSQ, row0 + tr);
        const float bt = sigmoidf_((GR[t * 16 + h] + GR[1024 + t * 16 + h]) * rs);
        const float a2 = (GR[t * 16 + 4 + h] + GR[1024 + t * 16 + 4 + h]) * rs + A.in[I_DTB][l * 4 + h];
        float g = -__expf(A.in[I_ALOG][l * 4 + h]) * softplusf_(a2);
        const bool pad = smp && t >= 16;
        BETA[h * 64 + t] = pad ? 0.f : bt; GC[h * 64 + t] = pad ? 0.f : g;
    } else if (smp || c == 63) {
        float* dst = smp ? A.out + O_SGC + (size_t)(l * BS + b) * 3 * 1536 : A.out + O_PGC + (size_t)(l * BP + b) * 3 * 1536;
        const int tl = smp ? 13 : 61;
        for (int e = tid - 256; e < 3 * 1536; e += 256) { const int j = e / 1536, col = e % 1536; dst[e] = bf2f(Z[(size_t)(row0 + tl + j) * NZ + col]); }
    }
    LBAR();
    if (wave < 4) {
        float v = GC[wave * 64 + lane];
#pragma unroll
        for (int o = 1; o < 64; o <<= 1) { const float up = __shfl_up(v, o); if (lane >= o) v += up; }
        GC[wave * 64 + lane] = v;
        if (lane == 63) EG[chbase + wave * chstep] = __expf(v);
    }
    LBAR();
    for (int h = 0; h < 4; ++h) {
        bf16_t* P = PREP + (size_t)(chbase + h * chstep) * PCH;
        if (h > 0) { bf16_t* Pp = PREP + (size_t)(chbase + (h - 1) * chstep) * PCH;
#pragma unroll
            for (int i = 0; i < 2; ++i) { const int v = tid + 512 * i, t = v >> 4, d8 = v & 15; *(u32x4*)(Pp + PW + ((((t >> 4) * 4 + (d8 >> 2)) * 64 + (d8 & 3) * 16 + (t & 15)) << 3)) = *(const LAS u32x4*)(WST + t * 136 + 8 * d8); } }
#pragma unroll 1
        for (int pass = 0; pass < 2; ++pass) {
            const int t = (tid >> 4) + 32 * pass, seg = tid & 15, cg = h * 128 + 8 * seg;
            const bool pad = smp && t >= 16;
            u32x4 zr[3][4];
#pragma unroll
            for (int x = 0; x < 3; ++x)
#pragma unroll
                for (int i = 0; i < 4; ++i) {
                    const int tt = t - 3 + i, col = x * 512 + cg;
                    if (tt >= 0 || (!smp && c > 0)) zr[x][i] = *(const u32x4*)(Z + (size_t)(row0 + tt) * NZ + col);
                    else if (smp) { const float* cp = A.in[I_CGC] + ((size_t)(l * BS + b) * 3 + (tt + 3)) * 1536 + col; float f[8];
                        const f32x4 q0 = *(const f32x4*)cp, q1 = *(const f32x4*)(cp + 4); f[0] = q0[0]; f[1] = q0[1]; f[2] = q0[2]; f[3] = q0[3]; f[4] = q1[0]; f[5] = q1[1]; f[6] = q1[2]; f[7] = q1[3]; zr[x][i] = pk8(f); }
                    else zr[x][i] = (u32x4){0u, 0u, 0u, 0u};
                }
            const float gct = GC[h * 64 + t], egt = __expf(gct), bt = BETA[h * 64 + t], ed = __expf(GC[h * 64 + 63] - gct);
#pragma unroll
            for (int x = 0; x < 3; ++x) {
                float acc[8];
#pragma unroll
                for (int j = 0; j < 8; ++j) acc[j] = 0.f;
#pragma unroll
                for (int i = 0; i < 4; ++i) {
                    float xv[8]; unpk8(zr[x][i], xv);
                    const f32x4 w0 = *(const LAS f32x4*)(CW + (i * 3 + x) * 128 + 8 * seg), w1 = *(const LAS f32x4*)(CW + (i * 3 + x) * 128 + 8 * seg + 4);
                    acc[0] += w0[0] * xv[0]; acc[1] += w0[1] * xv[1]; acc[2] += w0[2] * xv[2]; acc[3] += w0[3] * xv[3];
                    acc[4] += w1[0] * xv[4]; acc[5] += w1[1] * xv[5]; acc[6] += w1[2] * xv[6]; acc[7] += w1[3] * xv[7];
                }
                float ssum = 0.f;
#pragma unroll
                for (int j = 0; j < 8; ++j) { acc[j] = pad ? 0.f : siluf_(acc[j]); ssum += acc[j] * acc[j]; }
                ssum += __shfl_xor(ssum, 1); ssum += __shfl_xor(ssum, 2); ssum += __shfl_xor(ssum, 4); ssum += __shfl_xor(ssum, 8);
                const float rn = rsqrtf(ssum + EPS);
                if (x == 0) {
                    float qe[8];
#pragma unroll
                    for (int j = 0; j < 8; ++j) { acc[j] *= rn * 0.08838834764831845f; qe[j] = acc[j] * egt; }
                    *(LAS u32x4*)(Qsh + t * 136 + 8 * seg) = pk8(acc);
                    *(u32x4*)(P + PQE + ((((t >> 4) * 4 + (seg >> 2)) * 64 + (seg & 3) * 16 + (t & 15)) << 3)) = pk8(qe);
                } else if (x == 1) {
                    const float kb = bt * egt; float k1[8], k2[8];
#pragma unroll
                    for (int j = 0; j < 8; ++j) { acc[j] *= rn; k1[j] = acc[j] * kb; k2[j] = acc[j] * ed; }
                    *(LAS u32x4*)(Ksh + t * 136 + 8 * seg) = pk8(acc); *(LAS u32x4*)(KB + t * 136 + 8 * seg) = pk8(k1); *(LAS u32x4*)(KD + t * 136 + 8 * seg) = pk8(k2);
                } else {
#pragma unroll
                    for (int j = 0; j < 8; ++j) acc[j] *= bt;
                    *(LAS u32x4*)(VB + t * 136 + 8 * seg) = pk8(acc);
                }
            }
        }
        LBAR();
        {
#pragma unroll
            for (int i = 0; i < 2; ++i) { const int v = tid + 512 * i, d = v & 127, t8 = v >> 7; unsigned w[4];
#pragma unroll
                for (int j = 0; j < 4; ++j) w[j] = (unsigned)KD[(8 * t8 + 2 * j) * 136 + d] | ((unsigned)KD[(8 * t8 + 2 * j + 1) * 136 + d] << 16);
                *(u32x4*)(P + PKDT + ((((d >> 4) * 2 + (t8 >> 2)) * 64 + (t8 & 3) * 16 + (d & 15)) << 3)) = (u32x4){w[0], w[1], w[2], w[3]}; }
#pragma unroll
            for (int i = 0; i < 4; ++i) {
                const int id = wave + 8 * i, isqk = id >> 4, st = (id >> 2) & 3, tt = id & 3;
                f32x4 acc = {0.f, 0.f, 0.f, 0.f};
                if (st <= tt) {
                    const LAS bf16_t* ap = Ksh + (16 * st + fr) * 136 + 8 * fq;
                    const LAS bf16_t* bp = (isqk ? Qsh : Ksh) + (16 * tt + fr) * 136 + 8 * fq;
#pragma unroll
                    for (int ks = 0; ks < 4; ++ks) acc = MFMA16(*(const LAS bf16x8*)(ap + 32 * ks), *(const LAS bf16x8*)(bp + 32 * ks), acc);
                }
                const int t = 16 * tt + fr; const float gct = GC[h * 64 + t], bt = BETA[h * 64 + t];
                f32x4 o;
#pragma unroll
                for (int e = 0; e < 4; ++e) {
                    const int s = 16 * st + 4 * fq + e;
                    const float dec = __expf(fminf(gct - GC[h * 64 + s], 0.f));
                    if (isqk) o[e] = (s <= t) ? acc[e] * dec : 0.f;
                    else o[e] = (s < t) ? acc[e] * dec * bt : 0.f;
                }
                if (isqk) *(u32x2*)(P + PQK + (((tt * 2 + (st >> 1)) * 64 + (2 * (st & 1) + (fq >> 1)) * 16 + fr) << 3) + 4 * (fq & 1)) = pk4(o);
                else if (st == tt) *(LAS f32x4*)(LD + (st * 16 + fr) * 16 + 4 * fq) = o;
                else if (st < tt) *(LAS u32x2*)(LB + t * 72 + 16 * st + 4 * fq) = pk4(-o);
            }
        }
        LBAR();
        if (wave == 0) {
            const int blk = lane >> 4, cc = lane & 15;
            float x[16];
#pragma unroll
            for (int i = 0; i < 16; ++i) {
                float s = (i == cc) ? 1.f : 0.f;
                const LAS float* lr = LD + (blk * 16 + i) * 16;
#pragma unroll
                for (int j = 0; j < i; ++j) s -= lr[j] * x[j];
                x[i] = s;
            }
#pragma unroll
            for (int i = 0; i < 16; ++i) DI_[(blk * 16 + i) * 16 + cc] = f2bf(x[i]);
        } else if (h < 3) prep_load_cw(cw, h + 1, CW, tid - 64, 448);
        LBAR();
#pragma unroll
        for (int cti = 0; cti < 2; ++cti) {
            const int ct = 2 * wave + cti; const bool isw = ct >= 8; const int d = 16 * (ct & 7) + fr;
            const LAS bf16_t* rhs = (isw ? KB : VB) + d;
            bf16x4 Xb[4];
#pragma unroll
            for (int i = 0; i < 4; ++i) {
                f32x4 acc;
#pragma unroll
                for (int e = 0; e < 4; ++e) acc[e] = bf2f(rhs[(16 * i + 4 * fq + e) * 136]);
#pragma unroll
                for (int k = 0; k < i; ++k) acc = MFMA16K16(*(const LAS bf16x4*)(LB + (16 * i + fr) * 72 + 16 * k + 4 * fq), Xb[k], acc);
                const u32x2 ab = pk4(acc);
                const f32x4 xi = MFMA16K16(*(const LAS bf16x4*)(DI_ + (i * 16 + fr) * 16 + 4 * fq), __builtin_bit_cast(bf16x4, ab), ((f32x4){0.f, 0.f, 0.f, 0.f}));
                const u32x2 xb = pk4(xi); Xb[i] = __builtin_bit_cast(bf16x4, xb);
                if (!isw) *(u32x2*)(P + PUT + ((((ct & 7) * 4 + i) * 64 + fq * 16 + fr) << 2)) = xb;
                else {
                    WST[(16 * i + 4 * fq + 0) * 136 + d] = (bf16_t)(xb.x & 0xffffu); WST[(16 * i + 4 * fq + 1) * 136 + d] = (bf16_t)(xb.x >> 16);
                    WST[(16 * i + 4 * fq + 2) * 136 + d] = (bf16_t)(xb.y & 0xffffu); WST[(16 * i + 4 * fq + 3) * 136 + d] = (bf16_t)(xb.y >> 16);
                }
            }
        }
        LBAR();
    }
    { bf16_t* Pp = PREP + (size_t)(chbase + 3 * chstep) * PCH;
#pragma unroll
        for (int i = 0; i < 2; ++i) { const int v = tid + 512 * i, t = v >> 4, d8 = v & 15; *(u32x4*)(Pp + PW + ((((t >> 4) * 4 + (d8 >> 2)) * 64 + (d8 & 3) * 16 + (t & 15)) << 3)) = *(const LAS u32x4*)(WST + t * 136 + 8 * d8); } }
    LBAR();
}

constexpr int S_ST = 0, S_VN = 34816, S_NP = 53248;
struct ScanOps { bf16x8 Wf[4], QEf[4], QKf[2], KDf[2]; u32x2 Uf[4]; u32x2 gz[4]; float eg; };
DI void scan_load(ScanOps& o, const bf16_t* P, const bf16_t* Z, float egv, int row0, int h, int w, int tt, int dh, int fr, int fq, bool tok_ok) {
#pragma unroll
    for (int ks = 0; ks < 4; ++ks) { o.Wf[ks] = *(const bf16x8*)(P + PW + (((tt * 4 + ks) * 64 + fq * 16 + fr) << 3)); o.QEf[ks] = *(const bf16x8*)(P + PQE + (((tt * 4 + ks) * 64 + fq * 16 + fr) << 3)); }
#pragma unroll
    for (int ks = 0; ks < 2; ++ks) { o.QKf[ks] = *(const bf16x8*)(P + PQK + (((tt * 2 + ks) * 64 + fq * 16 + fr) << 3)); o.KDf[ks] = *(const bf16x8*)(P + PKDT + (((w * 2 + ks) * 64 + fq * 16 + fr) << 3)); }
#pragma unroll
    for (int j = 0; j < 4; ++j) o.Uf[j] = *(const u32x2*)(P + PUT + ((((4 * dh + j) * 4 + tt) * 64 + fq * 16 + fr) << 2));
    { int gr = row0 + 16 * tt + fr; gr = gr < MALL ? gr : MALL - 1;
#pragma unroll
        for (int j = 0; j < 4; ++j) o.gz[j] = *(const u32x2*)(Z + (size_t)gr * NZ + ZG + h * 128 + 16 * (4 * dh + j) + 4 * fq); }
    o.eg = egv;
}
template <bool SMP>
DI void scan_step(const ScanOps& o, f32x4 (&S)[8], LAS bf16_t* ST, LAS bf16_t* VN, LAS float* NP, bf16_t* Y, const f32x4 (&gn4)[4], int row0, int h, int w, int tt, int dh, int fr, int fq, bool tok_ok) {
    f32x4 accO[4];
#pragma unroll
    for (int j = 0; j < 4; ++j) {
        const int dt = 4 * dh + j;
        f32x4 accV = {0.f, 0.f, 0.f, 0.f}; accO[j] = (f32x4){0.f, 0.f, 0.f, 0.f};
#pragma unroll
        for (int ks = 0; ks < 4; ++ks) {
            const bf16x8 B = *(const LAS bf16x8*)(ST + (16 * dt + fr) * 136 + 32 * ks + 8 * fq);
            accV = MFMA16(o.Wf[ks], B, accV); accO[j] = MFMA16(B, o.QEf[ks], accO[j]);
        }
        const f32x4 vn = unpk4(o.Uf[j]) - accV;
        *(LAS u32x2*)(VN + (16 * dt + fr) * 72 + 16 * tt + 4 * fq) = pk4(vn);
    }
    LBAR();
#pragma unroll
    for (int j = 0; j < 4; ++j) {
        const int dt = 4 * dh + j;
#pragma unroll
        for (int ks = 0; ks < 2; ++ks) accO[j] = MFMA16(*(const LAS bf16x8*)(VN + (16 * dt + fr) * 72 + 32 * ks + 8 * fq), o.QKf[ks], accO[j]);
    }
    {
        float p = 0.f;
#pragma unroll
        for (int j = 0; j < 4; ++j) p += (accO[j][0] * accO[j][0] + accO[j][1] * accO[j][1]) + (accO[j][2] * accO[j][2] + accO[j][3] * accO[j][3]);
        p += __shfl_xor(p, 16); p += __shfl_xor(p, 32);
        if (fq == 0) NP[(16 * tt + fr) * 2 + dh] = p;
    }
#pragma unroll
    for (int dt = 0; dt < 8; ++dt) {
        S[dt] = S[dt] * o.eg;
#pragma unroll
        for (int ks = 0; ks < 2; ++ks) S[dt] = MFMA16(o.KDf[ks], *(const LAS bf16x8*)(VN + (16 * dt + fr) * 72 + 32 * ks + 8 * fq), S[dt]);
        *(LAS u32x2*)(ST + (16 * dt + fr) * 136 + 16 * w + 4 * fq) = pk4(S[dt]);
    }
    LBAR();
    if (!SMP || tok_ok) {
        const int t = 16 * tt + fr;
        const float rs = rsqrtf((NP[t * 2] + NP[t * 2 + 1]) * (1.0f / 128.0f) + EPS);
        bf16_t* yp = Y + (size_t)(row0 + t) * DM + h * 128 + 4 * fq;
#pragma unroll
        for (int j = 0; j < 4; ++j) {
            const f32x4 g4 = gn4[j]; const f32x4 z4 = unpk4(o.gz[j]);
            f32x4 v;
#pragma unroll
            for (int e = 0; e < 4; ++e) v[e] = accO[j][e] * rs * g4[e] * siluf_(z4[e]);
            *(u32x2*)(yp + 16 * (4 * dh + j)) = pk4(v);
        }
    }
}
DI void scan_item(const Args& A, LAS unsigned char* lds, int l, int item) {
    const int tid = otid(), lane = tid & 63, w = __builtin_amdgcn_readfirstlane(tid >> 6), fr = lane & 15, fq = lane >> 4, tt = w & 3, dh = w >> 2;
    const bool smp = item >= 64;
    const int b = smp ? ((item - 64) >> 2) : (item >> 2), h = item & 3, nsteps = smp ? 1 : 64;
    const bf16_t* Z = (const bf16_t*)(A.ws + WS_Z); bf16_t* Y = (bf16_t*)(A.ws + WS_Y);
    const bf16_t* PREP = (const bf16_t*)(A.ws + WS_PREP); const float* EG = (const float*)(A.ws + WS_EG);
    LAS bf16_t* ST = (LAS bf16_t*)(lds + S_ST); LAS bf16_t* VN = (LAS bf16_t*)(lds + S_VN); LAS float* NP = (LAS float*)(lds + S_NP);
    f32x4 gn4[4];
#pragma unroll
    for (int j = 0; j < 4; ++j) gn4[j] = *(const f32x4*)(A.in[I_GNG] + l * 128 + 16 * (4 * dh + j) + 4 * fq);
    const bool tok_ok = !smp || tt == 0;
    f32x4 S[8];
    if (smp) {
        const float* s0 = A.in[I_STATE] + (size_t)((l * BS + b) * 4 + h) * 128 * 128;
#pragma unroll
        for (int dt = 0; dt < 8; ++dt)
#pragma unroll
            for (int e = 0; e < 4; ++e) S[dt][e] = s0[(size_t)(16 * w + 4 * fq + e) * 128 + 16 * dt + fr];
    } else {
#pragma unroll
        for (int dt = 0; dt < 8; ++dt) S[dt] = (f32x4){0.f, 0.f, 0.f, 0.f};
    }
#pragma unroll
    for (int dt = 0; dt < 8; ++dt) *(LAS u32x2*)(ST + (16 * dt + fr) * 136 + 16 * w + 4 * fq) = pk4(S[dt]);
    const int ch0 = smp ? 4096 + 4 * b + h : (b * 4 + h) * 64;
    const int r00 = smp ? MP + 16 * b : b * TP;
    int zv = 0; asm volatile("" : "+v"(zv));
    const float* EGv = EG + zv;
    ScanOps oa, ob;
    if (smp) {
        scan_load(oa, PREP + (size_t)ch0 * PCH, Z, EGv[ch0], r00, h, w, tt, dh, fr, fq, tok_ok);
        __syncthreads();
        scan_step<true>(oa, S, ST, VN, NP, Y, gn4, r00, h, w, tt, dh, fr, fq, tok_ok);
    } else {
        scan_load(oa, PREP + (size_t)ch0 * PCH, Z, EGv[ch0], r00, h, w, tt, dh, fr, fq, true);
        __syncthreads();
#pragma unroll 1
        for (int c = 0; c < 64; c += 2) {
            scan_load(ob, PREP + (size_t)(ch0 + (c + 1)) * PCH, Z, EGv[ch0 + (c + 1)], r00 + 64 * (c + 1), h, w, tt, dh, fr, fq, true);
            scan_step<false>(oa, S, ST, VN, NP, Y, gn4, r00 + 64 * c, h, w, tt, dh, fr, fq, true);
            const int cn = c + 2 < 64 ? c + 2 : 63;
            scan_load(oa, PREP + (size_t)(ch0 + cn) * PCH, Z, EGv[ch0 + cn], r00 + 64 * cn, h, w, tt, dh, fr, fq, true);
            scan_step<false>(ob, S, ST, VN, NP, Y, gn4, r00 + 64 * (c + 1), h, w, tt, dh, fr, fq, true);
        }
    }
    float* so = (smp ? A.out + O_SGS + (size_t)((l * BS + b) * 4 + h) * 128 * 128 : A.out + O_PGS + (size_t)((l * BP + b) * 4 + h) * 128 * 128);
#pragma unroll
    for (int dt = 0; dt < 8; ++dt)
#pragma unroll
        for (int e = 0; e < 4; ++e) so[(size_t)(16 * w + 4 * fq + e) * 128 + 16 * dt + fr] = S[dt][e];
    __syncthreads();
}
constexpr float SB_CUT = 50.0f;
DI float neg_softplus(float z) {
    const float e = __builtin_amdgcn_exp2f(-fabsf(z) * 1.4426950408889634f);
    return -(fmaxf(z, 0.f) + __builtin_amdgcn_logf(1.0f + e) * 0.6931471805599453f);
}
template <bool SMP>
DI void sb_wave_unit(const Args& A, int l, int idx, int lane) {
    const int qi = lane & 31, hi = lane >> 5;
    const bf16_t* Z = (const bf16_t*)(A.ws + WS_Z); bf16_t* Y = (bf16_t*)(A.ws + WS_Y);
    int h, qrow, t0, b;
    bool qvalid = true;
    if (SMP) { b = idx >> 2; h = idx & 3; t0 = 0; qvalid = qi < TS; qrow = MP + TS * b + (qvalid ? qi : TS - 1); }
    else { h = idx & 3; const int qt = (idx >> 2) & 127; b = idx >> 9; t0 = 32 * qt; qrow = b * TP + t0 + qi; }
    bf16x8 Qf[4];
#pragma unroll
    for (int s = 0; s < 4; ++s) Qf[s] = *(const bf16x8*)(Z + (size_t)qrow * NZ + ZCQ + h * 64 + 16 * s + 8 * hi);
    f32x16 o0, o1;
#pragma unroll
    for (int r = 0; r < 16; ++r) { o0[r] = 0.f; o1[r] = 0.f; }
    float R = 0.f;
    const int nblk = SMP ? 1 + PAST / 32 : (t0 >> 5) + 1;
    const float* ck = SMP ? A.in[I_CSBK] + (size_t)(l * BS + b) * PAST * 256 + h * 64 : nullptr;
    const float* cv = SMP ? A.in[I_CSBV] + (size_t)(l * BS + b) * PAST * 256 + h * 64 : nullptr;
    for (int blk = 0; blk < nblk; ++blk) {
        const bool first = blk == 0;
        const bool from_z = !SMP || first;
        const int kbase = SMP ? (first ? 0 : PAST - 32 * blk) : t0 - 32 * blk;
        f32x16 acc;
#pragma unroll
        for (int r = 0; r < 16; ++r) acc[r] = 0.f;
        if (from_z) {
            int kr = kbase + qi; if (SMP && kr >= TS) kr = TS - 1;
            const bf16_t* kp = Z + (size_t)((SMP ? MP + TS * b : b * TP) + kr) * NZ + ZCK + h * 64 + 8 * hi;
#pragma unroll
            for (int s = 0; s < 4; ++s) acc = MFMA32(*(const bf16x8*)(kp + 16 * s), Qf[s], acc);
        } else {
            const float* kp = ck + (size_t)(kbase + qi) * 256 + 8 * hi;
#pragma unroll
            for (int s = 0; s < 4; ++s) { const f32x4 a = *(const f32x4*)(kp + 16 * s), c4 = *(const f32x4*)(kp + 16 * s + 4);
                u32x4 kf; kf.x = pk2(a[0], a[1]); kf.y = pk2(a[2], a[3]); kf.z = pk2(c4[0], c4[1]); kf.w = pk2(c4[2], c4[3]);
                acc = MFMA32(__builtin_bit_cast(bf16x8, kf), Qf[s], acc); }
        }
        float lb[16]; float gs[4];
#pragma unroll
        for (int r = 0; r < 16; ++r) {
            const int kl = (r & 3) + 8 * (r >> 2) + 4 * hi;
            const bool valid = first ? (SMP ? (kl < qi && kl < TS) : (kl < qi)) : true;
            acc[r] *= 0.125f;
            lb[r] = valid ? neg_softplus(acc[r]) : 0.f;
        }
#pragma unroll
        for (int g = 0; g < 4; ++g) gs[g] = (lb[4 * g] + lb[4 * g + 1]) + (lb[4 * g + 2] + lb[4 * g + 3]);
        float og[4];
#pragma unroll
        for (int g = 0; g < 4; ++g) og[g] = __shfl_xor(gs[g], 32);
        float off[4]; float run = 0.f;
#pragma unroll
        for (int g = 3; g >= 0; --g) {
            if (hi == 0) { run += og[g]; off[g] = run; run += gs[g]; }
            else { off[g] = run; run += gs[g] + og[g]; }
        }
        const float tot = (gs[0] + gs[1]) + (gs[2] + gs[3]) + (og[0] + og[1]) + (og[2] + og[3]);
        float p[16];
#pragma unroll
        for (int g = 0; g < 4; ++g) {
            float c = R + off[g];
#pragma unroll
            for (int e = 3; e >= 0; --e) {
                const int r = 4 * g + e; const int kl = (r & 3) + 8 * (r >> 2) + 4 * hi;
                const bool valid = first ? (SMP ? (kl < qi && kl < TS) : (kl < qi)) : true;
                p[r] = valid ? __builtin_amdgcn_exp2f((acc[r] + lb[r] + c) * 1.4426950408889634f) : 0.f;
                c += lb[r];
            }
        }
        R += tot;
#pragma unroll
        for (int s = 0; s < 2; ++s) {
            u32x4 pf; pf.x = pk2(p[8 * s], p[8 * s + 1]); pf.y = pk2(p[8 * s + 2], p[8 * s + 3]); pf.z = pk2(p[8 * s + 4], p[8 * s + 5]); pf.w = pk2(p[8 * s + 6], p[8 * s + 7]);
            const bf16x8 pb = __builtin_bit_cast(bf16x8, pf);
#pragma unroll
            for (int dt = 0; dt < 2; ++dt) {
                float vv[8];
#pragma unroll
                for (int j = 0; j < 8; ++j) {
                    const int kl = 16 * s + 8 * (j >> 2) + 4 * hi + (j & 3);
                    if (from_z) { int kr = kbase + kl; if (SMP && kr >= TS) kr = TS - 1;
                        vv[j] = bf2f(Z[(size_t)((SMP ? MP + TS * b : b * TP) + kr) * NZ + ZCV + h * 64 + 32 * dt + qi]); }
                    else vv[j] = cv[(size_t)(kbase + kl) * 256 + 32 * dt + qi];
                }
                const u32x4 vf = pk8(vv);
                if (dt == 0) o0 = MFMA32(__builtin_bit_cast(bf16x8, vf), pb, o0); else o1 = MFMA32(__builtin_bit_cast(bf16x8, vf), pb, o1);
            }
        }
        if (__all(R < -SB_CUT)) break;
    }
    float ss = 0.f;
#pragma unroll
    for (int r = 0; r < 16; ++r) ss += o0[r] * o0[r] + o1[r] * o1[r];
    ss += __shfl_xor(ss, 32);
    const float rs = rsqrtf(ss * (1.0f / 64.0f) + EPS);
    if (qvalid) {
        const float* g = A.in[I_SBG] + l * 256 + h * 64;
        bf16_t* yp = Y + (size_t)qrow * DM + 768 + h * 64;
#pragma unroll
        for (int dt = 0; dt < 2; ++dt)
#pragma unroll
            for (int g4 = 0; g4 < 4; ++g4) {
                const int d = 32 * dt + 8 * g4 + 4 * hi;
                const f32x4 gg = *(const f32x4*)(g + d);
                f32x4 v;
#pragma unroll
                for (int e = 0; e < 4; ++e) v[e] = (dt == 0 ? o0[4 * g4 + e] : o1[4 * g4 + e]) * rs * gg[e];
                *(u32x2*)(yp + d) = pk4(v);
            }
    }
}

DI void sc_task(const Args& A, int l, int task) {
    const int cgi = task & 31, seg = task >> 5, r0 = 16 * seg, c0 = 8 * cgi;
    const bf16_t* Z = (const bf16_t*)(A.ws + WS_Z); bf16_t* Y = (bf16_t*)(A.ws + WS_Y);
    const bool smp = r0 >= MP; const int t0 = smp ? 0 : (r0 & (TP - 1)), T = smp ? TS : TP, bb = smp ? (r0 - MP) / TS : r0 / TP;
    float w0[8], w1[8], w2[8], gn[8], p2[8], p1[8];
    const float* cw = A.in[I_SCW] + (size_t)l * 3 * 256 + c0;
#pragma unroll
    for (int j = 0; j < 8; ++j) { w0[j] = cw[j]; w1[j] = cw[256 + j]; w2[j] = cw[512 + j]; gn[j] = A.in[I_SCG][l * 256 + c0 + j]; }
    if (t0 == 0) {
        if (smp) { const float* cp = A.in[I_CSC] + (size_t)(l * BS + bb) * 2 * 256 + c0;
#pragma unroll
            for (int j = 0; j < 8; ++j) { p2[j] = cp[j]; p1[j] = cp[256 + j]; } }
        else {
#pragma unroll
            for (int j = 0; j < 8; ++j) { p2[j] = 0.f; p1[j] = 0.f; } }
    } else {
        float a[8], c[8];
        unpk8(*(const u32x4*)(Z + (size_t)(r0 - 2) * NZ + ZSC + c0), a); unpk8(*(const u32x4*)(Z + (size_t)(r0 - 2) * NZ + ZSX + c0), c);
#pragma unroll
        for (int j = 0; j < 8; ++j) p2[j] = a[j] * c[j];
        unpk8(*(const u32x4*)(Z + (size_t)(r0 - 1) * NZ + ZSC + c0), a); unpk8(*(const u32x4*)(Z + (size_t)(r0 - 1) * NZ + ZSX + c0), c);
#pragma unroll
        for (int j = 0; j < 8; ++j) p1[j] = a[j] * c[j];
    }
    for (int i = 0; i < 16; ++i) {
        const bf16_t* zr = Z + (size_t)(r0 + i) * NZ;
        float sb[8], sc[8], sx[8], y[8];
        unpk8(*(const u32x4*)(zr + ZSB + c0), sb); unpk8(*(const u32x4*)(zr + ZSC + c0), sc); unpk8(*(const u32x4*)(zr + ZSX + c0), sx);
        float ss = 0.f;
#pragma unroll
        for (int j = 0; j < 8; ++j) { const float xs = sc[j] * sx[j]; const float uu = w0[j] * p2[j] + w1[j] * p1[j] + w2[j] * xs; p2[j] = p1[j]; p1[j] = xs; y[j] = sb[j] * uu; ss += y[j] * y[j]; }
        ss += __shfl_xor(ss, 1); ss += __shfl_xor(ss, 2); ss += __shfl_xor(ss, 4);
        const float rs = rsqrtf(ss * (1.0f / 64.0f) + EPS);
#pragma unroll
        for (int j = 0; j < 8; ++j) y[j] *= rs * gn[j];
        *(u32x4*)(Y + (size_t)(r0 + i) * DM + 512 + c0) = pk8(y);
    }
    if (t0 + 16 == T) {
        float* dst = smp ? A.out + O_SSC + (size_t)(l * BS + bb) * 2 * 256 + c0 : A.out + O_PSC + (size_t)(l * BP + bb) * 2 * 256 + c0;
#pragma unroll
        for (int j = 0; j < 8; ++j) { dst[j] = p2[j]; dst[256 + j] = p1[j]; }
    }
}

constexpr int MA_K = 0, MA_VT = 69632;
DI void memattn_load_kv(const bf16_t* K, const bf16_t* VT, LAS unsigned char* lds, int tid) {
    LAS bf16_t* Ks = (LAS bf16_t*)(lds + MA_K); LAS bf16_t* Vs = (LAS bf16_t*)(lds + MA_VT);
#pragma unroll
    for (int i = 0; i < 8; ++i) { const int v = tid + 512 * i, n = v >> 4, d8 = v & 15; *(LAS u32x4*)(Ks + n * 136 + 8 * d8) = *(const u32x4*)(K + (size_t)n * 128 + 8 * d8); }
#pragma unroll
    for (int i = 0; i < 8; ++i) { const int v = tid + 512 * i, d = v >> 5, n8 = v & 31; *(LAS u32x4*)(Vs + d * 264 + 8 * n8) = *(const u32x4*)(VT + (size_t)d * 256 + 8 * n8); }
}
DI void memattn_wave(const bf16_t* QM, bf16_t* OM, int qrow, bool qvalid, int h, LAS unsigned char* lds, int lane) {
    const int ql = lane & 31, hi = lane >> 5;
    const LAS bf16_t* Ks = (const LAS bf16_t*)(lds + MA_K); const LAS bf16_t* Vs = (const LAS bf16_t*)(lds + MA_VT);
    bf16x8 Qf[8]; float ssq = 0.f;
#pragma unroll
    for (int s = 0; s < 8; ++s) { const u32x4 q = *(const u32x4*)(QM + (size_t)qrow * 512 + h * 128 + 16 * s + 8 * hi); Qf[s] = __builtin_bit_cast(bf16x8, q);
        float f[8]; unpk8(q, f);
#pragma unroll
        for (int j = 0; j < 8; ++j) ssq += f[j] * f[j]; }
    ssq += __shfl_xor(ssq, 32);
    const float sc2 = rsqrtf(ssq * (1.0f / 128.0f) + EPS) * 0.08838834764831845f * 1.4426950408889634f;
    float mx = -3.0e38f;
#pragma unroll 2
    for (int mt = 0; mt < 8; ++mt) {
        f32x16 s1;
#pragma unroll
        for (int r = 0; r < 16; ++r) s1[r] = 0.f;
#pragma unroll
        for (int s = 0; s < 8; ++s) s1 = MFMA32(*(const LAS bf16x8*)(Ks + (32 * mt + ql) * 136 + 16 * s + 8 * hi), Qf[s], s1);
#pragma unroll
        for (int r = 0; r < 16; ++r) mx = fmaxf(mx, s1[r]);
    }
    mx = fmaxf(mx, __shfl_xor(mx, 32));
    float sum = 0.f;
    f32x16 o[4];
#pragma unroll
    for (int dt = 0; dt < 4; ++dt)
#pragma unroll
        for (int r = 0; r < 16; ++r) o[dt][r] = 0.f;
#pragma unroll 1
    for (int mt = 0; mt < 8; ++mt) {
        f32x16 s1;
#pragma unroll
        for (int r = 0; r < 16; ++r) s1[r] = 0.f;
#pragma unroll
        for (int s = 0; s < 8; ++s) s1 = MFMA32(*(const LAS bf16x8*)(Ks + (32 * mt + ql) * 136 + 16 * s + 8 * hi), Qf[s], s1);
#pragma unroll
        for (int r = 0; r < 16; ++r) { s1[r] = __builtin_amdgcn_exp2f((s1[r] - mx) * sc2); sum += s1[r]; }
#pragma unroll
        for (int s = 0; s < 2; ++s) {
            u32x4 pf; pf.x = pk2(s1[8 * s], s1[8 * s + 1]); pf.y = pk2(s1[8 * s + 2], s1[8 * s + 3]); pf.z = pk2(s1[8 * s + 4], s1[8 * s + 5]); pf.w = pk2(s1[8 * s + 6], s1[8 * s + 7]);
            const bf16x8 pb = __builtin_bit_cast(bf16x8, pf);
#pragma unroll
            for (int dt = 0; dt < 4; ++dt) {
                const LAS bf16_t* vp = Vs + (32 * dt + ql) * 264 + 32 * mt + 16 * s + 4 * hi;
                u32x4 vf; const u32x2 a = *(const LAS u32x2*)vp, c = *(const LAS u32x2*)(vp + 8); vf.x = a.x; vf.y = a.y; vf.z = c.x; vf.w = c.y;
                o[dt] = MFMA32(__builtin_bit_cast(bf16x8, vf), pb, o[dt]);
            }
        }
    }
    sum += __shfl_xor(sum, 32);
    const float inv = 1.0f / sum;
    if (qvalid) {
        bf16_t* op = OM + (size_t)qrow * 512 + h * 128;
#pragma unroll
        for (int dt = 0; dt < 4; ++dt)
#pragma unroll
            for (int g4 = 0; g4 < 4; ++g4) {
                f32x4 v;
#pragma unroll
                for (int e = 0; e < 4; ++e) v[e] = o[dt][4 * g4 + e] * inv;
                *(u32x2*)(op + 32 * dt + 8 * g4 + 4 * hi) = pk4(v);
            }
    }
}
DI void phase_memattn(const Args& A, LAS unsigned char* lds, int l) {
    const int tid = otid(), lane = tid & 63, wave = tid >> 6, G = gridDim.x;
    const bf16_t* QM = (const bf16_t*)(A.ws + WS_QM); bf16_t* OM = (bf16_t*)(A.ws + WS_OM);
    for (int u = blockIdx.x; u < BS * 4; u += G) {
        const int sb = u >> 2, h = u & 3;
        __syncthreads();
        memattn_load_kv((const bf16_t*)(A.ws + WS_SMK) + (size_t)((l * BS + sb) * 4 + h) * 256 * 128, (const bf16_t*)(A.ws + WS_SMVT) + (size_t)((l * BS + sb) * 4 + h) * 128 * 256, lds, tid);
        __syncthreads();
        if (wave == 0) { const int ql = lane & 31; const bool ok = ql < TS; memattn_wave(QM, OM, MP + TS * sb + (ok ? ql : TS - 1), ok, h, lds, lane); }
    }
    const int NU = BP * 4 * 16, per = (NU + G - 1) / G;
    int cur = -1;
    for (int u = blockIdx.x * per; u < NU && u < (blockIdx.x + 1) * per; ++u) {
        const int qt = u & 15, bh = u >> 4, b = bh >> 2, h = bh & 3;
        if (bh != cur) {
            __syncthreads();
            memattn_load_kv((const bf16_t*)(A.ws + WS_MK) + (size_t)((l * BP + b) * 4 + h) * 256 * 128, (const bf16_t*)(A.ws + WS_MVT) + (size_t)((l * BP + b) * 4 + h) * 128 * 256, lds, tid);
            __syncthreads();
            cur = bh;
        }
        memattn_wave(QM, OM, b * TP + 256 * qt + 32 * wave + (lane & 31), true, h, lds, lane);
    }
    __syncthreads();
}

DI void act_task(const Args& A, int l, int task) {
    const int cgi = task % 352, seg = task / 352, r0 = 16 * seg, c0 = 8 * cgi;
    const bf16_t* GU = (const bf16_t*)(A.ws + WS_GU); bf16_t* ACT = (bf16_t*)(A.ws + WS_ACT);
    const bool smp = r0 >= MP; const int t0 = smp ? 0 : (r0 & (TP - 1)), T = smp ? TS : TP, bb = smp ? (r0 - MP) / TS : r0 / TP;
    float w0[8], w1[8], w2[8], p2[8], p1[8];
    const float* cw = A.in[I_FCW] + (size_t)l * 3 * DFF + c0;
#pragma unroll
    for (int j = 0; j < 8; ++j) { w0[j] = cw[j]; w1[j] = cw[DFF + j]; w2[j] = cw[2 * DFF + j]; }
    if (t0 == 0) {
        if (smp) { const float* cp = A.in[I_CFC] + (size_t)(l * BS + bb) * 2 * DFF + c0;
#pragma unroll
            for (int j = 0; j < 8; ++j) { p2[j] = cp[j]; p1[j] = cp[DFF + j]; } }
        else {
#pragma unroll
            for (int j = 0; j < 8; ++j) { p2[j] = 0.f; p1[j] = 0.f; } }
    } else { unpk8(*(const u32x4*)(GU + (size_t)(r0 - 2) * NGU + c0), p2); unpk8(*(const u32x4*)(GU + (size_t)(r0 - 1) * NGU + c0), p1); }
#pragma unroll 4
    for (int i = 0; i < 16; ++i) {
        const bf16_t* gr = GU + (size_t)(r0 + i) * NGU + c0;
        float g[8], up[8], y[8];
        unpk8(*(const u32x4*)gr, g); unpk8(*(const u32x4*)(gr + DFF), up);
#pragma unroll
        for (int j = 0; j < 8; ++j) { const float gt = w0[j] * p2[j] + w1[j] * p1[j] + w2[j] * g[j]; p2[j] = p1[j]; p1[j] = g[j]; y[j] = siluf_(gt) * up[j]; }
        *(u32x4*)(ACT + (size_t)(r0 + i) * DFF + c0) = pk8(y);
    }
    if (t0 + 16 == T) {
        float* dst = smp ? A.out + O_SFC + (size_t)(l * BS + bb) * 2 * DFF + c0 : A.out + O_PFC + (size_t)(l * BP + bb) * 2 * DFF + c0;
#pragma unroll
        for (int j = 0; j < 8; ++j) { dst[j] = p2[j]; dst[DFF + j] = p1[j]; }
    }
}
#ifndef MK_ONE_LAUNCH
#define MK_ONE_LAUNCH 1
#endif
constexpr int NPH = 3 + 9 * NL;
#ifndef PHMASK
#define PHMASK 0xFFFF
#endif
#define PHX(k) (((PHMASK) >> (k)) & 1)
#ifndef DUP_KIND
#define DUP_KIND -1
#endif
#define REPS(k) ((DUP_KIND == (k)) ? 2 : 1)
__global__ void __launch_bounds__(NTHR, 2) hse_fwd(Args A) {
    extern __shared__ __attribute__((aligned(16))) unsigned char smem[];
    LAS unsigned char* lds = (LAS unsigned char*)smem;
    volatile LAS unsigned* MISC = (volatile LAS unsigned*)(lds + MISC_OFF);
    const int tid0 = threadIdx.x, G = gridDim.x;
    for (int u = tid0; u < (LDS_BYTES - MISC_OFF) / 4; u += NTHR) ((LAS unsigned*)(lds + MISC_OFF))[u] = 0u;
    __syncthreads();
    unsigned* ctl = (unsigned*)(A.ws + WS_CTL);
    XcdBarrier bar; bar.bar = ctl + CW_BAR; bar.x = 0; bar.st = nullptr;
    const int lo = A.ph_lo, hi = A.ph_hi;
    if (hi - lo > 1) bar = xcd_barrier_post(ctl + CW_BAR, MISC + 8);
#define IN(k) (lo <= (k) && (k) < hi)
#define SEAM(k) do { if (IN(k) && IN((k) + 1)) xcd_barrier(bar); } while (0)
    unsigned char* ws = A.ws;
    bf16_t* XB = (bf16_t*)(ws + WS_XB); u64_t* SSQ0 = (u64_t*)(ws + WS_SSQ);

    if (PHX(0) && IN(0)) { for (int rep = 0; rep < REPS(0); ++rep) { phase_convert(A, lds); __syncthreads(); } }
    SEAM(0);
    if (PHX(1) && IN(1)) { for (int rep = 0; rep < REPS(1); ++rep) {
        pg8::Gemm g{(const bf16_t*)(ws + WS_MEMB), (const bf16_t*)(ws + WS_WMKV), 4096, 4096, DM}; pg8::StaticOrder S; S.init(4096, 4096, ogrid(), obid());
        EpiScaleF32 E{(float*)(ws + WS_RAWKV), 4096, (const float*)(ws + WS_SSQM)};
        pg8::gemm_phase<EpiScaleF32, pg8::StaticOrder, true, true>(lds, g, S, E);
        __syncthreads(); } }
    SEAM(1);
    if (PHX(2) && IN(2)) { for (int rep = 0; rep < REPS(2); ++rep) { phase_memkv_post(A, lds); __syncthreads(); } }
    SEAM(2);

    for (int l = 0; l < NL; ++l) {
        const int pb = 3 + 9 * l;
        u64_t* SSQ = SSQ0 + (size_t)(3 * l) * MALL;
        if (PHX(3) && IN(pb + 0)) { for (int rep = 0; rep < REPS(3); ++rep) {
            pg8::Gemm g{XB, (const bf16_t*)(ws + WS_WIN + l * SZ_WIN), MALL, NZ, DM}; pg8::StaticOrder S; S.init(MALL, NZ, ogrid(), obid());
            EpiScaleBf16 E{(bf16_t*)(ws + WS_Z), NZ, SSQ, 12, 13, A.out + O_PSK + (size_t)l * MP * 256, A.out + O_SSK + (size_t)l * MS * 256, A.out + O_PSV + (size_t)l * MP * 256, A.out + O_SSV + (size_t)l * MS * 256};
            pg8::gemm_phase<EpiScaleBf16, pg8::StaticOrder, true, true>(lds, g, S, E);
            __syncthreads(); } }
        SEAM(pb + 0);
        if (PHX(4) && IN(pb + 1)) { for (int rep = 0; rep < REPS(4); ++rep) {
            unsigned* cnt = ctl + 2048 + 64 * l;
            for (;;) {
                if (threadIdx.x == 0) MISC[12] = atomicAdd(cnt, 1u);
                __syncthreads();
                const int u = (int)MISC[12];
                __syncthreads();
                if (u >= 1024) break;
                prep_unit(A, lds, l, 1023 - u);
            }
            __syncthreads(); } }
        SEAM(pb + 1);
        if (PHX(5) && IN(pb + 2)) { for (int rep = 0; rep < REPS(5); ++rep) {
            for (int r2 = 0; r2 < REPS(14); ++r2) for (int it = blockIdx.x; it < 64 + BS; it += G) {
                if (it < 64) scan_item(A, lds, l, it);
                else { prep_unit(A, lds, l, 1024 + (it - 64)); __threadfence_block(); VM_WAIT(); __syncthreads();
                       for (int hh = 0; hh < 4; ++hh) scan_item(A, lds, l, 64 + 4 * (it - 64) + hh); }
            }
            const int nhead = G > 128 ? 64 : 0;
            if ((int)blockIdx.x >= nhead) {
                const int tid = otid(), lane = tid & 63, wave = __builtin_amdgcn_readfirstlane(tid >> 6);
                const int wb = blockIdx.x - nhead, NWB = G - nhead;
                for (int r2 = 0; r2 < REPS(13); ++r2) {
                for (int i = wb * NWAVES + wave; i < BS * 4; i += NWB * NWAVES) sb_wave_unit<true>(A, l, i, lane);
                for (int i = wb * NWAVES + wave; i < BP * 128 * 4; i += NWB * NWAVES) sb_wave_unit<false>(A, l, i, lane);
                for (int t = wb * NTHR + tid; t < (MALL / 16) * 32; t += NWB * NTHR) sc_task(A, l, t);
                }
            }
            __syncthreads(); } }
        SEAM(pb + 2);
        if (PHX(6) && IN(pb + 3)) { for (int rep = 0; rep < REPS(6); ++rep) {
            pg8::Gemm g{(const bf16_t*)(ws + WS_Y), (const bf16_t*)(ws + WS_WMIX + l * SZ_WMIX), MALL, DM, DM}; pg8::StaticOrder S; S.init(MALL, DM, ogrid(), obid());
            EpiResid E{A.out, XB, SSQ + MALL, 0};
            pg8::gemm_phase<EpiResid, pg8::StaticOrder, true, true>(lds, g, S, E);
            __syncthreads(); } }
        SEAM(pb + 3);
        if (PHX(7) && IN(pb + 4)) { for (int rep = 0; rep < REPS(7); ++rep) {
            pg8::Gemm g{XB, (const bf16_t*)(ws + WS_WMQ + l * SZ_WMQ), MALL, 512, DM}; pg8::StaticOrder S; S.init(MALL, 512, ogrid(), obid());
            EpiScaleBf16 E{(bf16_t*)(ws + WS_QM), 512, SSQ + MALL, -1, -1, nullptr, nullptr, nullptr, nullptr};
            pg8::gemm_phase<EpiScaleBf16, pg8::StaticOrder, true, true>(lds, g, S, E);
            __syncthreads(); } }
        SEAM(pb + 4);
        if (PHX(8) && IN(pb + 5)) { for (int rep = 0; rep < REPS(8); ++rep) { phase_memattn(A, lds, l); __syncthreads(); } }
        SEAM(pb + 5);
        if (PHX(9) && IN(pb + 6)) { for (int rep = 0; rep < REPS(9); ++rep) {
            pg8::Gemm g{(const bf16_t*)(ws + WS_OM), (const bf16_t*)(ws + WS_WMO + l * SZ_WMO), MALL, DM, 512}; pg8::StaticOrder S; S.init(MALL, DM, ogrid(), obid());
            EpiResid E{A.out, XB, SSQ + 2 * MALL, 0};
            pg8::gemm_phase<EpiResid, pg8::StaticOrder, true, true>(lds, g, S, E);
            __syncthreads(); } }
        SEAM(pb + 6);
        if (PHX(10) && IN(pb + 7)) {
            pg8::Gemm g{XB, (const bf16_t*)(ws + WS_WGU + l * SZ_WGU), MALL, NGU, DM}; pg8::StaticOrder S; S.init_tiles((MALL + 247) / 248, NGU / 256, ogrid(), obid());
            EpiAct E{(bf16_t*)(ws + WS_ACT), SSQ + 2 * MALL, A.in[I_FCW] + (size_t)l * 3 * DFF, A.in[I_CFC] + (size_t)l * BS * 2 * DFF, A.out + O_PFC + (size_t)l * BP * 2 * DFF, A.out + O_SFC + (size_t)l * BS * 2 * DFF};
            pg8::gemm_phase<EpiAct, pg8::StaticOrder, true, true>(lds, g, S, E);
        }
        SEAM(pb + 7);
        if (PHX(12) && IN(pb + 8)) { for (int rep = 0; rep < REPS(12); ++rep) {
            pg8::Gemm g{(const bf16_t*)(ws + WS_ACT), (const bf16_t*)(ws + WS_WDN + l * SZ_WDN), MALL, DM, DFF}; pg8::StaticOrder S; S.init(MALL, DM, ogrid(), obid()); S.rev = 1;
            EpiResid E{A.out, XB, SSQ + 3 * (size_t)MALL, l == NL - 1 ? 1 : 0};
            pg8::gemm_phase<EpiResid, pg8::StaticOrder, true, true>(lds, g, S, E);
            __syncthreads(); } }
        if (l + 1 < NL) SEAM(pb + 8);
    }
#undef IN
#undef SEAM
}

extern "C" void kernel_launch(void* const* d_in, const int* in_sizes, int n_in, void* d_out, int out_size, void* d_ws, size_t ws_size, hipStream_t stream) {
    static int grid = 0;
    if (grid == 0) {
        if (n_in != 34 || (size_t)out_size != O_END || ws_size < WS_END) { fprintf(stderr, "kernel_launch: unexpected problem (n_in %d, out %d, ws %zu; need 34, %zu, >= %zu); nothing launched\n", n_in, out_size, ws_size, (size_t)O_END, (size_t)WS_END); grid = -1; return; }
        int dev = 0, cus = 0, per_cu = 0;
        if (hipGetDevice(&dev) != hipSuccess || hipDeviceGetAttribute(&cus, hipDeviceAttributeMultiprocessorCount, dev) != hipSuccess) { grid = -1; return; }
        if (hipFuncSetAttribute((const void*)hse_fwd, hipFuncAttributeMaxDynamicSharedMemorySize, LDS_BYTES) != hipSuccess) { fprintf(stderr, "kernel_launch: hipFuncSetAttribute failed\n"); grid = -1; return; }
        if (hipOccupancyMaxActiveBlocksPerMultiprocessor(&per_cu, (const void*)hse_fwd, NTHR, LDS_BYTES) != hipSuccess || per_cu < 1) { fprintf(stderr, "kernel_launch: occupancy query reports %d blocks per CU\n", per_cu); }
        (void)hipGetLastError();
        grid = cus;
    }
    if (grid < 0) return;
    (void)hipMemsetAsync((char*)d_ws + WS_CTL, 0, CTL_BYTES, stream);
    (void)hipMemsetAsync((char*)d_ws + WS_SSQ, 0, (size_t)(3 * NL + 1) * MALL * 8, stream);
    Args a{};
    for (int i = 0; i < 34; ++i) a.in[i] = (const float*)d_in[i];
    a.out = (float*)d_out; a.ws = (unsigned char*)d_ws;
#if MK_ONE_LAUNCH
    a.ph_lo = 0; a.ph_hi = NPH;
    hipLaunchKernelGGL(hse_fwd, dim3(grid), dim3(NTHR), LDS_BYTES, stream, a);
#else
    for (int p = 0; p < NPH; ++p) { a.ph_lo = p; a.ph_hi = p + 1; hipLaunchKernelGGL(hse_fwd, dim3(grid), dim3(NTHR), LDS_BYTES, stream, a); }
#endif
    const hipError_t le = hipPeekAtLastError();
    if (le != hipSuccess) fprintf(stderr, "kernel_launch: launch failed: %s\n", hipGetErrorName(le));
}
```

```cpp
#include <hip/hip_runtime.h>
#include <cstdio>
#include <cstdint>

#define DI __device__ __forceinline__
#define GAS __attribute__((address_space(1)))
#define LAS __attribute__((address_space(3)))

typedef unsigned short bf16_t;
typedef short bf16x8 __attribute__((ext_vector_type(8)));
typedef short bf16x4 __attribute__((ext_vector_type(4)));
typedef float f32x4 __attribute__((ext_vector_type(4)));
typedef float f32x2 __attribute__((ext_vector_type(2)));
typedef float f32x16 __attribute__((ext_vector_type(16)));
typedef unsigned u32x4 __attribute__((ext_vector_type(4)));
typedef unsigned u32x2 __attribute__((ext_vector_type(2)));
typedef __bf16 bf16x2_t __attribute__((ext_vector_type(2)));

constexpr int DM = 1024, BP = 16, TP = 4096, NL = 4, BS = 32, TS = 16, PAST = 4096, NMEM = 256;
constexpr int MP = BP * TP, MS = BS * TS, MALL = MP + MS;
constexpr int NZ = 3584;
constexpr int ZQ = 0, ZK = 512, ZV = 1024, ZG = 1536, ZSB = 2048, ZSC = 2304, ZSX = 2560, ZCQ = 2816, ZCK = 3072, ZCV = 3328;
constexpr int DFF = 2816, NGU = 2 * DFF;
constexpr int DIN = 3592;
constexpr float EPS = 1e-6f;
constexpr int NCH = BP * 64 * 4 + BS * 4;
constexpr int PCH = 36864;
constexpr int PW = 0, PQE = 8192, PUT = 16384, PKDT = 24576, PQK = 32768;

constexpr size_t O_YP = 0, O_YS = O_YP + (size_t)MP * DM, O_PGS = O_YS + (size_t)MS * DM, O_PGC = O_PGS + (size_t)NL * BP * 4 * 128 * 128,
    O_PSC = O_PGC + (size_t)NL * BP * 3 * 1536, O_PSK = O_PSC + (size_t)NL * BP * 2 * 256, O_PSV = O_PSK + (size_t)NL * MP * 256, O_PMK = O_PSV + (size_t)NL * MP * 256,
    O_PMV = O_PMK + (size_t)NL * BP * NMEM * 512, O_PFC = O_PMV + (size_t)NL * BP * NMEM * 512, O_SGS = O_PFC + (size_t)NL * BP * 2 * DFF,
    O_SGC = O_SGS + (size_t)NL * BS * 4 * 128 * 128, O_SSC = O_SGC + (size_t)NL * BS * 3 * 1536, O_SSK = O_SSC + (size_t)NL * BS * 2 * 256,
    O_SSV = O_SSK + (size_t)NL * MS * 256, O_SFC = O_SSV + (size_t)NL * MS * 256, O_END = O_SFC + (size_t)NL * BS * 2 * DFF;
static_assert(O_END == 234323968ull, "output size");

constexpr size_t al256(size_t x) { return (x + 255) & ~(size_t)255; }
constexpr size_t WS_CTL = 0, CTL_BYTES = 1u << 20;
constexpr size_t SZ_WIN = (size_t)NZ * DM * 2, SZ_WG8 = 16 * DM * 2, SZ_WMIX = (size_t)DM * DM * 2, SZ_WMQ = 512 * DM * 2, SZ_WMO = (size_t)DM * 512 * 2,
    SZ_WGU = (size_t)NGU * DM * 2, SZ_WDN = (size_t)DM * DFF * 2;
constexpr size_t WS_WIN = WS_CTL + CTL_BYTES, WS_WG8 = WS_WIN + NL * SZ_WIN, WS_WMIX = WS_WG8 + NL * SZ_WG8, WS_WMQ = WS_WMIX + NL * SZ_WMIX, WS_WMO = WS_WMQ + NL * SZ_WMQ,
    WS_WGU = WS_WMO + NL * SZ_WMO, WS_WDN = WS_WGU + NL * SZ_WGU, WS_WMKV = WS_WDN + NL * SZ_WDN;
constexpr size_t WS_XB = WS_WMKV + (size_t)4096 * DM * 2;
constexpr size_t WS_SSQ = WS_XB + (size_t)(MALL + 256) * DM * 2;
constexpr size_t WS_MEMB = WS_SSQ + (size_t)MALL * 16 * 8;
constexpr size_t WS_SSQM = WS_MEMB + (size_t)4096 * DM * 2;
constexpr size_t WS_RAWKV = WS_SSQM + 4096 * 4;
constexpr size_t WS_MK = WS_RAWKV + (size_t)4096 * 4096 * 4;
constexpr size_t WS_MVT = WS_MK + (size_t)NL * BP * 4 * 256 * 128 * 2;
constexpr size_t WS_SMK = WS_MVT + (size_t)NL * BP * 4 * 256 * 128 * 2;
constexpr size_t WS_SMVT = WS_SMK + (size_t)NL * BS * 4 * 256 * 128 * 2;
constexpr size_t WS_Z = WS_SMVT + (size_t)NL * BS * 4 * 256 * 128 * 2;
constexpr size_t WS_PREP = WS_Z + (size_t)MALL * NZ * 2;
constexpr size_t WS_GU = WS_Z;
constexpr size_t WS_EG = WS_PREP + (size_t)NCH * PCH * 2;
constexpr size_t WS_Y = al256(WS_EG + (size_t)NCH * 4);
constexpr size_t WS_QM = WS_Y + (size_t)MALL * DM * 2;
constexpr size_t WS_OM = WS_QM + (size_t)MALL * 512 * 2;
constexpr size_t WS_ACT = WS_OM + (size_t)MALL * 512 * 2;
constexpr size_t WS_END = WS_ACT + (size_t)MALL * DFF * 2;
static_assert(WS_GU + (size_t)MALL * NGU * 2 <= WS_EG, "GU overlay fits in Z | PREP");
static_assert(WS_END <= 2147483648ull, "workspace map exceeds the guaranteed 2 GiB");

constexpr int LDS_BYTES = 147456;
constexpr int MISC_OFF = 139264;
constexpr int NWAVES = 8, NTHR = 512;

DI unsigned pk2(float lo, float hi) { f32x2 v = {lo, hi}; bf16x2_t b = __builtin_convertvector(v, bf16x2_t); return __builtin_bit_cast(unsigned, b); }
DI float bflo(unsigned u) { return __uint_as_float(u << 16); }
DI float bfhi(unsigned u) { return __uint_as_float(u & 0xffff0000u); }
DI float bf2f(bf16_t u) { return __uint_as_float((unsigned)u << 16); }
DI bf16_t f2bf(float f) { return (bf16_t)(pk2(f, 0.f) & 0xffffu); }
DI u32x4 pk8(const float* v) { u32x4 r; r.x = pk2(v[0], v[1]); r.y = pk2(v[2], v[3]); r.z = pk2(v[4], v[5]); r.w = pk2(v[6], v[7]); return r; }
DI void unpk8(u32x4 r, float* v) { v[0] = bflo(r.x); v[1] = bfhi(r.x); v[2] = bflo(r.y); v[3] = bfhi(r.y); v[4] = bflo(r.z); v[5] = bfhi(r.z); v[6] = bflo(r.w); v[7] = bfhi(r.w); }
DI u32x2 pk4(f32x4 v) { u32x2 r; r.x = pk2(v[0], v[1]); r.y = pk2(v[2], v[3]); return r; }
DI f32x4 unpk4(u32x2 r) { f32x4 v; v[0] = bflo(r.x); v[1] = bfhi(r.x); v[2] = bflo(r.y); v[3] = bfhi(r.y); return v; }
DI float wave_sum(float v) {
#pragma unroll
    for (int o = 1; o < 64; o <<= 1) v += __shfl_xor(v, o);
    return v;
}
DI float fexp(float x) { return __builtin_amdgcn_exp2f(x * 1.4426950408889634f); }
DI float flog(float x) { return __builtin_amdgcn_logf(x) * 0.6931471805599453f; }
DI float sigmoidf_(float x) { return __builtin_amdgcn_rcpf(1.0f + __builtin_amdgcn_exp2f(-1.4426950408889634f * x)); }
DI float siluf_(float x) { return x * __builtin_amdgcn_rcpf(1.0f + __builtin_amdgcn_exp2f(-1.4426950408889634f * x)); }
DI float softplusf_(float x) { return fmaxf(x, 0.f) + log1pf(__expf(-fabsf(x))); }
#define MFMA16(a, b, c) __builtin_amdgcn_mfma_f32_16x16x32_bf16((a), (b), (c), 0, 0, 0)
#define MFMA16K16(a, b, c) __builtin_amdgcn_mfma_f32_16x16x16bf16_1k((a), (b), (c), 0, 0, 0)
#define MFMA32(a, b, c) __builtin_amdgcn_mfma_f32_32x32x16_bf16((a), (b), (c), 0, 0, 0)
#define LDS_WAIT() asm volatile("s_waitcnt lgkmcnt(0)" ::: "memory")
#define VM_WAIT() asm volatile("s_waitcnt vmcnt(0)" ::: "memory")
DI int otid() { int t = threadIdx.x; asm volatile("" : "+v"(t)); return t; }
DI int obid() { int b = blockIdx.x; asm volatile("" : "+s"(b)); return b; }
DI int ogrid() { int g = gridDim.x; asm volatile("" : "+s"(g)); return g; }
#define LBAR() do { asm volatile("s_waitcnt lgkmcnt(0)" ::: "memory"); __builtin_amdgcn_s_barrier(); asm volatile("" ::: "memory"); } while (0)
#define MK_ONE_LAUNCH 1
namespace pg8 {
#define PG8_LAS __attribute__((address_space(3)))
constexpr int BM = 256, BK = 64, HALF = 128, HTB = HALF * BK * 2  , STAGE_BYTES = 8 * HTB, NXCD = 8, WGM = 4;
__host__ __device__ __forceinline__ int lds_byte(int r, int c) { const int st = (r >> 4) * 2 + (c >> 5), rr = r & 15, cc = c & 31, ob = rr * 64 + cc * 2; return st * 1024 + (ob ^ (((ob >> 9) & 1) << 5)); }
__host__ __device__ __forceinline__ void stage_rc(int b, int& R, int& C) { const int st = b / 1024, sb = b % 1024, swz = sb ^ (((sb >> 9) & 1) << 5); R = (st >> 1) * 16 + swz / 64; C = (st & 1) * 32 + (swz % 64) / 2; }
__host__ __device__ __forceinline__ int perm32(int rho) { const int n = rho >> 4, i = rho & 15; return 8 * (i >> 2) + 4 * n + (i & 3); }

struct Unit { int pm, pn; };
struct Gemm { const bf16_t* A; const bf16_t* Bt; int M, N, K; };

struct StaticOrder {
    int nM, nN, nwg, G, c;
    __host__ __device__ void init(int M, int N, int G_, int c_) { nM = M / BM; nN = N / BM; nwg = nM * nN; G = G_; c = c_; }
    __host__ __device__ void init_tiles(int nM_, int nN_, int G_, int c_) { nM = nM_; nN = nN_; nwg = nM * nN; G = G_; c = c_; }
    __host__ __device__ bool next(int i, Unit& u) const {
        const long L = (long)i * G + c; if (L >= nwg) return false;
        int wgid = (int)L; { const int q = nwg / NXCD, r = nwg % NXCD, xcd = wgid % NXCD, off = wgid / NXCD; wgid = (xcd < r ? xcd * (q + 1) : r * (q + 1) + (xcd - r) * q) + off; }
        const int nig = WGM * nN, gid = wgid / nig, fm = gid * WGM, gsz = (nM - fm) < WGM ? (nM - fm) : WGM;
        u.pm = fm + ((wgid % nig) % gsz); u.pn = (wgid % nig) / gsz; return true;
    }
    __device__ __forceinline__ void a_ready(const Unit&) const {}
    __device__ __forceinline__ void done(const Unit&) const {}
};
template <class Epi, class Sched, bool ALIGN_EPI = false, bool SP2 = false>
__device__ __forceinline__ void gemm_phase(PG8_LAS unsigned char* lds, const Gemm g, const Sched& S, const Epi& E) {
    const int tid = otid(), wid = __builtin_amdgcn_readfirstlane(tid >> 6), lane = tid & 63, wr = wid >> 2, wc = wid & 3, fr = lane & 15, fq = lane >> 4;
    const int K = g.K, nt = K / BK;
    int voffA[2], voffB[2];
#pragma unroll
    for (int i = 0; i < 2; ++i) { int R, C; stage_rc(tid * 16 + i * 8192, R, C); const int Rb = Epi::PERM ? ((R & ~31) + perm32(R & 31)) : R;
        const int Ra = Epi::ROWMAP ? (62 * (R >> 6) - 2 + (R & 63)) : R;
        voffA[i] = (Ra * K + C) * 2; voffB[i] = (Rb * K + C) * 2; }
    const size_t kstep = (size_t)(BK * 2);
    const size_t hstep = (size_t)HALF * K * 2;
    const size_t tstep = 2 * hstep;
    const size_t hstepA = Epi::ROWMAP ? (size_t)124 * K * 2 : hstep, tstepA = 2 * hstepA;
    const unsigned ldsw = (unsigned)wid * 1024u;
    const int aoff = lds_byte(wr * 64 + fr, fq * 8), boff = lds_byte(wc * 32 + fr, fq * 8);
#define PG8_SA(b, h) (((b) * 2 + (h)) * HTB)
#define PG8_SB(b, h) ((4 + (b) * 2 + (h)) * HTB)
#define PG8_STAGE(bufoff, gbase, voff) do { _Pragma("unroll") for (int _i = 0; _i < 2; ++_i) \
        __builtin_amdgcn_global_load_lds((const unsigned*)((const char*)(gbase) + (voff)[_i]), (PG8_LAS unsigned*)(lds + (bufoff) + ldsw + _i * 8192), 16, 0, 0); } while (0)
#define PG8_LDA(dst, b, h) do { _Pragma("unroll") for (int m = 0; m < 4; ++m) _Pragma("unroll") for (int k = 0; k < 2; ++k) dst[m][k] = *(const PG8_LAS bf16x8*)(lds + PG8_SA(b, h) + aoff + m * 2048 + k * 1024); } while (0)
#define PG8_LDB(dst, b, h) do { _Pragma("unroll") for (int n = 0; n < 2; ++n) _Pragma("unroll") for (int k = 0; k < 2; ++k) dst[n][k] = *(const PG8_LAS bf16x8*)(lds + PG8_SB(b, h) + boff + n * 2048 + k * 1024); } while (0)
#define PG8_MMA(ai, bj, At, Bt) do { __builtin_amdgcn_s_setprio(1); _Pragma("unroll") for (int m = 0; m < 4; ++m) _Pragma("unroll") for (int n = 0; n < 2; ++n) _Pragma("unroll") for (int k = 0; k < 2; ++k) \
        acc[ai][bj][m][n] = __builtin_amdgcn_mfma_f32_16x16x32_bf16(Bt[n][k], At[m][k], acc[ai][bj][m][n], 0, 0, 0); __builtin_amdgcn_s_setprio(0); } while (0)
#define PG8_WAIT_V(n) asm volatile("s_waitcnt vmcnt(" #n ")" ::: "memory")
#define PG8_WAIT_L(n) asm volatile("s_waitcnt lgkmcnt(" #n ")" ::: "memory")
#define PG8_BAR __builtin_amdgcn_s_barrier()
#define PG8_SCHED __builtin_amdgcn_sched_barrier(0)
    Unit cur, nxt; int ui = 0;
    if (!S.next(0, cur)) return;
    f32x4 acc[2][2][4][2];
#pragma unroll
    for (int a = 0; a < 2; ++a)
#pragma unroll
        for (int b = 0; b < 2; ++b)
#pragma unroll
            for (int m = 0; m < 4; ++m)
#pragma unroll
                for (int n = 0; n < 2; ++n) acc[a][b][m][n] = (f32x4){0.f, 0.f, 0.f, 0.f};
    bf16x8 At[4][2], B0[2][2], B1[2][2];
    const char* cA = (const char*)g.A + (size_t)cur.pm * tstepA; const char* cB = (const char*)g.Bt + (size_t)cur.pn * tstep;
    S.a_ready(cur);
    PG8_LAS float* RS = (PG8_LAS float*)(lds + MISC_OFF + 1024);
    u32x2 raw0 = {0u, 0u}; if constexpr (Epi::STAGE) raw0 = E.st_issue(cur, tid);
    if constexpr (SP2) {
        PG8_STAGE(PG8_SB(0, 0), cB, voffB); PG8_STAGE(PG8_SB(0, 1), cB + hstep, voffB); PG8_STAGE(PG8_SA(0, 0), cA, voffA); PG8_STAGE(PG8_SA(0, 1), cA + hstepA, voffA);
        if (wr == 1) PG8_BAR;
        PG8_WAIT_V(2); PG8_BAR;
        PG8_STAGE(PG8_SB(1, 0), cB + kstep, voffB); PG8_STAGE(PG8_SA(1, 0), cA + kstep, voffA); PG8_STAGE(PG8_SB(1, 1), cB + hstep + kstep, voffB);
        PG8_WAIT_V(6); PG8_BAR;
    } else {
        PG8_STAGE(PG8_SB(0, 0), cB, voffB); PG8_STAGE(PG8_SA(0, 0), cA, voffA); PG8_STAGE(PG8_SB(0, 1), cB + hstep, voffB); PG8_STAGE(PG8_SA(0, 1), cA + hstepA, voffA);
        if (wr == 1) PG8_BAR;
        PG8_WAIT_V(4); PG8_BAR;
        PG8_STAGE(PG8_SB(1, 0), cB + kstep, voffB); PG8_STAGE(PG8_SA(1, 0), cA + kstep, voffA); PG8_STAGE(PG8_SB(1, 1), cB + hstep + kstep, voffB);
        PG8_WAIT_V(6); PG8_BAR;
    }
    if constexpr (Epi::STAGE) E.st_commit(raw0, cur, RS, tid);
    for (;;) {
        const bool has_next = S.next(ui + 1, nxt);
        const char* nA = has_next ? (const char*)g.A + (size_t)nxt.pm * tstepA : cA; const char* nB = has_next ? (const char*)g.Bt + (size_t)nxt.pn * tstep : cB;
        for (int t = 0; t < nt; t += 2) {
            const bool last = (t == nt - 2);
            const char* a1 = cA + (size_t)(t + 1) * kstep;
            const char* a2 = last ? nA : cA + (size_t)(t + 2) * kstep; const char* b2 = last ? nB : cB + (size_t)(t + 2) * kstep;
            const char* a3 = a2 + kstep; const char* b3 = b2 + kstep;
            if (last && has_next) S.a_ready(nxt);
            if constexpr (SP2) {
            PG8_LDB(B0, 0, 0); PG8_LDB(B1, 0, 1); PG8_SCHED; PG8_LDA(At, 0, 0); PG8_STAGE(PG8_SA(1, 1), a1 + hstepA, voffA);
            PG8_WAIT_V(8); PG8_WAIT_L(0); PG8_BAR; PG8_MMA(0, 0, At, B0); PG8_MMA(0, 1, At, B1); PG8_BAR; PG8_SCHED;
            PG8_LDA(At, 0, 1); PG8_STAGE(PG8_SB(0, 0), b2, voffB); PG8_STAGE(PG8_SB(0, 1), b2 + hstep, voffB); PG8_STAGE(PG8_SA(0, 0), a2, voffA);
            PG8_WAIT_V(8); PG8_WAIT_L(0); PG8_BAR; PG8_MMA(1, 0, At, B0); PG8_MMA(1, 1, At, B1); PG8_BAR; PG8_SCHED;
            PG8_LDB(B0, 1, 0); PG8_LDB(B1, 1, 1); PG8_SCHED; PG8_LDA(At, 1, 0); PG8_STAGE(PG8_SA(0, 1), a2 + hstepA, voffA);
            PG8_WAIT_V(8); PG8_WAIT_L(0); PG8_BAR; PG8_MMA(0, 0, At, B0); PG8_MMA(0, 1, At, B1); PG8_BAR; PG8_SCHED;
            PG8_LDA(At, 1, 1); PG8_STAGE(PG8_SB(1, 0), b3, voffB); PG8_STAGE(PG8_SB(1, 1), b3 + hstep, voffB); PG8_STAGE(PG8_SA(1, 0), a3, voffA);
            PG8_WAIT_V(8); PG8_WAIT_L(0); PG8_BAR; PG8_MMA(1, 0, At, B0); PG8_MMA(1, 1, At, B1); PG8_BAR; PG8_SCHED;
            } else {
            PG8_LDB(B0, 0, 0); PG8_SCHED; PG8_LDA(At, 0, 0); PG8_STAGE(PG8_SA(1, 1), a1 + hstepA, voffA);
            PG8_WAIT_L(8); PG8_BAR; PG8_WAIT_L(0); PG8_MMA(0, 0, At, B0); PG8_BAR; PG8_SCHED;
            PG8_LDB(B1, 0, 1); PG8_STAGE(PG8_SB(0, 0), b2, voffB);
            PG8_BAR; PG8_WAIT_L(0); PG8_MMA(0, 1, At, B1); PG8_BAR;
            PG8_LDA(At, 0, 1); PG8_STAGE(PG8_SA(0, 0), a2, voffA);
            PG8_BAR; PG8_WAIT_L(0); PG8_MMA(1, 0, At, B0); PG8_BAR; PG8_SCHED;
            PG8_STAGE(PG8_SB(0, 1), b2 + hstep, voffB);
            PG8_WAIT_V(6); PG8_BAR; PG8_MMA(1, 1, At, B1); PG8_BAR;
            PG8_LDB(B0, 1, 0); PG8_SCHED; PG8_LDA(At, 1, 0); PG8_STAGE(PG8_SA(0, 1), a2 + hstepA, voffA);
            PG8_WAIT_L(8); PG8_BAR; PG8_WAIT_L(0); PG8_MMA(0, 0, At, B0); PG8_BAR; PG8_SCHED;
            PG8_LDB(B1, 1, 1); PG8_STAGE(PG8_SB(1, 0), b3, voffB);
            PG8_BAR; PG8_WAIT_L(0); PG8_MMA(0, 1, At, B1); PG8_BAR;
            PG8_LDA(At, 1, 1); PG8_STAGE(PG8_SA(1, 0), a3, voffA);
            PG8_BAR; PG8_WAIT_L(0); PG8_MMA(1, 0, At, B0); PG8_BAR; PG8_SCHED;
            PG8_STAGE(PG8_SB(1, 1), b3 + hstep, voffB);
            PG8_WAIT_V(6); PG8_BAR; PG8_MMA(1, 1, At, B1); PG8_BAR;
            }
        }
        if constexpr (ALIGN_EPI) { if (wr == 0) PG8_BAR; }
        if constexpr (!Epi::AFTER_DRAIN) {
            if constexpr (Epi::STAGE) {
                const Unit& nu = has_next ? nxt : cur; const u32x2 raw = E.st_issue(nu, tid);
                E(acc, cur, wr, wc, fr, fq, RS + (ui & 1) * 640);
                E.st_commit(raw, nu, RS + ((ui + 1) & 1) * 640, tid);
            } else E(acc, cur, wr, wc, fr, fq);
            S.done(cur); }
        if (!has_next) break;
#pragma unroll
        for (int a = 0; a < 2; ++a)
#pragma unroll
            for (int b = 0; b < 2; ++b)
#pragma unroll
                for (int m = 0; m < 4; ++m)
#pragma unroll
                    for (int n = 0; n < 2; ++n) acc[a][b][m][n] = (f32x4){0.f, 0.f, 0.f, 0.f};
        cur = nxt; cA = nA; cB = nB; ++ui;
        if constexpr (ALIGN_EPI) { if (wr == 1) PG8_BAR; }
    }
    PG8_WAIT_V(0);
    if constexpr (!ALIGN_EPI) { if (wr == 0) PG8_BAR; }
    PG8_BAR;
    if constexpr (Epi::AFTER_DRAIN) { E.fused(acc, cur, wr, wc, fr, fq, lds, wid, lane); S.done(cur); }
#undef PG8_SA
#undef PG8_SB
#undef PG8_STAGE
#undef PG8_LDA
#undef PG8_LDB
#undef PG8_MMA
#undef PG8_WAIT_V
#undef PG8_WAIT_L
#undef PG8_BAR
#undef PG8_SCHED
}
}
#define XB_TMO      128
#define XB_XCNT(j)  (256  + 64 * (j))
#define XB_XSUB(j)  (1280 + 64 * (j))
#define XB_XGEN(j)  (2304 + 64 * (j))
#define XB_TOP      3328
#define XB_TOPGEN   3392
#define XCD_BAR_WORDS 3456
#define XB_SPIN_CAP (1u << 18)

__device__ __forceinline__ unsigned xb_ld(unsigned* p)              { return __hip_atomic_load(p, __ATOMIC_RELAXED, __HIP_MEMORY_SCOPE_AGENT); }
__device__ __forceinline__ unsigned xb_add(unsigned* p, unsigned v) { return __hip_atomic_fetch_add(p, v, __ATOMIC_RELAXED, __HIP_MEMORY_SCOPE_AGENT); }
__device__ __forceinline__ unsigned xb_xcc_id() { return (unsigned)__builtin_amdgcn_s_getreg((3 << 11) | 20) & 0xFu; }
#define XB_SPIN(cond, bar) do { unsigned _sp = 0; while (cond) { __builtin_amdgcn_s_sleep(4); \
    if ((++_sp & 255u) == 0u) { if (xb_ld(&(bar)[XB_TMO])) break; if (_sp > XB_SPIN_CAP) { atomicAdd(&(bar)[XB_TMO], 1u); break; } } } } while (0)

struct XcdBarrier {
    unsigned* bar; unsigned x;
    volatile LAS unsigned* st;
};

__device__ __forceinline__ XcdBarrier xcd_barrier_post(unsigned* bar, volatile LAS unsigned* st) {
    XcdBarrier b; b.bar = bar; b.x = xb_xcc_id(); b.st = st;
    if (threadIdx.x == 0) (void)xb_add(&bar[XB_XCNT(b.x)], 1u);
    return b;
}
__device__ __forceinline__ void xcd_barrier_complete(unsigned* bar, unsigned x, unsigned& nloc, unsigned& nx) {
    const unsigned G = gridDim.x * gridDim.y * gridDim.z;
    unsigned sum, cnt, mine, sp = 0u;
    for (;;) {
        sum = 0u; cnt = 0u; mine = 0u;
#pragma unroll
        for (unsigned j = 0; j < 16; ++j) { const unsigned c = xb_ld(&bar[XB_XCNT(j)]); sum += c; cnt += (c > 0u) ? 1u : 0u; mine = (j == x) ? c : mine; }
        if (sum == G) break;
        __builtin_amdgcn_s_sleep(1);
        if ((++sp & 255u) == 0u) { if (xb_ld(&bar[XB_TMO])) break; if (sp > XB_SPIN_CAP) { atomicAdd(&bar[XB_TMO], 1u); break; } }
    }
    nloc = mine > 0u ? mine : 1u; nx = cnt > 0u ? cnt : 1u;
}

__device__ __forceinline__ void xcd_barrier(const XcdBarrier& b) {
    asm volatile("s_waitcnt vmcnt(0)" ::: "memory");
    __syncthreads();
    if (threadIdx.x == 0) {
        unsigned* bar = b.bar;
        __builtin_amdgcn_s_waitcnt(0);
        unsigned nloc = b.st[0], nx = b.st[1];
        if (nloc == 0u) { xcd_barrier_complete(bar, b.x, nloc, nx); b.st[0] = nloc; b.st[1] = nx; }
        const unsigned old = xb_add(&bar[XB_XSUB(b.x)], 1u);
        const unsigned gen = old / nloc;
        if (old + 1u == (gen + 1u) * nloc) {
            __builtin_amdgcn_fence(__ATOMIC_RELEASE, "agent");
            asm volatile("s_waitcnt vmcnt(0)" ::: "memory");
            const unsigned og = xb_add(&bar[XB_TOP], 1u);
            const unsigned tg = og / nx;
            if (og + 1u == (tg + 1u) * nx) xb_add(&bar[XB_TOPGEN], 1u);
            else XB_SPIN(xb_ld(&bar[XB_TOPGEN]) == tg, bar);
            __builtin_amdgcn_fence(__ATOMIC_ACQUIRE, "agent");
            xb_add(&bar[XB_XGEN(b.x)], 1u);
            asm volatile("s_waitcnt vmcnt(0)" ::: "memory");
        } else {
            XB_SPIN(xb_ld(&bar[XB_XGEN(b.x)]) == gen, bar);
            __builtin_amdgcn_fence(__ATOMIC_ACQUIRE, "agent");
            asm volatile("s_waitcnt vmcnt(0)" ::: "memory");
        }
    }
    __syncthreads();
}
struct Args { const float* in[34]; float* out; unsigned char* ws; int ph_lo, ph_hi; };
enum { I_XP = 0, I_XS, I_MEM, I_STATE, I_CGC, I_CSC, I_CSBK, I_CSBV, I_CMK, I_CMV, I_CFC, I_NMIXG, I_WIN, I_GCW, I_ALOG, I_DTB, I_GNG, I_SCW, I_SCG, I_SBG, I_WMIX,
       I_NMEMG, I_MEMING, I_WMQ, I_WMK, I_WMV, I_MQG, I_MKG, I_WMO, I_NFFNG, I_WGATE, I_WUP, I_FCW, I_WDN };
constexpr int CW_BAR = 4096;

typedef unsigned long long u64_t;
constexpr float SSQ_FIX = 1048576.0f;
DI float ssq_ld(const u64_t* ssq, int row) { return (float)ssq[row] * (1.0f / SSQ_FIX); }
DI float row_rstd(const u64_t* ssq, int row) { return rsqrtf(ssq_ld(ssq, row) * (1.0f / DM) + EPS); }
struct EpiScaleBf16 {
    static constexpr bool PERM = true, AFTER_DRAIN = false, ROWMAP = false, STAGE = true;
    bf16_t* O; int ldc; const u64_t* ssq; int tk, tv; float* fkp; float* fks; float* fvp; float* fvs;
    DI u32x2 st_issue(const pg8::Unit& n, int tid) const { return *(const u32x2*)(ssq + n.pm * 256 + (tid & 255)); }
    DI void st_commit(u32x2 raw, const pg8::Unit&, LAS float* RSn, int tid) const {
        const u64_t v = ((u64_t)raw.y << 32) | raw.x; if (tid < 256) RSn[tid] = rsqrtf((float)v * (1.0f / (SSQ_FIX * DM)) + EPS); }
    DI void operator()(const f32x4 (&acc)[2][2][4][2], const pg8::Unit& u, int wr, int wc, int fr, int fq, const LAS float* RS) const {
        const int row0 = u.pm * 256 + wr * 64 + fr, col0 = u.pn * 256 + wc * 32 + 8 * fq;
        const bool side = (u.pn == tk) || (u.pn == tv);
#pragma unroll
        for (int ai = 0; ai < 2; ++ai)
#pragma unroll
            for (int m = 0; m < 4; ++m) {
                const int row = row0 + ai * 128 + m * 16;
                const float rs = RS[wr * 64 + ai * 128 + m * 16 + fr];
                bf16_t* rowp = O + (size_t)row * ldc + col0;
#pragma unroll
                for (int bj = 0; bj < 2; ++bj) {
                    const f32x4 v0 = acc[ai][bj][m][0] * rs, v1 = acc[ai][bj][m][1] * rs;
                    u32x4 w; w.x = pk2(v0[0], v0[1]); w.y = pk2(v0[2], v0[3]); w.z = pk2(v1[0], v1[1]); w.w = pk2(v1[2], v1[3]);
                    *(u32x4*)(rowp + bj * 128) = w;
                    if (side) {
                        float* f = (u.pn == tk) ? (row < MP ? fkp + (size_t)row * 256 : fks + (size_t)(row - MP) * 256) : (row < MP ? fvp + (size_t)row * 256 : fvs + (size_t)(row - MP) * 256);
                        f += wc * 32 + 8 * fq + bj * 128;
                        __builtin_nontemporal_store(v0, (f32x4*)f); __builtin_nontemporal_store(v1, (f32x4*)(f + 4));
                    }
                }
            }
    }
};
struct EpiScaleF32 {
    static constexpr bool PERM = true, AFTER_DRAIN = false, ROWMAP = false, STAGE = false;
    float* O; int ldc; const float* ssq1;
    DI void operator()(const f32x4 (&acc)[2][2][4][2], const pg8::Unit& u, int wr, int wc, int fr, int fq) const {
        const int row0 = u.pm * 256 + wr * 64 + fr, col0 = u.pn * 256 + wc * 32 + 8 * fq;
#pragma unroll
        for (int ai = 0; ai < 2; ++ai)
#pragma unroll
            for (int m = 0; m < 4; ++m) {
                const int row = row0 + ai * 128 + m * 16;
                const float rs = rsqrtf(ssq1[row] * (1.0f / DM) + EPS);
                float* rowp = O + (size_t)row * ldc + col0;
#pragma unroll
                for (int bj = 0; bj < 2; ++bj) { *(f32x4*)(rowp + bj * 128) = acc[ai][bj][m][0] * rs; *(f32x4*)(rowp + bj * 128 + 4) = acc[ai][bj][m][1] * rs; }
            }
    }
};
struct EpiResid {
    static constexpr bool PERM = true, AFTER_DRAIN = false, ROWMAP = false, STAGE = false;
    float* XF; bf16_t* XB; u64_t* ssq; int fin;
    DI void operator()(const f32x4 (&acc)[2][2][4][2], const pg8::Unit& u, int wr, int wc, int fr, int fq) const {
        const int row0 = u.pm * 256 + wr * 64 + fr, col0 = u.pn * 256 + wc * 32 + 8 * fq;
        u32x4 rv[4][2];
#pragma unroll
        for (int i = 0; i < 4; ++i) { const bf16_t* rp = XB + (size_t)(row0 + i * 16) * DM + col0; rv[i][0] = *(const u32x4*)rp; rv[i][1] = *(const u32x4*)(rp + 128); }
#pragma unroll
        for (int i = 0; i < 8; ++i) {
            const int ai = i >> 2, m = i & 3, row = row0 + ai * 128 + m * 16;
            const u32x4 r0 = rv[i & 3][0], r1 = rv[i & 3][1];
            if (i + 4 < 8) { const bf16_t* rp = XB + (size_t)(row0 + 128 + (i & 3) * 16) * DM + col0; rv[i & 3][0] = *(const u32x4*)rp; rv[i & 3][1] = *(const u32x4*)(rp + 128); }
            float* xo = XF + (size_t)row * DM + col0; bf16_t* xb = XB + (size_t)row * DM + col0;
            float s = 0.f;
#pragma unroll
            for (int bj = 0; bj < 2; ++bj) {
                float r8[8]; unpk8(bj == 0 ? r0 : r1, r8);
                const f32x4 v0 = acc[ai][bj][m][0] + (f32x4){r8[0], r8[1], r8[2], r8[3]}, v1 = acc[ai][bj][m][1] + (f32x4){r8[4], r8[5], r8[6], r8[7]};
                if (fin) { *(f32x4*)(xo + bj * 128) = v0; *(f32x4*)(xo + bj * 128 + 4) = v1; }
                else { u32x4 w; w.x = pk2(v0[0], v0[1]); w.y = pk2(v0[2], v0[3]); w.z = pk2(v1[0], v1[1]); w.w = pk2(v1[2], v1[3]);
                    *(u32x4*)(xb + bj * 128) = w; }
                s += (v0[0] * v0[0] + v0[1] * v0[1]) + (v0[2] * v0[2] + v0[3] * v0[3]) + (v1[0] * v1[0] + v1[1] * v1[1]) + (v1[2] * v1[2] + v1[3] * v1[3]);
            }
            s += __shfl_xor(s, 16); s += __shfl_xor(s, 32);
            if (fq == 0 && !fin) atomicAdd(ssq + row, (u64_t)(s * SSQ_FIX));
        }
    }
};

DI float dpp_ror1(float v) { return __builtin_bit_cast(float, __builtin_amdgcn_update_dpp(0, __builtin_bit_cast(int, v), 0x121, 0xf, 0xf, false)); }
DI float dpp_ror2(float v) { return __builtin_bit_cast(float, __builtin_amdgcn_update_dpp(0, __builtin_bit_cast(int, v), 0x122, 0xf, 0xf, false)); }
struct EpiAct {
    static constexpr bool PERM = true, AFTER_DRAIN = false, ROWMAP = true, STAGE = true;
    bf16_t* ACT; const u64_t* ssq; const float* cw; const float* cache; float* pfc; float* sfc;
    DI u32x2 st_issue(const pg8::Unit& n, int tid) const {
        int tok = 248 * n.pm + 62 * (tid >> 6) - 2 + (tid & 63); tok = tok < 0 ? 0 : (tok < MALL ? tok : MALL - 1);
        int c = tid - 256; c = c < 0 ? 0 : (c < 192 ? c : 191);
        const unsigned* p = tid < 256 ? (const unsigned*)(ssq + tok) : (const unsigned*)(cw + (c >> 6) * DFF + n.pn * 128 + 2 * (c & 63));
        return *(const u32x2*)p;
    }
    DI void st_commit(u32x2 raw, const pg8::Unit& n, LAS float* RSn, int tid) const {
        if (tid < 256) { const int tok = 248 * n.pm + 62 * (tid >> 6) - 2 + (tid & 63); const u64_t v = ((u64_t)raw.y << 32) | raw.x;
            RSn[tid] = (tok >= 0 && tok < MALL) ? rsqrtf((float)v * (1.0f / (SSQ_FIX * DM)) + EPS) : 0.f; }
        else if (tid < 448) { const int c = tid - 256; *(LAS u32x2*)(RSn + 256 + (c >> 6) * 128 + 2 * (c & 63)) = raw; }
    }
    DI void operator()(f32x4 (&acc)[2][2][4][2], const pg8::Unit& u, int wr, int wc, int fr, int fq, const LAS float* RS) const {
        const int ch0 = u.pn * 128 + wc * 32 + 8 * fq;
        f32x4 w[3][2];
#pragma unroll
        for (int i = 0; i < 3; ++i)
#pragma unroll
            for (int n = 0; n < 2; ++n) w[i][n] = *(const LAS f32x4*)(RS + 256 + i * 128 + wc * 32 + 8 * fq + 4 * n);
#pragma unroll
        for (int ai = 0; ai < 2; ++ai) {
            const int tok0 = 248 * u.pm + 62 * (2 * ai + wr) - 2 + fr;
#pragma unroll
            for (int m = 0; m < 4; ++m) {
                const float rs = RS[(2 * ai + wr) * 64 + 16 * m + fr];
#pragma unroll
                for (int bj = 0; bj < 2; ++bj)
#pragma unroll
                    for (int n = 0; n < 2; ++n) acc[ai][bj][m][n] = acc[ai][bj][m][n] * rs;
            }
            f32x4 p1[2], p2[2];
#pragma unroll
            for (int n = 0; n < 2; ++n) { p1[n] = (f32x4){0.f, 0.f, 0.f, 0.f}; p2[n] = p1[n]; }
#pragma unroll
            for (int m = 0; m < 4; ++m) {
                const int tok = tok0 + 16 * m;
                f32x4 g1[2], g2[2];
#pragma unroll
                for (int n = 0; n < 2; ++n)
#pragma unroll
                    for (int e = 0; e < 4; ++e) {
                        const float a1 = dpp_ror1(acc[ai][0][m][n][e]), a2 = dpp_ror2(acc[ai][0][m][n][e]);
                        g1[n][e] = fr >= 1 ? a1 : p1[n][e]; g2[n][e] = fr >= 2 ? a2 : p2[n][e];
                        p1[n][e] = a1; p2[n][e] = a2;
                    }
                const bool outrow = (16 * m + fr >= 2) && tok < MALL;
                const bool smp = tok >= MP;
                const int t = smp ? ((tok - MP) & (TS - 1)) : (tok & (TP - 1)), bb = smp ? ((tok - MP) >> 4) : (tok >> 12), T = smp ? TS : TP;
                if (outrow && t < 2) {
                    f32x4 h0[2], h1[2];
#pragma unroll
                    for (int n = 0; n < 2; ++n) { h0[n] = (f32x4){0.f, 0.f, 0.f, 0.f}; h1[n] = h0[n]; }
                    if (smp) { const float* cp = cache + (size_t)bb * 2 * DFF + ch0;
#pragma unroll
                        for (int n = 0; n < 2; ++n) { h0[n] = *(const f32x4*)(cp + 4 * n); h1[n] = *(const f32x4*)(cp + DFF + 4 * n); } }
#pragma unroll
                    for (int n = 0; n < 2; ++n) { if (t == 0) { g2[n] = h0[n]; g1[n] = h1[n]; } else g2[n] = h1[n]; }
                }
                if (outrow) {
                    float y[8];
#pragma unroll
                    for (int n = 0; n < 2; ++n)
#pragma unroll
                        for (int e = 0; e < 4; ++e) { const float gt = w[0][n][e] * g2[n][e] + w[1][n][e] * g1[n][e] + w[2][n][e] * acc[ai][0][m][n][e]; y[4 * n + e] = siluf_(gt) * acc[ai][1][m][n][e]; }
                    *(u32x4*)(ACT + (size_t)tok * DFF + ch0) = pk8(y);
                    if (t >= T - 2) { float* dst = (smp ? sfc : pfc) + ((size_t)bb * 2 + (t - (T - 2))) * DFF + ch0; *(f32x4*)dst = acc[ai][0][m][0]; *(f32x4*)(dst + 4) = acc[ai][0][m][1]; }
                }
            }
        }
    }
};

DI void transpose_item(const float* W, int K, int N, int n_src0, const float* gain, bf16_t* WT, int row_dst0, int kb, LAS float* scr, int lane) {
    const int k0 = 64 * kb, q = lane & 15, r4 = lane >> 4;
    f32x4 v[16];
#pragma unroll
    for (int i = 0; i < 16; ++i) v[i] = *(const f32x4*)(W + (size_t)(k0 + 4 * i + r4) * N + n_src0 + 4 * q);
#pragma unroll
    for (int i = 0; i < 16; ++i) { const int kk = 4 * i + r4; const float g = gain ? gain[k0 + kk] : 1.f; LAS float* s = scr + kk * 65 + 4 * q;
        s[0] = v[i][0] * g; s[1] = v[i][1] * g; s[2] = v[i][2] * g; s[3] = v[i][3] * g; }
    LDS_WAIT(); asm volatile("" ::: "memory");
    const int c = lane & 7;
#pragma unroll
    for (int j = 0; j < 8; ++j) { const int n = (lane >> 3) + 8 * j; const LAS float* s = scr + (8 * c) * 65 + n;
        u32x4 o; o.x = pk2(s[0 * 65], s[1 * 65]); o.y = pk2(s[2 * 65], s[3 * 65]); o.z = pk2(s[4 * 65], s[5 * 65]); o.w = pk2(s[6 * 65], s[7 * 65]);
        *(u32x4*)(WT + (size_t)(row_dst0 + n) * K + k0 + 8 * c) = o; }
    LDS_WAIT(); asm volatile("" ::: "memory");
}
DI float row_to_bf16(const float* xrow, bf16_t* orow, int lane) {
    const f32x4* xr = (const f32x4*)xrow + lane; float s = 0.f;
    unsigned long long* o8 = (unsigned long long*)orow + lane;
#pragma unroll
    for (int j = 0; j < 4; ++j) { const f32x4 v = xr[64 * j]; s += (v[0] * v[0] + v[1] * v[1]) + (v[2] * v[2] + v[3] * v[3]);
        o8[64 * j] = (unsigned long long)pk2(v[0], v[1]) | ((unsigned long long)pk2(v[2], v[3]) << 32); }
    return wave_sum(s);
}
DI void transpose_v_tile(const float* src, size_t pitch, bf16_t* dst, LAS unsigned char* lds, int tid) {
    LAS bf16_t* tile = (LAS bf16_t*)lds;
#pragma unroll 4
    for (int i = 0; i < 64; ++i) { const int idx = tid + 512 * i, n = idx >> 7, d = idx & 127; tile[d * 264 + n] = f2bf(src[(size_t)n * pitch + d]); }
    __syncthreads();
#pragma unroll
    for (int i = 0; i < 8; ++i) { const int v = tid + 512 * i, d = v >> 5, n8 = v & 31; *(u32x4*)(dst + (size_t)d * 256 + 8 * n8) = *(const LAS u32x4*)(tile + d * 264 + 8 * n8); }
    __syncthreads();
}

DI void phase_convert(const Args& A, LAS unsigned char* lds) {
    const int tid = otid(), lane = tid & 63, wave = tid >> 6, G = gridDim.x;
    const int gw = blockIdx.x * NWAVES + wave, NGW = G * NWAVES;
    unsigned char* ws = A.ws;
    LAS float* scr = (LAS float*)(lds + wave * 16640);
    constexpr int NI = 3776;
    for (int it = gw; it < NL * NI; it += NGW) {
        const int l = it / NI; int r = it % NI;
        if (r < 896) { const int kb = r / 56, nb = r % 56, nd = 64 * nb; transpose_item(A.in[I_WIN] + (size_t)l * DM * DIN, DM, DIN, nd + (nd >= 2048 ? 8 : 0), A.in[I_NMIXG] + l * DM, (bf16_t*)(ws + WS_WIN + l * SZ_WIN), nd, kb, scr, lane); continue; } r -= 896;
        if (r < 256) { transpose_item(A.in[I_WMIX] + (size_t)l * DM * DM, DM, DM, 64 * (r % 16), nullptr, (bf16_t*)(ws + WS_WMIX + l * SZ_WMIX), 64 * (r % 16), r / 16, scr, lane); continue; } r -= 256;
        if (r < 128) { transpose_item(A.in[I_WMQ] + (size_t)l * DM * 512, DM, 512, 64 * (r % 8), A.in[I_NMEMG] + l * DM, (bf16_t*)(ws + WS_WMQ + l * SZ_WMQ), 64 * (r % 8), r / 8, scr, lane); continue; } r -= 128;
        if (r < 128) { transpose_item(A.in[I_WMK] + (size_t)l * DM * 512, DM, 512, 64 * (r % 8), A.in[I_MEMING] + l * DM, (bf16_t*)(ws + WS_WMKV), l * 1024 + 64 * (r % 8), r / 8, scr, lane); continue; } r -= 128;
        if (r < 128) { transpose_item(A.in[I_WMV] + (size_t)l * DM * 512, DM, 512, 64 * (r % 8), A.in[I_MEMING] + l * DM, (bf16_t*)(ws + WS_WMKV), l * 1024 + 512 + 64 * (r % 8), r / 8, scr, lane); continue; } r -= 128;
        if (r < 128) { transpose_item(A.in[I_WMO] + (size_t)l * 512 * DM, 512, DM, 64 * (r % 16), nullptr, (bf16_t*)(ws + WS_WMO + l * SZ_WMO), 64 * (r % 16), r / 16, scr, lane); continue; } r -= 128;
        if (r < 704) { const int nb = r % 44; transpose_item(A.in[I_WGATE] + (size_t)l * DM * DFF, DM, DFF, 64 * nb, A.in[I_NFFNG] + l * DM, (bf16_t*)(ws + WS_WGU + l * SZ_WGU), 256 * (nb >> 1) + 64 * (nb & 1), r / 44, scr, lane); continue; } r -= 704;
        if (r < 704) { const int nb = r % 44; transpose_item(A.in[I_WUP] + (size_t)l * DM * DFF, DM, DFF, 64 * nb, A.in[I_NFFNG] + l * DM, (bf16_t*)(ws + WS_WGU + l * SZ_WGU), 256 * (nb >> 1) + 128 + 64 * (nb & 1), r / 44, scr, lane); continue; } r -= 704;
        transpose_item(A.in[I_WDN] + (size_t)l * DFF * DM, DFF, DM, 64 * (r % 16), nullptr, (bf16_t*)(ws + WS_WDN + l * SZ_WDN), 64 * (r % 16), r / 16, scr, lane);
    }
    for (int e = blockIdx.x * NTHR + tid; e < NL * 16 * DM; e += G * NTHR) {
        const int l = e / (16 * DM), j = (e / DM) & 15, k = e % DM;
        const float v = j < 8 ? A.in[I_WIN][(size_t)l * DM * DIN + (size_t)k * DIN + 2048 + j] * A.in[I_NMIXG][l * DM + k] : 0.f;
        ((bf16_t*)(ws + WS_WG8 + l * SZ_WG8))[j * DM + k] = f2bf(v);
    }
    bf16_t* XB = (bf16_t*)(ws + WS_XB); u64_t* SSQ = (u64_t*)(ws + WS_SSQ);
    for (int row = gw; row < MALL + 4096; row += NGW) {
        if (row < MALL) {
            const float* src = row < MP ? A.in[I_XP] + (size_t)row * DM : A.in[I_XS] + (size_t)(row - MP) * DM;
            const float s = row_to_bf16(src, XB + (size_t)row * DM, lane);
            if (lane == 0) SSQ[row] = (u64_t)(s * SSQ_FIX);
        } else {
            const int r = row - MALL;
            const float s = row_to_bf16(A.in[I_MEM] + (size_t)r * DM, (bf16_t*)(ws + WS_MEMB) + (size_t)r * DM, lane);
            if (lane == 0) ((float*)(ws + WS_SSQM))[r] = s;
        }
    }
    for (int e = blockIdx.x * NTHR + tid; e < 256 * DM / 8; e += G * NTHR) ((u32x4*)(XB + (size_t)MALL * DM))[e] = (u32x4){0u, 0u, 0u, 0u};
    {
        bf16_t* SMK = (bf16_t*)(ws + WS_SMK);
        const int NV = NL * BS * 4 * 256 * 16;
        for (int v = blockIdx.x * NTHR + tid; v < NV; v += G * NTHR) {
            const int d8 = v & 15, n = (v >> 4) & 255, h = (v >> 12) & 3, sb = (v >> 14) & 31, l = v >> 19;
            const float* src = A.in[I_CMK] + ((((size_t)(l * BS + sb) * 256 + n) * 4 + h) * 128 + 8 * d8);
            const float* g = A.in[I_MQG] + l * 128 + 8 * d8;
            const f32x4 a = *(const f32x4*)src, b = *(const f32x4*)(src + 4), ga = *(const f32x4*)g, gb = *(const f32x4*)(g + 4);
            u32x4 o; o.x = pk2(a[0] * ga[0], a[1] * ga[1]); o.y = pk2(a[2] * ga[2], a[3] * ga[3]); o.z = pk2(b[0] * gb[0], b[1] * gb[1]); o.w = pk2(b[2] * gb[2], b[3] * gb[3]);
            *(u32x4*)(SMK + (size_t)v * 8) = o;
        }
    }
    __syncthreads();
    for (int t = blockIdx.x; t < NL * BS * 4; t += G) {
        const int h = t & 3, sb = (t >> 2) & 31, l = t >> 7;
        transpose_v_tile(A.in[I_CMV] + ((size_t)(l * BS + sb) * 256 * 4 + h) * 128, 512, (bf16_t*)(ws + WS_SMVT) + (size_t)t * 128 * 256, lds, tid);
    }
}

DI void phase_memkv_post(const Args& A, LAS unsigned char* lds) {
    const int tid = otid(), lane = tid & 63, wave = tid >> 6, G = gridDim.x;
    const float* RAW = (const float*)(A.ws + WS_RAWKV);
    for (int u = blockIdx.x; u < NL * BP * 4; u += G) {
        const int h = u & 3, b = (u >> 2) & 15, l = u >> 6;
        const float mkg0 = A.in[I_MKG][l * 128 + 2 * lane], mkg1 = A.in[I_MKG][l * 128 + 2 * lane + 1];
        const float mqg0 = A.in[I_MQG][l * 128 + 2 * lane], mqg1 = A.in[I_MQG][l * 128 + 2 * lane + 1];
        bf16_t* MK = (bf16_t*)(A.ws + WS_MK) + (size_t)((l * BP + b) * 4 + h) * 256 * 128;
        for (int n = wave; n < 256; n += NWAVES) {
            const float* src = RAW + (size_t)(b * 256 + n) * 4096 + l * 1024 + h * 128;
            const f32x2 k = *(const f32x2*)(src + 2 * lane), v = *(const f32x2*)(src + 512 + 2 * lane);
            const float ss = wave_sum(k[0] * k[0] + k[1] * k[1]);
            const float rs = rsqrtf(ss * (1.0f / 128.0f) + EPS);
            const float k0 = k[0] * rs * mkg0, k1 = k[1] * rs * mkg1;
            const size_t oo = (((size_t)(l * BP + b) * 256 + n) * 4 + h) * 128 + 2 * lane;
            *(f32x2*)(A.out + O_PMK + oo) = (f32x2){k0, k1};
            *(f32x2*)(A.out + O_PMV + oo) = v;
            *(unsigned*)(MK + (size_t)n * 128 + 2 * lane) = pk2(k0 * mqg0, k1 * mqg1);
        }
        __syncthreads();
        transpose_v_tile(RAW + (size_t)(b * 256) * 4096 + l * 1024 + 512 + h * 128, 4096, (bf16_t*)(A.ws + WS_MVT) + (size_t)((l * BP + b) * 4 + h) * 128 * 256, lds, tid);
    }
}
constexpr int P_K = 0, P_Q = 17408, P_VB = 34816, P_KB = 52224, P_KD = 69632, P_LD = 87040, P_LB = 91136, P_DI = 100352, P_GR = 102400, P_BETA = 106496, P_GC = 107520,
    P_CW = 108544, P_WST = 114688, P_END = 132096;
DI void prep_load_cw(const float* cw, int h, LAS float* CW, int t0, int nt) {
    for (int v = t0; v < 4 * 3 * 32; v += nt) { const int c4 = v & 31, x = (v >> 5) % 3, i = v / 96; *(LAS f32x4*)(CW + (i * 3 + x) * 128 + 4 * c4) = *(const f32x4*)(cw + i * 1536 + x * 512 + h * 128 + 4 * c4); }
}
DI void prep_unit(const Args& A, LAS unsigned char* lds, int l, int u) {
    const int tid = otid(), lane = tid & 63, wave = __builtin_amdgcn_readfirstlane(tid >> 6), fr = lane & 15, fq = lane >> 4;
    const bool smp = u >= 1024;
    const int b = smp ? (u - 1024) : (u >> 6), c = smp ? 0 : (u & 63);
    const int row0 = smp ? MP + 16 * b : b * TP + 64 * c;
    const int chbase = smp ? 4096 + 4 * b : b * 256 + c, chstep = smp ? 1 : 64;
    const bf16_t* Z = (const bf16_t*)(A.ws + WS_Z); const bf16_t* XB = (const bf16_t*)(A.ws + WS_XB); const u64_t* SSQ = (const u64_t*)(A.ws + WS_SSQ) + (size_t)(3 * l) * MALL;
    bf16_t* PREP = (bf16_t*)(A.ws + WS_PREP); float* EG = (float*)(A.ws + WS_EG);
    LAS bf16_t* Ksh = (LAS bf16_t*)(lds + P_K); LAS bf16_t* Qsh = (LAS bf16_t*)(lds + P_Q); LAS bf16_t* VB = (LAS bf16_t*)(lds + P_VB); LAS bf16_t* KB = (LAS bf16_t*)(lds + P_KB);
    LAS bf16_t* KD = (LAS bf16_t*)(lds + P_KD); LAS float* LD = (LAS float*)(lds + P_LD); LAS bf16_t* LB = (LAS bf16_t*)(lds + P_LB); LAS bf16_t* DI_ = (LAS bf16_t*)(lds + P_DI);
    LAS float* GR = (LAS float*)(lds + P_WST);       LAS float* BETA = (LAS float*)(lds + P_BETA); LAS float* GC = (LAS float*)(lds + P_GC);
    LAS float* CW = (LAS float*)(lds + P_CW); LAS bf16_t* WST = (LAS bf16_t*)(lds + P_WST);
    const float* cw = A.in[I_GCW] + (size_t)l * 4 * 1536;
    {
        const int tw = wave & 3, kh = wave >> 2;
        const bf16_t* wg = (const bf16_t*)(A.ws + WS_WG8 + l * SZ_WG8) + (size_t)fr * DM + 8 * fq + 512 * kh;
        int tr = 16 * tw + fr; if (smp && tr >= 16) tr = 15;
        const bf16_t* xa = XB + (size_t)(row0 + tr) * DM + 8 * fq + 512 * kh;
        f32x4 acc = {0.f, 0.f, 0.f, 0.f};
#pragma unroll
        for (int ks = 0; ks < 16; ++ks) acc = MFMA16(*(const bf16x8*)(xa + 32 * ks), *(const bf16x8*)(wg + 32 * ks), acc);
#pragma unroll
        for (int e = 0; e < 4; ++e) GR[kh * 1024 + (16 * tw + 4 * fq + e) * 16 + fr] = acc[e];
    }
    prep_load_cw(cw, 0, CW, tid, NTHR);
    LBAR();
    if (tid < 256) {
        const int t = tid >> 2, h = tid & 3;
        int tr = t; if (smp && tr >= 16) tr = 15;
        const float rs = row_rstd(SSQ, row0 + tr);
        const float bt = sigmoidf_((GR[t * 16 + h] + GR[1024 + t * 16 + h]) * rs);
        const float a2 = (GR[t * 16 + 4 + h] + GR[1024 + t * 16 + 4 + h]) * rs + A.in[I_DTB][l * 4 + h];
        float g = -__expf(A.in[I_ALOG][l * 4 + h]) * softplusf_(a2);
        const bool pad = smp && t >= 16;
        BETA[h * 64 + t] = pad ? 0.f : bt; GC[h * 64 + t] = pad ? 0.f : g;
    } else if (smp || c == 63) {
        float* dst = smp ? A.out + O_SGC + (size_t)(l * BS + b) * 3 * 1536 : A.out + O_PGC + (size_t)(l * BP + b) * 3 * 1536;
        const int tl = smp ? 13 : 61;
        for (int e = tid - 256; e < 3 * 1536; e += 256) { const int j = e / 1536, col = e % 1536; dst[e] = bf2f(Z[(size_t)(row0 + tl + j) * NZ + col]); }
    }
    LBAR();
    if (wave < 4) {
        float v = GC[wave * 64 + lane];
#pragma unroll
        for (int o = 1; o < 64; o <<= 1) { const float up = __shfl_up(v, o); if (lane >= o) v += up; }
        GC[wave * 64 + lane] = v;
        if (lane == 63) EG[chbase + wave * chstep] = __expf(v);
    }
    LBAR();
    for (int h = 0; h < 4; ++h) {
        bf16_t* P = PREP + (size_t)(chbase + h * chstep) * PCH;
        if (h > 0) { bf16_t* Pp = PREP + (size_t)(chbase + (h - 1) * chstep) * PCH;
#pragma unroll
            for (int i = 0; i < 2; ++i) { const int v = tid + 512 * i, t = v >> 4, d8 = v & 15; *(u32x4*)(Pp + PW + ((((t >> 4) * 4 + (d8 >> 2)) * 64 + (d8 & 3) * 16 + (t & 15)) << 3)) = *(const LAS u32x4*)(WST + t * 136 + 8 * d8); } }
#pragma unroll 1
        for (int pass = 0; pass < 2; ++pass) {
            const int t = (tid >> 4) + 32 * pass, seg = tid & 15, cg = h * 128 + 8 * seg;
            const bool pad = smp && t >= 16;
            u32x4 zr[3][4];
#pragma unroll
            for (int x = 0; x < 3; ++x)
#pragma unroll
                for (int i = 0; i < 4; ++i) {
                    const int tt = t - 3 + i, col = x * 512 + cg;
                    if (tt >= 0 || (!smp && c > 0)) zr[x][i] = *(const u32x4*)(Z + (size_t)(row0 + tt) * NZ + col);
                    else if (smp) { const float* cp = A.in[I_CGC] + ((size_t)(l * BS + b) * 3 + (tt + 3)) * 1536 + col; float f[8];
                        const f32x4 q0 = *(const f32x4*)cp, q1 = *(const f32x4*)(cp + 4); f[0] = q0[0]; f[1] = q0[1]; f[2] = q0[2]; f[3] = q0[3]; f[4] = q1[0]; f[5] = q1[1]; f[6] = q1[2]; f[7] = q1[3]; zr[x][i] = pk8(f); }
                    else zr[x][i] = (u32x4){0u, 0u, 0u, 0u};
                }
            const float gct = GC[h * 64 + t], egt = __expf(gct), bt = BETA[h * 64 + t], ed = __expf(GC[h * 64 + 63] - gct);
#pragma unroll
            for (int x = 0; x < 3; ++x) {
                float acc[8];
#pragma unroll
                for (int j = 0; j < 8; ++j) acc[j] = 0.f;
#pragma unroll
                for (int i = 0; i < 4; ++i) {
                    float xv[8]; unpk8(zr[x][i], xv);
                    const f32x4 w0 = *(const LAS f32x4*)(CW + (i * 3 + x) * 128 + 8 * seg), w1 = *(const LAS f32x4*)(CW + (i * 3 + x) * 128 + 8 * seg + 4);
                    acc[0] += w0[0] * xv[0]; acc[1] += w0[1] * xv[1]; acc[2] += w0[2] * xv[2]; acc[3] += w0[3] * xv[3];
                    acc[4] += w1[0] * xv[4]; acc[5] += w1[1] * xv[5]; acc[6] += w1[2] * xv[6]; acc[7] += w1[3] * xv[7];
                }
                float ssum = 0.f;
#pragma unroll
                for (int j = 0; j < 8; ++j) { acc[j] = pad ? 0.f : siluf_(acc[j]); ssum += acc[j] * acc[j]; }
                ssum += __shfl_xor(ssum, 1); ssum += __shfl_xor(ssum, 2); ssum += __shfl_xor(ssum, 4); ssum += __shfl_xor(ssum, 8);
                const float rn = rsqrtf(ssum + EPS);
                if (x == 0) {
                    float qe[8];
#pragma unroll
                    for (int j = 0; j < 8; ++j) { acc[j] *= rn * 0.08838834764831845f; qe[j] = acc[j] * egt; }
                    *(LAS u32x4*)(Qsh + t * 136 + 8 * seg) = pk8(acc);
                    *(u32x4*)(P + PQE + ((((t >> 4) * 4 + (seg >> 2)) * 64 + (seg & 3) * 16 + (t & 15)) << 3)) = pk8(qe);
                } else if (x == 1) {
                    const float kb = bt * egt; float k1[8], k2[8];
#pragma unroll
                    for (int j = 0; j < 8; ++j) { acc[j] *= rn; k1[j] = acc[j] * kb; k2[j] = acc[j] * ed; }
                    *(LAS u32x4*)(Ksh + t * 136 + 8 * seg) = pk8(acc); *(LAS u32x4*)(KB + t * 136 + 8 * seg) = pk8(k1); *(LAS u32x4*)(KD + t * 136 + 8 * seg) = pk8(k2);
                } else {
#pragma unroll
                    for (int j = 0; j < 8; ++j) acc[j] *= bt;
                    *(LAS u32x4*)(VB + t * 136 + 8 * seg) = pk8(acc);
                }
            }
        }
        LBAR();
        {
#pragma unroll
            for (int i = 0; i < 2; ++i) { const int v = tid + 512 * i, d = v & 127, t8 = v >> 7; unsigned w[4];
#pragma unroll
                for (int j = 0; j < 4; ++j) w[j] = (unsigned)KD[(8 * t8 + 2 * j) * 136 + d] | ((unsigned)KD[(8 * t8 + 2 * j + 1) * 136 + d] << 16);
                *(u32x4*)(P + PKDT + ((((d >> 4) * 2 + (t8 >> 2)) * 64 + (t8 & 3) * 16 + (d & 15)) << 3)) = (u32x4){w[0], w[1], w[2], w[3]}; }
#pragma unroll
            for (int i = 0; i < 4; ++i) {
                const int id = wave + 8 * i, isqk = id >> 4, st = (id >> 2) & 3, tt = id & 3;
                f32x4 acc = {0.f, 0.f, 0.f, 0.f};
                if (st <= tt) {
                    const LAS bf16_t* ap = Ksh + (16 * st + fr) * 136 + 8 * fq;
                    const LAS bf16_t* bp = (isqk ? Qsh : Ksh) + (16 * tt + fr) * 136 + 8 * fq;
#pragma unroll
                    for (int ks = 0; ks < 4; ++ks) acc = MFMA16(*(const LAS bf16x8*)(ap + 32 * ks), *(const LAS bf16x8*)(bp + 32 * ks), acc);
                }
                const int t = 16 * tt + fr; const float gct = GC[h * 64 + t], bt = BETA[h * 64 + t];
                f32x4 o;
#pragma unroll
                for (int e = 0; e < 4; ++e) {
                    const int s = 16 * st + 4 * fq + e;
                    const float dec = __expf(fminf(gct - GC[h * 64 + s], 0.f));
                    if (isqk) o[e] = (s <= t) ? acc[e] * dec : 0.f;
                    else o[e] = (s < t) ? acc[e] * dec * bt : 0.f;
                }
                if (isqk) *(u32x2*)(P + PQK + (((tt * 2 + (st >> 1)) * 64 + (2 * (st & 1) + (fq >> 1)) * 16 + fr) << 3) + 4 * (fq & 1)) = pk4(o);
                else if (st == tt) *(LAS f32x4*)(LD + (st * 16 + fr) * 16 + 4 * fq) = o;
                else if (st < tt) *(LAS u32x2*)(LB + t * 72 + 16 * st + 4 * fq) = pk4(-o);
            }
        }
        LBAR();
        if (wave == 0) {
            const int blk = lane >> 4, cc = lane & 15;
            float x[16];
#pragma unroll
            for (int i = 0; i < 16; ++i) {
                float s = (i == cc) ? 1.f : 0.f;
                const LAS float* lr = LD + (blk * 16 + i) * 16;
#pragma unroll
                for (int j = 0; j < i; ++j) s -= lr[j] * x[j];
                x[i] = s;
            }
#pragma unroll
            for (int i = 0; i < 16; ++i) DI_[(blk * 16 + i) * 16 + cc] = f2bf(x[i]);
        } else if (h < 3) prep_load_cw(cw, h + 1, CW, tid - 64, 448);
        LBAR();
#pragma unroll
        for (int cti = 0; cti < 2; ++cti) {
            const int ct = 2 * wave + cti; const bool isw = ct >= 8; const int d = 16 * (ct & 7) + fr;
            const LAS bf16_t* rhs = (isw ? KB : VB) + d;
            bf16x4 Xb[4];
#pragma unroll
            for (int i = 0; i < 4; ++i) {
                f32x4 acc;
#pragma unroll
                for (int e = 0; e < 4; ++e) acc[e] = bf2f(rhs[(16 * i + 4 * fq + e) * 136]);
#pragma unroll
                for (int k = 0; k < i; ++k) acc = MFMA16K16(*(const LAS bf16x4*)(LB + (16 * i + fr) * 72 + 16 * k + 4 * fq), Xb[k], acc);
                const u32x2 ab = pk4(acc);
                const f32x4 xi = MFMA16K16(*(const LAS bf16x4*)(DI_ + (i * 16 + fr) * 16 + 4 * fq), __builtin_bit_cast(bf16x4, ab), ((f32x4){0.f, 0.f, 0.f, 0.f}));
                const u32x2 xb = pk4(xi); Xb[i] = __builtin_bit_cast(bf16x4, xb);
                if (!isw) *(u32x2*)(P + PUT + ((((ct & 7) * 4 + i) * 64 + fq * 16 + fr) << 2)) = xb;
                else {
                    WST[(16 * i + 4 * fq + 0) * 136 + d] = (bf16_t)(xb.x & 0xffffu); WST[(16 * i + 4 * fq + 1) * 136 + d] = (bf16_t)(xb.x >> 16);
                    WST[(16 * i + 4 * fq + 2) * 136 + d] = (bf16_t)(xb.y & 0xffffu); WST[(16 * i + 4 * fq + 3) * 136 + d] = (bf16_t)(xb.y >> 16);
                }
            }
        }
        LBAR();
    }
    { bf16_t* Pp = PREP + (size_t)(chbase + 3 * chstep) * PCH;
#pragma unroll
        for (int i = 0; i < 2; ++i) { const int v = tid + 512 * i, t = v >> 4, d8 = v & 15; *(u32x4*)(Pp + PW + ((((t >> 4) * 4 + (d8 >> 2)) * 64 + (d8 & 3) * 16 + (t & 15)) << 3)) = *(const LAS u32x4*)(WST + t * 136 + 8 * d8); } }
    LBAR();
}

constexpr int S_ST = 0, S_VN = 34816, S_NP = 53248;
struct ScanOps { bf16x8 Wf[4], QEf[4], QKf[2], KDf[2]; u32x2 Uf[4]; u32x2 gz[4]; float eg; };
DI void scan_load(ScanOps& o, const bf16_t* P, const bf16_t* Z, float egv, int row0, int h, int w, int tt, int dh, int fr, int fq, bool tok_ok) {
#pragma unroll
    for (int ks = 0; ks < 4; ++ks) { o.Wf[ks] = *(const bf16x8*)(P + PW + (((tt * 4 + ks) * 64 + fq * 16 + fr) << 3)); o.QEf[ks] = *(const bf16x8*)(P + PQE + (((tt * 4 + ks) * 64 + fq * 16 + fr) << 3)); }
#pragma unroll
    for (int ks = 0; ks < 2; ++ks) { o.QKf[ks] = *(const bf16x8*)(P + PQK + (((tt * 2 + ks) * 64 + fq * 16 + fr) << 3)); o.KDf[ks] = *(const bf16x8*)(P + PKDT + (((w * 2 + ks) * 64 + fq * 16 + fr) << 3)); }
#pragma unroll
    for (int j = 0; j < 4; ++j) o.Uf[j] = *(const u32x2*)(P + PUT + ((((4 * dh + j) * 4 + tt) * 64 + fq * 16 + fr) << 2));
    { int gr = row0 + 16 * tt + fr; gr = gr < MALL ? gr : MALL - 1;
#pragma unroll
        for (int j = 0; j < 4; ++j) o.gz[j] = *(const u32x2*)(Z + (size_t)gr * NZ + ZG + h * 128 + 16 * (4 * dh + j) + 4 * fq); }
    o.eg = egv;
}
template <bool SMP>
DI void scan_step(const ScanOps& o, f32x4 (&S)[8], LAS bf16_t* ST, LAS bf16_t* VN, LAS float* NP, bf16_t* Y, const f32x4 (&gn4)[4], int row0, int h, int w, int tt, int dh, int fr, int fq, bool tok_ok) {
    f32x4 accO[4];
#pragma unroll
    for (int j = 0; j < 4; ++j) {
        const int dt = 4 * dh + j;
        f32x4 accV = {0.f, 0.f, 0.f, 0.f}; accO[j] = (f32x4){0.f, 0.f, 0.f, 0.f};
#pragma unroll
        for (int ks = 0; ks < 4; ++ks) {
            const bf16x8 B = *(const LAS bf16x8*)(ST + (16 * dt + fr) * 136 + 32 * ks + 8 * fq);
            accV = MFMA16(o.Wf[ks], B, accV); accO[j] = MFMA16(B, o.QEf[ks], accO[j]);
        }
        const f32x4 vn = unpk4(o.Uf[j]) - accV;
        *(LAS u32x2*)(VN + (16 * dt + fr) * 72 + 16 * tt + 4 * fq) = pk4(vn);
    }
    LBAR();
#pragma unroll
    for (int j = 0; j < 4; ++j) {
        const int dt = 4 * dh + j;
#pragma unroll
        for (int ks = 0; ks < 2; ++ks) accO[j] = MFMA16(*(const LAS bf16x8*)(VN + (16 * dt + fr) * 72 + 32 * ks + 8 * fq), o.QKf[ks], accO[j]);
    }
    {
        float p = 0.f;
#pragma unroll
        for (int j = 0; j < 4; ++j) p += (accO[j][0] * accO[j][0] + accO[j][1] * accO[j][1]) + (accO[j][2] * accO[j][2] + accO[j][3] * accO[j][3]);
        p += __shfl_xor(p, 16); p += __shfl_xor(p, 32);
        if (fq == 0) NP[(16 * tt + fr) * 2 + dh] = p;
    }
#pragma unroll
    for (int dt = 0; dt < 8; ++dt) {
        S[dt] = S[dt] * o.eg;
#pragma unroll
        for (int ks = 0; ks < 2; ++ks) S[dt] = MFMA16(o.KDf[ks], *(const LAS bf16x8*)(VN + (16 * dt + fr) * 72 + 32 * ks + 8 * fq), S[dt]);
        *(LAS u32x2*)(ST + (16 * dt + fr) * 136 + 16 * w + 4 * fq) = pk4(S[dt]);
    }
    LBAR();
    if (!SMP || tok_ok) {
        const int t = 16 * tt + fr;
        const float rs = rsqrtf((NP[t * 2] + NP[t * 2 + 1]) * (1.0f / 128.0f) + EPS);
        bf16_t* yp = Y + (size_t)(row0 + t) * DM + h * 128 + 4 * fq;
#pragma unroll
        for (int j = 0; j < 4; ++j) {
            const f32x4 g4 = gn4[j]; const f32x4 z4 = unpk4(o.gz[j]);
            f32x4 v;
#pragma unroll
            for (int e = 0; e < 4; ++e) v[e] = accO[j][e] * rs * g4[e] * siluf_(z4[e]);
            *(u32x2*)(yp + 16 * (4 * dh + j)) = pk4(v);
        }
    }
}
DI void scan_item(const Args& A, LAS unsigned char* lds, int l, int item) {
    const int tid = otid(), lane = tid & 63, w = __builtin_amdgcn_readfirstlane(tid >> 6), fr = lane & 15, fq = lane >> 4, tt = w & 3, dh = w >> 2;
    const bool smp = item >= 64;
    const int b = smp ? ((item - 64) >> 2) : (item >> 2), h = item & 3, nsteps = smp ? 1 : 64;
    const bf16_t* Z = (const bf16_t*)(A.ws + WS_Z); bf16_t* Y = (bf16_t*)(A.ws + WS_Y);
    const bf16_t* PREP = (const bf16_t*)(A.ws + WS_PREP); const float* EG = (const float*)(A.ws + WS_EG);
    LAS bf16_t* ST = (LAS bf16_t*)(lds + S_ST); LAS bf16_t* VN = (LAS bf16_t*)(lds + S_VN); LAS float* NP = (LAS float*)(lds + S_NP);
    f32x4 gn4[4];
#pragma unroll
    for (int j = 0; j < 4; ++j) gn4[j] = *(const f32x4*)(A.in[I_GNG] + l * 128 + 16 * (4 * dh + j) + 4 * fq);
    const bool tok_ok = !smp || tt == 0;
    f32x4 S[8];
    if (smp) {
        const float* s0 = A.in[I_STATE] + (size_t)((l * BS + b) * 4 + h) * 128 * 128;
#pragma unroll
        for (int dt = 0; dt < 8; ++dt)
#pragma unroll
            for (int e = 0; e < 4; ++e) S[dt][e] = s0[(size_t)(16 * w + 4 * fq + e) * 128 + 16 * dt + fr];
    } else {
#pragma unroll
        for (int dt = 0; dt < 8; ++dt) S[dt] = (f32x4){0.f, 0.f, 0.f, 0.f};
    }
#pragma unroll
    for (int dt = 0; dt < 8; ++dt) *(LAS u32x2*)(ST + (16 * dt + fr) * 136 + 16 * w + 4 * fq) = pk4(S[dt]);
    const int ch0 = smp ? 4096 + 4 * b + h : (b * 4 + h) * 64;
    const int r00 = smp ? MP + 16 * b : b * TP;
    int zv = 0; asm volatile("" : "+v"(zv));
    const float* EGv = EG + zv;
    ScanOps oa, ob;
    if (smp) {
        scan_load(oa, PREP + (size_t)ch0 * PCH, Z, EGv[ch0], r00, h, w, tt, dh, fr, fq, tok_ok);
        __syncthreads();
        scan_step<true>(oa, S, ST, VN, NP, Y, gn4, r00, h, w, tt, dh, fr, fq, tok_ok);
    } else {
        scan_load(oa, PREP + (size_t)ch0 * PCH, Z, EGv[ch0], r00, h, w, tt, dh, fr, fq, true);
        __syncthreads();
#pragma unroll 1
        for (int c = 0; c < 64; c += 2) {
            scan_load(ob, PREP + (size_t)(ch0 + (c + 1)) * PCH, Z, EGv[ch0 + (c + 1)], r00 + 64 * (c + 1), h, w, tt, dh, fr, fq, true);
            scan_step<false>(oa, S, ST, VN, NP, Y, gn4, r00 + 64 * c, h, w, tt, dh, fr, fq, true);
            const int cn = c + 2 < 64 ? c + 2 : 63;
            scan_load(oa, PREP + (size_t)(ch0 + cn) * PCH, Z, EGv[ch0 + cn], r00 + 64 * cn, h, w, tt, dh, fr, fq, true);
            scan_step<false>(ob, S, ST, VN, NP, Y, gn4, r00 + 64 * (c + 1), h, w, tt, dh, fr, fq, true);
        }
    }
    float* so = (smp ? A.out + O_SGS + (size_t)((l * BS + b) * 4 + h) * 128 * 128 : A.out + O_PGS + (size_t)((l * BP + b) * 4 + h) * 128 * 128);
#pragma unroll
    for (int dt = 0; dt < 8; ++dt)
#pragma unroll
        for (int e = 0; e < 4; ++e) so[(size_t)(16 * w + 4 * fq + e) * 128 + 16 * dt + fr] = S[dt][e];
    __syncthreads();
}
constexpr float SB_CUT = 50.0f;
DI float neg_softplus(float z) {
    const float e = __builtin_amdgcn_exp2f(-fabsf(z) * 1.4426950408889634f);
    return -(fmaxf(z, 0.f) + __builtin_amdgcn_logf(1.0f + e) * 0.6931471805599453f);
}
template <bool SMP>
DI void sb_wave_unit(const Args& A, int l, int idx, int lane) {
    const int qi = lane & 31, hi = lane >> 5;
    const bf16_t* Z = (const bf16_t*)(A.ws + WS_Z); bf16_t* Y = (bf16_t*)(A.ws + WS_Y);
    int h, qrow, t0, b;
    bool qvalid = true;
    if (SMP) { b = idx >> 2; h = idx & 3; t0 = 0; qvalid = qi < TS; qrow = MP + TS * b + (qvalid ? qi : TS - 1); }
    else { h = idx & 3; const int qt = (idx >> 2) & 127; b = idx >> 9; t0 = 32 * qt; qrow = b * TP + t0 + qi; }
    bf16x8 Qf[4];
#pragma unroll
    for (int s = 0; s < 4; ++s) Qf[s] = *(const bf16x8*)(Z + (size_t)qrow * NZ + ZCQ + h * 64 + 16 * s + 8 * hi);
    f32x16 o0, o1;
#pragma unroll
    for (int r = 0; r < 16; ++r) { o0[r] = 0.f; o1[r] = 0.f; }
    float R = 0.f;
    const int nblk = SMP ? 1 + PAST / 32 : (t0 >> 5) + 1;
    const float* ck = SMP ? A.in[I_CSBK] + (size_t)(l * BS + b) * PAST * 256 + h * 64 : nullptr;
    const float* cv = SMP ? A.in[I_CSBV] + (size_t)(l * BS + b) * PAST * 256 + h * 64 : nullptr;
    for (int blk = 0; blk < nblk; ++blk) {
        const bool first = blk == 0;
        const bool from_z = !SMP || first;
        const int kbase = SMP ? (first ? 0 : PAST - 32 * blk) : t0 - 32 * blk;
        f32x16 acc;
#pragma unroll
        for (int r = 0; r < 16; ++r) acc[r] = 0.f;
        if (from_z) {
            int kr = kbase + qi; if (SMP && kr >= TS) kr = TS - 1;
            const bf16_t* kp = Z + (size_t)((SMP ? MP + TS * b : b * TP) + kr) * NZ + ZCK + h * 64 + 8 * hi;
#pragma unroll
            for (int s = 0; s < 4; ++s) acc = MFMA32(*(const bf16x8*)(kp + 16 * s), Qf[s], acc);
        } else {
            const float* kp = ck + (size_t)(kbase + qi) * 256 + 8 * hi;
#pragma unroll
            for (int s = 0; s < 4; ++s) { const f32x4 a = *(const f32x4*)(kp + 16 * s), c4 = *(const f32x4*)(kp + 16 * s + 4);
                u32x4 kf; kf.x = pk2(a[0], a[1]); kf.y = pk2(a[2], a[3]); kf.z = pk2(c4[0], c4[1]); kf.w = pk2(c4[2], c4[3]);
                acc = MFMA32(__builtin_bit_cast(bf16x8, kf), Qf[s], acc); }
        }
        float lb[16]; float gs[4];
#pragma unroll
        for (int r = 0; r < 16; ++r) {
            const int kl = (r & 3) + 8 * (r >> 2) + 4 * hi;
            const bool valid = first ? (SMP ? (kl < qi && kl < TS) : (kl < qi)) : true;
            acc[r] *= 0.125f;
            lb[r] = valid ? neg_softplus(acc[r]) : 0.f;
        }
#pragma unroll
        for (int g = 0; g < 4; ++g) gs[g] = (lb[4 * g] + lb[4 * g + 1]) + (lb[4 * g + 2] + lb[4 * g + 3]);
        float og[4];
#pragma unroll
        for (int g = 0; g < 4; ++g) og[g] = __shfl_xor(gs[g], 32);
        float off[4]; float run = 0.f;
#pragma unroll
        for (int g = 3; g >= 0; --g) {
            if (hi == 0) { run += og[g]; off[g] = run; run += gs[g]; }
            else { off[g] = run; run += gs[g] + og[g]; }
        }
        const float tot = (gs[0] + gs[1]) + (gs[2] + gs[3]) + (og[0] + og[1]) + (og[2] + og[3]);
        float p[16];
#pragma unroll
        for (int g = 0; g < 4; ++g) {
            float c = R + off[g];
#pragma unroll
            for (int e = 3; e >= 0; --e) {
                const int r = 4 * g + e; const int kl = (r & 3) + 8 * (r >> 2) + 4 * hi;
                const bool valid = first ? (SMP ? (kl < qi && kl < TS) : (kl < qi)) : true;
                p[r] = valid ? __builtin_amdgcn_exp2f((acc[r] + lb[r] + c) * 1.4426950408889634f) : 0.f;
                c += lb[r];
            }
        }
        R += tot;
#pragma unroll
        for (int s = 0; s < 2; ++s) {
            u32x4 pf; pf.x = pk2(p[8 * s], p[8 * s + 1]); pf.y = pk2(p[8 * s + 2], p[8 * s + 3]); pf.z = pk2(p[8 * s + 4], p[8 * s + 5]); pf.w = pk2(p[8 * s + 6], p[8 * s + 7]);
            const bf16x8 pb = __builtin_bit_cast(bf16x8, pf);
#pragma unroll
            for (int dt = 0; dt < 2; ++dt) {
                float vv[8];
#pragma unroll
                for (int j = 0; j < 8; ++j) {
                    const int kl = 16 * s + 8 * (j >> 2) + 4 * hi + (j & 3);
                    if (from_z) { int kr = kbase + kl; if (SMP && kr >= TS) kr = TS - 1;
                        vv[j] = bf2f(Z[(size_t)((SMP ? MP + TS * b : b * TP) + kr) * NZ + ZCV + h * 64 + 32 * dt + qi]); }
                    else vv[j] = cv[(size_t)(kbase + kl) * 256 + 32 * dt + qi];
                }
                const u32x4 vf = pk8(vv);
                if (dt == 0) o0 = MFMA32(__builtin_bit_cast(bf16x8, vf), pb, o0); else o1 = MFMA32(__builtin_bit_cast(bf16x8, vf), pb, o1);
            }
        }
        if (__all(R < -SB_CUT)) break;
    }
    float ss = 0.f;
#pragma unroll
    for (int r = 0; r < 16; ++r) ss += o0[r] * o0[r] + o1[r] * o1[r];
    ss += __shfl_xor(ss, 32);
    const float rs = rsqrtf(ss * (1.0f / 64.0f) + EPS);
    if (qvalid) {
        const float* g = A.in[I_SBG] + l * 256 + h * 64;
        bf16_t* yp = Y + (size_t)qrow * DM + 768 + h * 64;
#pragma unroll
        for (int dt = 0; dt < 2; ++dt)
#pragma unroll
            for (int g4 = 0; g4 < 4; ++g4) {
                const int d = 32 * dt + 8 * g4 + 4 * hi;
                const f32x4 gg = *(const f32x4*)(g + d);
                f32x4 v;
#pragma unroll
                for (int e = 0; e < 4; ++e) v[e] = (dt == 0 ? o0[4 * g4 + e] : o1[4 * g4 + e]) * rs * gg[e];
                *(u32x2*)(yp + d) = pk4(v);
            }
    }
}

DI void sc_task(const Args& A, int l, int task) {
    const int cgi = task & 31, seg = task >> 5, r0 = 16 * seg, c0 = 8 * cgi;
    const bf16_t* Z = (const bf16_t*)(A.ws + WS_Z); bf16_t* Y = (bf16_t*)(A.ws + WS_Y);
    const bool smp = r0 >= MP; const int t0 = smp ? 0 : (r0 & (TP - 1)), T = smp ? TS : TP, bb = smp ? (r0 - MP) / TS : r0 / TP;
    float w0[8], w1[8], w2[8], gn[8], p2[8], p1[8];
    const float* cw = A.in[I_SCW] + (size_t)l * 3 * 256 + c0;
#pragma unroll
    for (int j = 0; j < 8; ++j) { w0[j] = cw[j]; w1[j] = cw[256 + j]; w2[j] = cw[512 + j]; gn[j] = A.in[I_SCG][l * 256 + c0 + j]; }
    if (t0 == 0) {
        if (smp) { const float* cp = A.in[I_CSC] + (size_t)(l * BS + bb) * 2 * 256 + c0;
#pragma unroll
            for (int j = 0; j < 8; ++j) { p2[j] = cp[j]; p1[j] = cp[256 + j]; } }
        else {
#pragma unroll
            for (int j = 0; j < 8; ++j) { p2[j] = 0.f; p1[j] = 0.f; } }
    } else {
        float a[8], c[8];
        unpk8(*(const u32x4*)(Z + (size_t)(r0 - 2) * NZ + ZSC + c0), a); unpk8(*(const u32x4*)(Z + (size_t)(r0 - 2) * NZ + ZSX + c0), c);
#pragma unroll
        for (int j = 0; j < 8; ++j) p2[j] = a[j] * c[j];
        unpk8(*(const u32x4*)(Z + (size_t)(r0 - 1) * NZ + ZSC + c0), a); unpk8(*(const u32x4*)(Z + (size_t)(r0 - 1) * NZ + ZSX + c0), c);
#pragma unroll
        for (int j = 0; j < 8; ++j) p1[j] = a[j] * c[j];
    }
    for (int i = 0; i < 16; ++i) {
        const bf16_t* zr = Z + (size_t)(r0 + i) * NZ;
        float sb[8], sc[8], sx[8], y[8];
        unpk8(*(const u32x4*)(zr + ZSB + c0), sb); unpk8(*(const u32x4*)(zr + ZSC + c0), sc); unpk8(*(const u32x4*)(zr + ZSX + c0), sx);
        float ss = 0.f;
#pragma unroll
        for (int j = 0; j < 8; ++j) { const float xs = sc[j] * sx[j]; const float uu = w0[j] * p2[j] + w1[j] * p1[j] + w2[j] * xs; p2[j] = p1[j]; p1[j] = xs; y[j] = sb[j] * uu; ss += y[j] * y[j]; }
        ss += __shfl_xor(ss, 1); ss += __shfl_xor(ss, 2); ss += __shfl_xor(ss, 4);
        const float rs = rsqrtf(ss * (1.0f / 64.0f) + EPS);
#pragma unroll
        for (int j = 0; j < 8; ++j) y[j] *= rs * gn[j];
        *(u32x4*)(Y + (size_t)(r0 + i) * DM + 512 + c0) = pk8(y);
    }
    if (t0 + 16 == T) {
        float* dst = smp ? A.out + O_SSC + (size_t)(l * BS + bb) * 2 * 256 + c0 : A.out + O_PSC + (size_t)(l * BP + bb) * 2 * 256 + c0;
#pragma unroll
        for (int j = 0; j < 8; ++j) { dst[j] = p2[j]; dst[256 + j] = p1[j]; }
    }
}

constexpr int MA_K = 0, MA_VT = 69632;
DI void memattn_load_kv(const bf16_t* K, const bf16_t* VT, LAS unsigned char* lds, int tid) {
    LAS bf16_t* Ks = (LAS bf16_t*)(lds + MA_K); LAS bf16_t* Vs = (LAS bf16_t*)(lds + MA_VT);
#pragma unroll
    for (int i = 0; i < 8; ++i) { const int v = tid + 512 * i, n = v >> 4, d8 = v & 15; *(LAS u32x4*)(Ks + n * 136 + 8 * d8) = *(const u32x4*)(K + (size_t)n * 128 + 8 * d8); }
#pragma unroll
    for (int i = 0; i < 8; ++i) { const int v = tid + 512 * i, d = v >> 5, n8 = v & 31; *(LAS u32x4*)(Vs + d * 264 + 8 * n8) = *(const u32x4*)(VT + (size_t)d * 256 + 8 * n8); }
}
DI void memattn_wave(const bf16_t* QM, bf16_t* OM, int qrow, bool qvalid, int h, LAS unsigned char* lds, int lane) {
    const int ql = lane & 31, hi = lane >> 5;
    const LAS bf16_t* Ks = (const LAS bf16_t*)(lds + MA_K); const LAS bf16_t* Vs = (const LAS bf16_t*)(lds + MA_VT);
    bf16x8 Qf[8]; float ssq = 0.f;
#pragma unroll
    for (int s = 0; s < 8; ++s) { const u32x4 q = *(const u32x4*)(QM + (size_t)qrow * 512 + h * 128 + 16 * s + 8 * hi); Qf[s] = __builtin_bit_cast(bf16x8, q);
        float f[8]; unpk8(q, f);
#pragma unroll
        for (int j = 0; j < 8; ++j) ssq += f[j] * f[j]; }
    ssq += __shfl_xor(ssq, 32);
    const float sc2 = rsqrtf(ssq * (1.0f / 128.0f) + EPS) * 0.08838834764831845f * 1.4426950408889634f;
    float mx = -3.0e38f;
#pragma unroll 2
    for (int mt = 0; mt < 8; ++mt) {
        f32x16 s1;
#pragma unroll
        for (int r = 0; r < 16; ++r) s1[r] = 0.f;
#pragma unroll
        for (int s = 0; s < 8; ++s) s1 = MFMA32(*(const LAS bf16x8*)(Ks + (32 * mt + ql) * 136 + 16 * s + 8 * hi), Qf[s], s1);
#pragma unroll
        for (int r = 0; r < 16; ++r) mx = fmaxf(mx, s1[r]);
    }
    mx = fmaxf(mx, __shfl_xor(mx, 32));
    float sum = 0.f;
    f32x16 o[4];
#pragma unroll
    for (int dt = 0; dt < 4; ++dt)
#pragma unroll
        for (int r = 0; r < 16; ++r) o[dt][r] = 0.f;
#pragma unroll 1
    for (int mt = 0; mt < 8; ++mt) {
        f32x16 s1;
#pragma unroll
        for (int r = 0; r < 16; ++r) s1[r] = 0.f;
#pragma unroll
        for (int s = 0; s < 8; ++s) s1 = MFMA32(*(const LAS bf16x8*)(Ks + (32 * mt + ql) * 136 + 16 * s + 8 * hi), Qf[s], s1);
#pragma unroll
        for (int r = 0; r < 16; ++r) { s1[r] = __builtin_amdgcn_exp2f((s1[r] - mx) * sc2); sum += s1[r]; }
#pragma unroll
        for (int s = 0; s < 2; ++s) {
            u32x4 pf; pf.x = pk2(s1[8 * s], s1[8 * s + 1]); pf.y = pk2(s1[8 * s + 2], s1[8 * s + 3]); pf.z = pk2(s1[8 * s + 4], s1[8 * s + 5]); pf.w = pk2(s1[8 * s + 6], s1[8 * s + 7]);
            const bf16x8 pb = __builtin_bit_cast(bf16x8, pf);
#pragma unroll
            for (int dt = 0; dt < 4; ++dt) {
                const LAS bf16_t* vp = Vs + (32 * dt + ql) * 264 + 32 * mt + 16 * s + 4 * hi;
                u32x4 vf; const u32x2 a = *(const LAS u32x2*)vp, c = *(const LAS u32x2*)(vp + 8); vf.x = a.x; vf.y = a.y; vf.z = c.x; vf.w = c.y;
                o[dt] = MFMA32(__builtin_bit_cast(bf16x8, vf), pb, o[dt]);
            }
        }
    }
    sum += __shfl_xor(sum, 32);
    const float inv = 1.0f / sum;
    if (qvalid) {
        bf16_t* op = OM + (size_t)qrow * 512 + h * 128;
#pragma unroll
        for (int dt = 0; dt < 4; ++dt)
#pragma unroll
            for (int g4 = 0; g4 < 4; ++g4) {
                f32x4 v;
#pragma unroll
                for (int e = 0; e < 4; ++e) v[e] = o[dt][4 * g4 + e] * inv;
                *(u32x2*)(op + 32 * dt + 8 * g4 + 4 * hi) = pk4(v);
            }
    }
}
DI void phase_memattn(const Args& A, LAS unsigned char* lds, int l) {
    const int tid = otid(), lane = tid & 63, wave = tid >> 6, G = gridDim.x;
    const bf16_t* QM = (const bf16_t*)(A.ws + WS_QM); bf16_t* OM = (bf16_t*)(A.ws + WS_OM);
    for (int u = blockIdx.x; u < BS * 4; u += G) {
        const int sb = u >> 2, h = u & 3;
        __syncthreads();
        memattn_load_kv((const bf16_t*)(A.ws + WS_SMK) + (size_t)((l * BS + sb) * 4 + h) * 256 * 128, (const bf16_t*)(A.ws + WS_SMVT) + (size_t)((l * BS + sb) * 4 + h) * 128 * 256, lds, tid);
        __syncthreads();
        if (wave == 0) { const int ql = lane & 31; const bool ok = ql < TS; memattn_wave(QM, OM, MP + TS * sb + (ok ? ql : TS - 1), ok, h, lds, lane); }
    }
    const int NU = BP * 4 * 16, per = (NU + G - 1) / G;
    int cur = -1;
    for (int u = blockIdx.x * per; u < NU && u < (blockIdx.x + 1) * per; ++u) {
        const int qt = u & 15, bh = u >> 4, b = bh >> 2, h = bh & 3;
        if (bh != cur) {
            __syncthreads();
            memattn_load_kv((const bf16_t*)(A.ws + WS_MK) + (size_t)((l * BP + b) * 4 + h) * 256 * 128, (const bf16_t*)(A.ws + WS_MVT) + (size_t)((l * BP + b) * 4 + h) * 128 * 256, lds, tid);
            __syncthreads();
            cur = bh;
        }
        memattn_wave(QM, OM, b * TP + 256 * qt + 32 * wave + (lane & 31), true, h, lds, lane);
    }
    __syncthreads();
}

DI void act_task(const Args& A, int l, int task) {
    const int cgi = task % 352, seg = task / 352, r0 = 16 * seg, c0 = 8 * cgi;
    const bf16_t* GU = (const bf16_t*)(A.ws + WS_GU); bf16_t* ACT = (bf16_t*)(A.ws + WS_ACT);
    const bool smp = r0 >= MP; const int t0 = smp ? 0 : (r0 & (TP - 1)), T = smp ? TS : TP, bb = smp ? (r0 - MP) / TS : r0 / TP;
    float w0[8], w1[8], w2[8], p2[8], p1[8];
    const float* cw = A.in[I_FCW] + (size_t)l * 3 * DFF + c0;
#pragma unroll
    for (int j = 0; j < 8; ++j) { w0[j] = cw[j]; w1[j] = cw[DFF + j]; w2[j] = cw[2 * DFF + j]; }
    if (t0 == 0) {
        if (smp) { const float* cp = A.in[I_CFC] + (size_t)(l * BS + bb) * 2 * DFF + c0;
#pragma unroll
            for (int j = 0; j < 8; ++j) { p2[j] = cp[j]; p1[j] = cp[DFF + j]; } }
        else {
#pragma unroll
            for (int j = 0; j < 8; ++j) { p2[j] = 0.f; p1[j] = 0.f; } }
    } else { unpk8(*(const u32x4*)(GU + (size_t)(r0 - 2) * NGU + c0), p2); unpk8(*(const u32x4*)(GU + (size_t)(r0 - 1) * NGU + c0), p1); }
#pragma unroll 4
    for (int i = 0; i < 16; ++i) {
        const bf16_t* gr = GU + (size_t)(r0 + i) * NGU + c0;
        float g[8], up[8], y[8];
        unpk8(*(const u32x4*)gr, g); unpk8(*(const u32x4*)(gr + DFF), up);
#pragma unroll
        for (int j = 0; j < 8; ++j) { const float gt = w0[j] * p2[j] + w1[j] * p1[j] + w2[j] * g[j]; p2[j] = p1[j]; p1[j] = g[j]; y[j] = siluf_(gt) * up[j]; }
        *(u32x4*)(ACT + (size_t)(r0 + i) * DFF + c0) = pk8(y);
    }
    if (t0 + 16 == T) {
        float* dst = smp ? A.out + O_SFC + (size_t)(l * BS + bb) * 2 * DFF + c0 : A.out + O_PFC + (size_t)(l * BP + bb) * 2 * DFF + c0;
#pragma unroll
        for (int j = 0; j < 8; ++j) { dst[j] = p2[j]; dst[DFF + j] = p1[j]; }
    }
}
#ifndef MK_ONE_LAUNCH
#define MK_ONE_LAUNCH 1
#endif
constexpr int NPH = 3 + 9 * NL;
#ifndef PHMASK
#define PHMASK 0xFFFF
#endif
#define PHX(k) (((PHMASK) >> (k)) & 1)
#ifndef DUP_KIND
#define DUP_KIND -1
#endif
#define REPS(k) ((DUP_KIND == (k)) ? 2 : 1)
__global__ void __launch_bounds__(NTHR, 2) hse_fwd(Args A) {
    extern __shared__ __attribute__((aligned(16))) unsigned char smem[];
    LAS unsigned char* lds = (LAS unsigned char*)smem;
    volatile LAS unsigned* MISC = (volatile LAS unsigned*)(lds + MISC_OFF);
    const int tid0 = threadIdx.x, G = gridDim.x;
    for (int u = tid0; u < (LDS_BYTES - MISC_OFF) / 4; u += NTHR) ((LAS unsigned*)(lds + MISC_OFF))[u] = 0u;
    __syncthreads();
    unsigned* ctl = (unsigned*)(A.ws + WS_CTL);
    XcdBarrier bar; bar.bar = ctl + CW_BAR; bar.x = 0; bar.st = nullptr;
    const int lo = A.ph_lo, hi = A.ph_hi;
    if (hi - lo > 1) bar = xcd_barrier_post(ctl + CW_BAR, MISC + 8);
#define IN(k) (lo <= (k) && (k) < hi)
#define SEAM(k) do { if (IN(k) && IN((k) + 1)) xcd_barrier(bar); } while (0)
    unsigned char* ws = A.ws;
    bf16_t* XB = (bf16_t*)(ws + WS_XB); u64_t* SSQ0 = (u64_t*)(ws + WS_SSQ);

    if (PHX(0) && IN(0)) { for (int rep = 0; rep < REPS(0); ++rep) { phase_convert(A, lds); __syncthreads(); } }
    SEAM(0);
    if (PHX(1) && IN(1)) { for (int rep = 0; rep < REPS(1); ++rep) {
        pg8::Gemm g{(const bf16_t*)(ws + WS_MEMB), (const bf16_t*)(ws + WS_WMKV), 4096, 4096, DM}; pg8::StaticOrder S; S.init(4096, 4096, ogrid(), obid());
        EpiScaleF32 E{(float*)(ws + WS_RAWKV), 4096, (const float*)(ws + WS_SSQM)};
        pg8::gemm_phase<EpiScaleF32, pg8::StaticOrder, true, true>(lds, g, S, E);
        __syncthreads(); } }
    SEAM(1);
    if (PHX(2) && IN(2)) { for (int rep = 0; rep < REPS(2); ++rep) { phase_memkv_post(A, lds); __syncthreads(); } }
    SEAM(2);

    for (int l = 0; l < NL; ++l) {
        const int pb = 3 + 9 * l;
        u64_t* SSQ = SSQ0 + (size_t)(3 * l) * MALL;
        if (PHX(3) && IN(pb + 0)) { for (int rep = 0; rep < REPS(3); ++rep) {
            pg8::Gemm g{XB, (const bf16_t*)(ws + WS_WIN + l * SZ_WIN), MALL, NZ, DM}; pg8::StaticOrder S; S.init(MALL, NZ, ogrid(), obid());
            EpiScaleBf16 E{(bf16_t*)(ws + WS_Z), NZ, SSQ, 12, 13, A.out + O_PSK + (size_t)l * MP * 256, A.out + O_SSK + (size_t)l * MS * 256, A.out + O_PSV + (size_t)l * MP * 256, A.out + O_SSV + (size_t)l * MS * 256};
            pg8::gemm_phase<EpiScaleBf16, pg8::StaticOrder, true, true>(lds, g, S, E);
            __syncthreads(); } }
        SEAM(pb + 0);
        if (PHX(4) && IN(pb + 1)) { for (int rep = 0; rep < REPS(4); ++rep) {
            unsigned* cnt = ctl + 2048 + 64 * l;
            for (;;) {
                if (threadIdx.x == 0) MISC[12] = atomicAdd(cnt, 1u);
                __syncthreads();
                const int u = (int)MISC[12];
                __syncthreads();
                if (u >= 1024) break;
                prep_unit(A, lds, l, u);
            }
            __syncthreads(); } }
        SEAM(pb + 1);
        if (PHX(5) && IN(pb + 2)) { for (int rep = 0; rep < REPS(5); ++rep) {
            for (int r2 = 0; r2 < REPS(14); ++r2) for (int it = blockIdx.x; it < 64 + BS; it += G) {
                if (it < 64) scan_item(A, lds, l, it);
                else { prep_unit(A, lds, l, 1024 + (it - 64)); __threadfence_block(); VM_WAIT(); __syncthreads();
                       for (int hh = 0; hh < 4; ++hh) scan_item(A, lds, l, 64 + 4 * (it - 64) + hh); }
            }
            const int nhead = G > 128 ? 64 : 0;
            if ((int)blockIdx.x >= nhead) {
                const int tid = otid(), lane = tid & 63, wave = __builtin_amdgcn_readfirstlane(tid >> 6);
                const int wb = blockIdx.x - nhead, NWB = G - nhead;
                for (int r2 = 0; r2 < REPS(13); ++r2) {
                for (int i = wb * NWAVES + wave; i < BS * 4; i += NWB * NWAVES) sb_wave_unit<true>(A, l, i, lane);
                for (int i = wb * NWAVES + wave; i < BP * 128 * 4; i += NWB * NWAVES) sb_wave_unit<false>(A, l, i, lane);
                for (int t = wb * NTHR + tid; t < (MALL / 16) * 32; t += NWB * NTHR) sc_task(A, l, t);
                }
            }
            __syncthreads(); } }
        SEAM(pb + 2);
        if (PHX(6) && IN(pb + 3)) { for (int rep = 0; rep < REPS(6); ++rep) {
            pg8::Gemm g{(const bf16_t*)(ws + WS_Y), (const bf16_t*)(ws + WS_WMIX + l * SZ_WMIX), MALL, DM, DM}; pg8::StaticOrder S; S.init(MALL, DM, ogrid(), obid());
            EpiResid E{A.out, XB, SSQ + MALL, 0};
            pg8::gemm_phase<EpiResid, pg8::StaticOrder, true, true>(lds, g, S, E);
            __syncthreads(); } }
        SEAM(pb + 3);
        if (PHX(7) && IN(pb + 4)) { for (int rep = 0; rep < REPS(7); ++rep) {
            pg8::Gemm g{XB, (const bf16_t*)(ws + WS_WMQ + l * SZ_WMQ), MALL, 512, DM}; pg8::StaticOrder S; S.init(MALL, 512, ogrid(), obid());
            EpiScaleBf16 E{(bf16_t*)(ws + WS_QM), 512, SSQ + MALL, -1, -1, nullptr, nullptr, nullptr, nullptr};
            pg8::gemm_phase<EpiScaleBf16, pg8::StaticOrder, true, true>(lds, g, S, E);
            __syncthreads(); } }
        SEAM(pb + 4);
        if (PHX(8) && IN(pb + 5)) { for (int rep = 0; rep < REPS(8); ++rep) { phase_memattn(A, lds, l); __syncthreads(); } }
        SEAM(pb + 5);
        if (PHX(9) && IN(pb + 6)) { for (int rep = 0; rep < REPS(9); ++rep) {
            pg8::Gemm g{(const bf16_t*)(ws + WS_OM), (const bf16_t*)(ws + WS_WMO + l * SZ_WMO), MALL, DM, 512}; pg8::StaticOrder S; S.init(MALL, DM, ogrid(), obid());
            EpiResid E{A.out, XB, SSQ + 2 * MALL, 0};
            pg8::gemm_phase<EpiResid, pg8::StaticOrder, true, true>(lds, g, S, E);
            __syncthreads(); } }
        SEAM(pb + 6);
        if (PHX(10) && IN(pb + 7)) {
            pg8::Gemm g{XB, (const bf16_t*)(ws + WS_WGU + l * SZ_WGU), MALL, NGU, DM}; pg8::StaticOrder S; S.init_tiles((MALL + 247) / 248, NGU / 256, ogrid(), obid());
            EpiAct E{(bf16_t*)(ws + WS_ACT), SSQ + 2 * MALL, A.in[I_FCW] + (size_t)l * 3 * DFF, A.in[I_CFC] + (size_t)l * BS * 2 * DFF, A.out + O_PFC + (size_t)l * BP * 2 * DFF, A.out + O_SFC + (size_t)l * BS * 2 * DFF};
            pg8::gemm_phase<EpiAct, pg8::StaticOrder, true, true>(lds, g, S, E);
        }
        SEAM(pb + 7);
        if (PHX(12) && IN(pb + 8)) { for (int rep = 0; rep < REPS(12); ++rep) {
            pg8::Gemm g{(const bf16_t*)(ws + WS_ACT), (const bf16_t*)(ws + WS_WDN + l * SZ_WDN), MALL, DM, DFF}; pg8::StaticOrder S; S.init(MALL, DM, ogrid(), obid());
            EpiResid E{A.out, XB, SSQ + 3 * (size_t)MALL, l == NL - 1 ? 1 : 0};
            pg8::gemm_phase<EpiResid, pg8::StaticOrder, true, true>(lds, g, S, E);
            __syncthreads(); } }
        if (l + 1 < NL) SEAM(pb + 8);
    }
#undef IN
#undef SEAM
}

extern "C" void kernel_launch(void* const* d_in, const int* in_sizes, int n_in, void* d_out, int out_size, void* d_ws, size_t ws_size, hipStream_t stream) {
    static int grid = 0;
    if (grid == 0) {
        if (n_in != 34 || (size_t)out_size != O_END || ws_size < WS_END) { fprintf(stderr, "kernel_launch: unexpected problem (n_in %d, out %d, ws %zu; need 34, %zu, >= %zu); nothing launched\n", n_in, out_size, ws_size, (size_t)O_END, (size_t)WS_END); grid = -1; return; }
        int dev = 0, cus = 0, per_cu = 0;
        if (hipGetDevice(&dev) != hipSuccess || hipDeviceGetAttribute(&cus, hipDeviceAttributeMultiprocessorCount, dev) != hipSuccess) { grid = -1; return; }
        if (hipFuncSetAttribute((const void*)hse_fwd, hipFuncAttributeMaxDynamicSharedMemorySize, LDS_BYTES) != hipSuccess) { fprintf(stderr, "kernel_launch: hipFuncSetAttribute failed\n"); grid = -1; return; }
        if (hipOccupancyMaxActiveBlocksPerMultiprocessor(&per_cu, (const void*)hse_fwd, NTHR, LDS_BYTES) != hipSuccess || per_cu < 1) { fprintf(stderr, "kernel_launch: occupancy query reports %d blocks per CU\n", per_cu); }
        (void)hipGetLastError();
        grid = cus;
    }
    if (grid < 0) return;
    (void)hipMemsetAsync((char*)d_ws + WS_CTL, 0, CTL_BYTES, stream);
    (void)hipMemsetAsync((char*)d_ws + WS_SSQ, 0, (size_t)(3 * NL + 1) * MALL * 8, stream);
    Args a{};
    for (int i = 0; i < 34; ++i) a.in[i] = (const float*)d_in[i];
    a.out = (float*)d_out; a.ws = (unsigned char*)d_ws;
#if MK_ONE_LAUNCH
    a.ph_lo = 0; a.ph_hi = NPH;
    hipLaunchKernelGGL(hse_fwd, dim3(grid), dim3(NTHR), LDS_BYTES, stream, a);
#else
    for (int p = 0; p < NPH; ++p) { a.ph_lo = p; a.ph_hi = p + 1; hipLaunchKernelGGL(hse_fwd, dim3(grid), dim3(NTHR), LDS_BYTES, stream, a); }
#endif
    const hipError_t le = hipPeekAtLastError();
    if (le != hipSuccess) fprintf(stderr, "kernel_launch: launch failed: %s\n", hipGetErrorName(le));
}
```

```cpp
#include <hip/hip_runtime.h>
#include <cstdio>
#include <cstdint>

#define DI __device__ __forceinline__
#define GAS __attribute__((address_space(1)))
#define LAS __attribute__((address_space(3)))

typedef unsigned short bf16_t;
typedef short bf16x8 __attribute__((ext_vector_type(8)));
typedef short bf16x4 __attribute__((ext_vector_type(4)));
typedef float f32x4 __attribute__((ext_vector_type(4)));
typedef float f32x2 __attribute__((ext_vector_type(2)));
typedef float f32x16 __attribute__((ext_vector_type(16)));
typedef unsigned u32x4 __attribute__((ext_vector_type(4)));
typedef unsigned u32x2 __attribute__((ext_vector_type(2)));
typedef __bf16 bf16x2_t __attribute__((ext_vector_type(2)));

constexpr int DM = 1024, BP = 16, TP = 4096, NL = 4, BS = 32, TS = 16, PAST = 4096, NMEM = 256;
constexpr int MP = BP * TP, MS = BS * TS, MALL = MP + MS;
constexpr int NZ = 3584;
constexpr int ZQ = 0, ZK = 512, ZV = 1024, ZG = 1536, ZSB = 2048, ZSC = 2304, ZSX = 2560, ZCQ = 2816, ZCK = 3072, ZCV = 3328;
constexpr int DFF = 2816, NGU = 2 * DFF;
constexpr int DIN = 3592;
constexpr float EPS = 1e-6f;
constexpr int NCH = BP * 64 * 4 + BS * 4;
constexpr int PCH = 36864;
constexpr int PW = 0, PQE = 8192, PUT = 16384, PKDT = 24576, PQK = 32768;

constexpr size_t O_YP = 0, O_YS = O_YP + (size_t)MP * DM, O_PGS = O_YS + (size_t)MS * DM, O_PGC = O_PGS + (size_t)NL * BP * 4 * 128 * 128,
    O_PSC = O_PGC + (size_t)NL * BP * 3 * 1536, O_PSK = O_PSC + (size_t)NL * BP * 2 * 256, O_PSV = O_PSK + (size_t)NL * MP * 256, O_PMK = O_PSV + (size_t)NL * MP * 256,
    O_PMV = O_PMK + (size_t)NL * BP * NMEM * 512, O_PFC = O_PMV + (size_t)NL * BP * NMEM * 512, O_SGS = O_PFC + (size_t)NL * BP * 2 * DFF,
    O_SGC = O_SGS + (size_t)NL * BS * 4 * 128 * 128, O_SSC = O_SGC + (size_t)NL * BS * 3 * 1536, O_SSK = O_SSC + (size_t)NL * BS * 2 * 256,
    O_SSV = O_SSK + (size_t)NL * MS * 256, O_SFC = O_SSV + (size_t)NL * MS * 256, O_END = O_SFC + (size_t)NL * BS * 2 * DFF;
static_assert(O_END == 234323968ull, "output size");

constexpr size_t al256(size_t x) { return (x + 255) & ~(size_t)255; }
constexpr size_t WS_CTL = 0, CTL_BYTES = 1u << 20;
constexpr size_t SZ_WIN = (size_t)NZ * DM * 2, SZ_WG8 = 16 * DM * 2, SZ_WMIX = (size_t)DM * DM * 2, SZ_WMQ = 512 * DM * 2, SZ_WMO = (size_t)DM * 512 * 2,
    SZ_WGU = (size_t)NGU * DM * 2, SZ_WDN = (size_t)DM * DFF * 2;
constexpr size_t WS_WIN = WS_CTL + CTL_BYTES, WS_WG8 = WS_WIN + NL * SZ_WIN, WS_WMIX = WS_WG8 + NL * SZ_WG8, WS_WMQ = WS_WMIX + NL * SZ_WMIX, WS_WMO = WS_WMQ + NL * SZ_WMQ,
    WS_WGU = WS_WMO + NL * SZ_WMO, WS_WDN = WS_WGU + NL * SZ_WGU, WS_WMKV = WS_WDN + NL * SZ_WDN;
constexpr size_t WS_XB = WS_WMKV + (size_t)4096 * DM * 2;
constexpr size_t WS_SSQ = WS_XB + (size_t)(MALL + 256) * DM * 2;
constexpr size_t WS_MEMB = WS_SSQ + (size_t)MALL * 16 * 8;
constexpr size_t WS_SSQM = WS_MEMB + (size_t)4096 * DM * 2;
constexpr size_t WS_RAWKV = WS_SSQM + 4096 * 4;
constexpr size_t WS_MK = WS_RAWKV + (size_t)4096 * 4096 * 4;
constexpr size_t WS_MVT = WS_MK + (size_t)NL * BP * 4 * 256 * 128 * 2;
constexpr size_t WS_SMK = WS_MVT + (size_t)NL * BP * 4 * 256 * 128 * 2;
constexpr size_t WS_SMVT = WS_SMK + (size_t)NL * BS * 4 * 256 * 128 * 2;
constexpr size_t WS_Z = WS_SMVT + (size_t)NL * BS * 4 * 256 * 128 * 2;
constexpr size_t WS_PREP = WS_Z + (size_t)MALL * NZ * 2;
constexpr size_t WS_GU = WS_Z;
constexpr size_t WS_EG = WS_PREP + (size_t)NCH * PCH * 2;
constexpr size_t WS_Y = al256(WS_EG + (size_t)NCH * 4);
constexpr size_t WS_QM = WS_Y + (size_t)MALL * DM * 2;
constexpr size_t WS_OM = WS_QM + (size_t)MALL * 512 * 2;
constexpr size_t WS_ACT = WS_OM + (size_t)MALL * 512 * 2;
constexpr size_t WS_END = WS_ACT + (size_t)MALL * DFF * 2;
static_assert(WS_GU + (size_t)MALL * NGU * 2 <= WS_EG, "GU overlay fits in Z | PREP");
static_assert(WS_END <= 2147483648ull, "workspace map exceeds the guaranteed 2 GiB");

constexpr int LDS_BYTES = 147456;
constexpr int MISC_OFF = 139264;
constexpr int NWAVES = 8, NTHR = 512;

DI unsigned pk2(float lo, float hi) { f32x2 v = {lo, hi}; bf16x2_t b = __builtin_convertvector(v, bf16x2_t); return __builtin_bit_cast(unsigned, b); }
DI float bflo(unsigned u) { return __uint_as_float(u << 16); }
DI float bfhi(unsigned u) { return __uint_as_float(u & 0xffff0000u); }
DI float bf2f(bf16_t u) { return __uint_as_float((unsigned)u << 16); }
DI bf16_t f2bf(float f) { return (bf16_t)(pk2(f, 0.f) & 0xffffu); }
DI u32x4 pk8(const float* v) { u32x4 r; r.x = pk2(v[0], v[1]); r.y = pk2(v[2], v[3]); r.z = pk2(v[4], v[5]); r.w = pk2(v[6], v[7]); return r; }
DI void unpk8(u32x4 r, float* v) { v[0] = bflo(r.x); v[1] = bfhi(r.x); v[2] = bflo(r.y); v[3] = bfhi(r.y); v[4] = bflo(r.z); v[5] = bfhi(r.z); v[6] = bflo(r.w); v[7] = bfhi(r.w); }
DI u32x2 pk4(f32x4 v) { u32x2 r; r.x = pk2(v[0], v[1]); r.y = pk2(v[2], v[3]); return r; }
DI f32x4 unpk4(u32x2 r) { f32x4 v; v[0] = bflo(r.x); v[1] = bfhi(r.x); v[2] = bflo(r.y); v[3] = bfhi(r.y); return v; }
DI float wave_sum(float v) {
#pragma unroll
    for (int o = 1; o < 64; o <<= 1) v += __shfl_xor(v, o);
    return v;
}
DI float fexp(float x) { return __builtin_amdgcn_exp2f(x * 1.4426950408889634f); }
DI float flog(float x) { return __builtin_amdgcn_logf(x) * 0.6931471805599453f; }
DI float sigmoidf_(float x) { return __builtin_amdgcn_rcpf(1.0f + __builtin_amdgcn_exp2f(-1.4426950408889634f * x)); }
DI float siluf_(float x) { return x * __builtin_amdgcn_rcpf(1.0f + __builtin_amdgcn_exp2f(-1.4426950408889634f * x)); }
DI float softplusf_(float x) { return fmaxf(x, 0.f) + log1pf(__expf(-fabsf(x))); }
#define MFMA16(a, b, c) __builtin_amdgcn_mfma_f32_16x16x32_bf16((a), (b), (c), 0, 0, 0)
#define MFMA16K16(a, b, c) __builtin_amdgcn_mfma_f32_16x16x16bf16_1k((a), (b), (c), 0, 0, 0)
#define MFMA32(a, b, c) __builtin_amdgcn_mfma_f32_32x32x16_bf16((a), (b), (c), 0, 0, 0)
#define LDS_WAIT() asm volatile("s_waitcnt lgkmcnt(0)" ::: "memory")
#define VM_WAIT() asm volatile("s_waitcnt vmcnt(0)" ::: "memory")
DI int otid() { int t = threadIdx.x; asm volatile("" : "+v"(t)); return t; }
DI int obid() { int b = blockIdx.x; asm volatile("" : "+s"(b)); return b; }
DI int ogrid() { int g = gridDim.x; asm volatile("" : "+s"(g)); return g; }
#define LBAR() do { asm volatile("s_waitcnt lgkmcnt(0)" ::: "memory"); __builtin_amdgcn_s_barrier(); asm volatile("" ::: "memory"); } while (0)
#define MK_ONE_LAUNCH 1
namespace pg8 {
#define PG8_LAS __attribute__((address_space(3)))
constexpr int BM = 256, BK = 64, HALF = 128, HTB = HALF * BK * 2  , STAGE_BYTES = 8 * HTB, NXCD = 8, WGM = 4;
__host__ __device__ __forceinline__ int lds_byte(int r, int c) { const int st = (r >> 4) * 2 + (c >> 5), rr = r & 15, cc = c & 31, ob = rr * 64 + cc * 2; return st * 1024 + (ob ^ (((ob >> 9) & 1) << 5)); }
__host__ __device__ __forceinline__ void stage_rc(int b, int& R, int& C) { const int st = b / 1024, sb = b % 1024, swz = sb ^ (((sb >> 9) & 1) << 5); R = (st >> 1) * 16 + swz / 64; C = (st & 1) * 32 + (swz % 64) / 2; }
__host__ __device__ __forceinline__ int perm32(int rho) { const int n = rho >> 4, i = rho & 15; return 8 * (i >> 2) + 4 * n + (i & 3); }

struct Unit { int pm, pn; };
struct Gemm { const bf16_t* A; const bf16_t* Bt; int M, N, K; };

struct StaticOrder {
    int nM, nN, nwg, G, c;
    __host__ __device__ void init(int M, int N, int G_, int c_) { nM = M / BM; nN = N / BM; nwg = nM * nN; G = G_; c = c_; }
    __host__ __device__ void init_tiles(int nM_, int nN_, int G_, int c_) { nM = nM_; nN = nN_; nwg = nM * nN; G = G_; c = c_; }
    __host__ __device__ bool next(int i, Unit& u) const {
        const long L = (long)i * G + c; if (L >= nwg) return false;
        int wgid = (int)L; { const int q = nwg / NXCD, r = nwg % NXCD, xcd = wgid % NXCD, off = wgid / NXCD; wgid = (xcd < r ? xcd * (q + 1) : r * (q + 1) + (xcd - r) * q) + off; }
        const int nig = WGM * nN, gid = wgid / nig, fm = gid * WGM, gsz = (nM - fm) < WGM ? (nM - fm) : WGM;
        u.pm = fm + ((wgid % nig) % gsz); u.pn = (wgid % nig) / gsz; return true;
    }
    __device__ __forceinline__ void a_ready(const Unit&) const {}
    __device__ __forceinline__ void done(const Unit&) const {}
};
template <class Epi, class Sched, bool ALIGN_EPI = false, bool SP2 = false>
__device__ __forceinline__ void gemm_phase(PG8_LAS unsigned char* lds, const Gemm g, const Sched& S, const Epi& E) {
    const int tid = otid(), wid = __builtin_amdgcn_readfirstlane(tid >> 6), lane = tid & 63, wr = wid >> 2, wc = wid & 3, fr = lane & 15, fq = lane >> 4;
    const int K = g.K, nt = K / BK;
    int voffA[2], voffB[2];
#pragma unroll
    for (int i = 0; i < 2; ++i) { int R, C; stage_rc(tid * 16 + i * 8192, R, C); const int Rb = Epi::PERM ? ((R & ~31) + perm32(R & 31)) : R;
        const int Ra = Epi::ROWMAP ? (62 * (R >> 6) - 2 + (R & 63)) : R;
        voffA[i] = (Ra * K + C) * 2; voffB[i] = (Rb * K + C) * 2; }
    const size_t kstep = (size_t)(BK * 2);
    const size_t hstep = (size_t)HALF * K * 2;
    const size_t tstep = 2 * hstep;
    const size_t hstepA = Epi::ROWMAP ? (size_t)124 * K * 2 : hstep, tstepA = 2 * hstepA;
    const unsigned ldsw = (unsigned)wid * 1024u;
    const int aoff = lds_byte(wr * 64 + fr, fq * 8), boff = lds_byte(wc * 32 + fr, fq * 8);
#define PG8_SA(b, h) (((b) * 2 + (h)) * HTB)
#define PG8_SB(b, h) ((4 + (b) * 2 + (h)) * HTB)
#define PG8_STAGE(bufoff, gbase, voff) do { _Pragma("unroll") for (int _i = 0; _i < 2; ++_i) \
        __builtin_amdgcn_global_load_lds((const unsigned*)((const char*)(gbase) + (voff)[_i]), (PG8_LAS unsigned*)(lds + (bufoff) + ldsw + _i * 8192), 16, 0, 0); } while (0)
#define PG8_LDA(dst, b, h) do { _Pragma("unroll") for (int m = 0; m < 4; ++m) _Pragma("unroll") for (int k = 0; k < 2; ++k) dst[m][k] = *(const PG8_LAS bf16x8*)(lds + PG8_SA(b, h) + aoff + m * 2048 + k * 1024); } while (0)
#define PG8_LDB(dst, b, h) do { _Pragma("unroll") for (int n = 0; n < 2; ++n) _Pragma("unroll") for (int k = 0; k < 2; ++k) dst[n][k] = *(const PG8_LAS bf16x8*)(lds + PG8_SB(b, h) + boff + n * 2048 + k * 1024); } while (0)
#define PG8_MMA(ai, bj, At, Bt) do { __builtin_amdgcn_s_setprio(1); _Pragma("unroll") for (int m = 0; m < 4; ++m) _Pragma("unroll") for (int n = 0; n < 2; ++n) _Pragma("unroll") for (int k = 0; k < 2; ++k) \
        acc[ai][bj][m][n] = __builtin_amdgcn_mfma_f32_16x16x32_bf16(Bt[n][k], At[m][k], acc[ai][bj][m][n], 0, 0, 0); __builtin_amdgcn_s_setprio(0); } while (0)
#define PG8_WAIT_V(n) asm volatile("s_waitcnt vmcnt(" #n ")" ::: "memory")
#define PG8_WAIT_L(n) asm volatile("s_waitcnt lgkmcnt(" #n ")" ::: "memory")
#define PG8_BAR __builtin_amdgcn_s_barrier()
#define PG8_SCHED __builtin_amdgcn_sched_barrier(0)
    Unit cur, nxt; int ui = 0;
    if (!S.next(0, cur)) return;
    f32x4 acc[2][2][4][2];
#pragma unroll
    for (int a = 0; a < 2; ++a)
#pragma unroll
        for (int b = 0; b < 2; ++b)
#pragma unroll
            for (int m = 0; m < 4; ++m)
#pragma unroll
                for (int n = 0; n < 2; ++n) acc[a][b][m][n] = (f32x4){0.f, 0.f, 0.f, 0.f};
    bf16x8 At[4][2], B0[2][2], B1[2][2];
    const char* cA = (const char*)g.A + (size_t)cur.pm * tstepA; const char* cB = (const char*)g.Bt + (size_t)cur.pn * tstep;
    S.a_ready(cur);
    PG8_LAS float* RS = (PG8_LAS float*)(lds + MISC_OFF + 1024);
    u32x2 raw0 = {0u, 0u}; if constexpr (Epi::STAGE) raw0 = E.st_issue(cur, tid);
    if constexpr (SP2) {
        PG8_STAGE(PG8_SB(0, 0), cB, voffB); PG8_STAGE(PG8_SB(0, 1), cB + hstep, voffB); PG8_STAGE(PG8_SA(0, 0), cA, voffA); PG8_STAGE(PG8_SA(0, 1), cA + hstepA, voffA);
        if (wr == 1) PG8_BAR;
        PG8_WAIT_V(2); PG8_BAR;
        PG8_STAGE(PG8_SB(1, 0), cB + kstep, voffB); PG8_STAGE(PG8_SA(1, 0), cA + kstep, voffA); PG8_STAGE(PG8_SB(1, 1), cB + hstep + kstep, voffB);
        PG8_WAIT_V(6); PG8_BAR;
    } else {
        PG8_STAGE(PG8_SB(0, 0), cB, voffB); PG8_STAGE(PG8_SA(0, 0), cA, voffA); PG8_STAGE(PG8_SB(0, 1), cB + hstep, voffB); PG8_STAGE(PG8_SA(0, 1), cA + hstepA, voffA);
        if (wr == 1) PG8_BAR;
        PG8_WAIT_V(4); PG8_BAR;
        PG8_STAGE(PG8_SB(1, 0), cB + kstep, voffB); PG8_STAGE(PG8_SA(1, 0), cA + kstep, voffA); PG8_STAGE(PG8_SB(1, 1), cB + hstep + kstep, voffB);
        PG8_WAIT_V(6); PG8_BAR;
    }
    if constexpr (Epi::STAGE) E.st_commit(raw0, cur, RS, tid);
    for (;;) {
        const bool has_next = S.next(ui + 1, nxt);
        const char* nA = has_next ? (const char*)g.A + (size_t)nxt.pm * tstepA : cA; const char* nB = has_next ? (const char*)g.Bt + (size_t)nxt.pn * tstep : cB;
        for (int t = 0; t < nt; t += 2) {
            const bool last = (t == nt - 2);
            const char* a1 = cA + (size_t)(t + 1) * kstep;
            const char* a2 = last ? nA : cA + (size_t)(t + 2) * kstep; const char* b2 = last ? nB : cB + (size_t)(t + 2) * kstep;
            const char* a3 = a2 + kstep; const char* b3 = b2 + kstep;
            if (last && has_next) S.a_ready(nxt);
            if constexpr (SP2) {
            PG8_LDB(B0, 0, 0); PG8_LDB(B1, 0, 1); PG8_SCHED; PG8_LDA(At, 0, 0); PG8_STAGE(PG8_SA(1, 1), a1 + hstepA, voffA);
            PG8_WAIT_V(8); PG8_WAIT_L(0); PG8_BAR; PG8_MMA(0, 0, At, B0); PG8_MMA(0, 1, At, B1); PG8_BAR; PG8_SCHED;
            PG8_LDA(At, 0, 1); PG8_STAGE(PG8_SB(0, 0), b2, voffB); PG8_STAGE(PG8_SB(0, 1), b2 + hstep, voffB); PG8_STAGE(PG8_SA(0, 0), a2, voffA);
            PG8_WAIT_V(8); PG8_WAIT_L(0); PG8_BAR; PG8_MMA(1, 0, At, B0); PG8_MMA(1, 1, At, B1); PG8_BAR; PG8_SCHED;
            PG8_LDB(B0, 1, 0); PG8_LDB(B1, 1, 1); PG8_SCHED; PG8_LDA(At, 1, 0); PG8_STAGE(PG8_SA(0, 1), a2 + hstepA, voffA);
            PG8_WAIT_V(8); PG8_WAIT_L(0); PG8_BAR; PG8_MMA(0, 0, At, B0); PG8_MMA(0, 1, At, B1); PG8_BAR; PG8_SCHED;
            PG8_LDA(At, 1, 1); PG8_STAGE(PG8_SB(1, 0), b3, voffB); PG8_STAGE(PG8_SB(1, 1), b3 + hstep, voffB); PG8_STAGE(PG8_SA(1, 0), a3, voffA);
            PG8_WAIT_V(8); PG8_WAIT_L(0); PG8_BAR; PG8_MMA(1, 0, At, B0); PG8_MMA(1, 1, At, B1); PG8_BAR; PG8_SCHED;
            } else {
            PG8_LDB(B0, 0, 0); PG8_SCHED; PG8_LDA(At, 0, 0); PG8_STAGE(PG8_SA(1, 1), a1 + hstepA, voffA);
            PG8_WAIT_L(8); PG8_BAR; PG8_WAIT_L(0); PG8_MMA(0, 0, At, B0); PG8_BAR; PG8_SCHED;
            PG8_LDB(B1, 0, 1); PG8_STAGE(PG8_SB(0, 0), b2, voffB);
            PG8_BAR; PG8_WAIT_L(0); PG8_MMA(0, 1, At, B1); PG8_BAR;
            PG8_LDA(At, 0, 1); PG8_STAGE(PG8_SA(0, 0), a2, voffA);
            PG8_BAR; PG8_WAIT_L(0); PG8_MMA(1, 0, At, B0); PG8_BAR; PG8_SCHED;
            PG8_STAGE(PG8_SB(0, 1), b2 + hstep, voffB);
            PG8_WAIT_V(6); PG8_BAR; PG8_MMA(1, 1, At, B1); PG8_BAR;
            PG8_LDB(B0, 1, 0); PG8_SCHED; PG8_LDA(At, 1, 0); PG8_STAGE(PG8_SA(0, 1), a2 + hstepA, voffA);
            PG8_WAIT_L(8); PG8_BAR; PG8_WAIT_L(0); PG8_MMA(0, 0, At, B0); PG8_BAR; PG8_SCHED;
            PG8_LDB(B1, 1, 1); PG8_STAGE(PG8_SB(1, 0), b3, voffB);
            PG8_BAR; PG8_WAIT_L(0); PG8_MMA(0, 1, At, B1); PG8_BAR;
            PG8_LDA(At, 1, 1); PG8_STAGE(PG8_SA(1, 0), a3, voffA);
            PG8_BAR; PG8_WAIT_L(0); PG8_MMA(1, 0, At, B0); PG8_BAR; PG8_SCHED;
            PG8_STAGE(PG8_SB(1, 1), b3 + hstep, voffB);
            PG8_WAIT_V(6); PG8_BAR; PG8_MMA(1, 1, At, B1); PG8_BAR;
            }
        }
        if constexpr (ALIGN_EPI) { if (wr == 0) PG8_BAR; }
        if constexpr (!Epi::AFTER_DRAIN) {
            if constexpr (Epi::STAGE) {
                const Unit& nu = has_next ? nxt : cur; const u32x2 raw = E.st_issue(nu, tid);
                E(acc, cur, wr, wc, fr, fq, RS + (ui & 1) * 640);
                E.st_commit(raw, nu, RS + ((ui + 1) & 1) * 640, tid);
            } else E(acc, cur, wr, wc, fr, fq);
            S.done(cur); }
        if (!has_next) break;
#pragma unroll
        for (int a = 0; a < 2; ++a)
#pragma unroll
            for (int b = 0; b < 2; ++b)
#pragma unroll
                for (int m = 0; m < 4; ++m)
#pragma unroll
                    for (int n = 0; n < 2; ++n) acc[a][b][m][n] = (f32x4){0.f, 0.f, 0.f, 0.f};
        cur = nxt; cA = nA; cB = nB; ++ui;
        if constexpr (ALIGN_EPI) { if (wr == 1) PG8_BAR; }
    }
    PG8_WAIT_V(0);
    if constexpr (!ALIGN_EPI) { if (wr == 0) PG8_BAR; }
    PG8_BAR;
    if constexpr (Epi::AFTER_DRAIN) { E.fused(acc, cur, wr, wc, fr, fq, lds, wid, lane); S.done(cur); }
#undef PG8_SA
#undef PG8_SB
#undef PG8_STAGE
#undef PG8_LDA
#undef PG8_LDB
#undef PG8_MMA
#undef PG8_WAIT_V
#undef PG8_WAIT_L
#undef PG8_BAR
#undef PG8_SCHED
}
}
#define XB_TMO      128
#define XB_XCNT(j)  (256  + 64 * (j))
#define XB_XSUB(j)  (1280 + 64 * (j))
#define XB_XGEN(j)  (2304 + 64 * (j))
#define XB_TOP      3328
#define XB_TOPGEN   3392
#define XCD_BAR_WORDS 3456
#define XB_SPIN_CAP (1u << 18)

__device__ __forceinline__ unsigned xb_ld(unsigned* p)              { return __hip_atomic_load(p, __ATOMIC_RELAXED, __HIP_MEMORY_SCOPE_AGENT); }
__device__ __forceinline__ unsigned xb_add(unsigned* p, unsigned v) { return __hip_atomic_fetch_add(p, v, __ATOMIC_RELAXED, __HIP_MEMORY_SCOPE_AGENT); }
__device__ __forceinline__ unsigned xb_xcc_id() { return (unsigned)__builtin_amdgcn_s_getreg((3 << 11) | 20) & 0xFu; }
#define XB_SPIN(cond, bar) do { unsigned _sp = 0; while (cond) { __builtin_amdgcn_s_sleep(16); \
    if ((++_sp & 255u) == 0u) { if (xb_ld(&(bar)[XB_TMO])) break; if (_sp > XB_SPIN_CAP) { atomicAdd(&(bar)[XB_TMO], 1u); break; } } } } while (0)

struct XcdBarrier {
    unsigned* bar; unsigned x;
    volatile LAS unsigned* st;
};

__device__ __forceinline__ XcdBarrier xcd_barrier_post(unsigned* bar, volatile LAS unsigned* st) {
    XcdBarrier b; b.bar = bar; b.x = xb_xcc_id(); b.st = st;
    if (threadIdx.x == 0) (void)xb_add(&bar[XB_XCNT(b.x)], 1u);
    return b;
}
__device__ __forceinline__ void xcd_barrier_complete(unsigned* bar, unsigned x, unsigned& nloc, unsigned& nx) {
    const unsigned G = gridDim.x * gridDim.y * gridDim.z;
    unsigned sum, cnt, mine, sp = 0u;
    for (;;) {
        sum = 0u; cnt = 0u; mine = 0u;
#pragma unroll
        for (unsigned j = 0; j < 16; ++j) { const unsigned c = xb_ld(&bar[XB_XCNT(j)]); sum += c; cnt += (c > 0u) ? 1u : 0u; mine = (j == x) ? c : mine; }
        if (sum == G) break;
        __builtin_amdgcn_s_sleep(1);
        if ((++sp & 255u) == 0u) { if (xb_ld(&bar[XB_TMO])) break; if (sp > XB_SPIN_CAP) { atomicAdd(&bar[XB_TMO], 1u); break; } }
    }
    nloc = mine > 0u ? mine : 1u; nx = cnt > 0u ? cnt : 1u;
}

__device__ __forceinline__ void xcd_barrier(const XcdBarrier& b) {
    asm volatile("s_waitcnt vmcnt(0)" ::: "memory");
    __syncthreads();
    if (threadIdx.x == 0) {
        unsigned* bar = b.bar;
        __builtin_amdgcn_s_waitcnt(0);
        unsigned nloc = b.st[0], nx = b.st[1];
        if (nloc == 0u) { xcd_barrier_complete(bar, b.x, nloc, nx); b.st[0] = nloc; b.st[1] = nx; }
        const unsigned old = xb_add(&bar[XB_XSUB(b.x)], 1u);
        const unsigned gen = old / nloc;
        if (old + 1u == (gen + 1u) * nloc) {
            __builtin_amdgcn_fence(__ATOMIC_RELEASE, "agent");
            asm volatile("s_waitcnt vmcnt(0)" ::: "memory");
            const unsigned og = xb_add(&bar[XB_TOP], 1u);
            const unsigned tg = og / nx;
            if (og + 1u == (tg + 1u) * nx) xb_add(&bar[XB_TOPGEN], 1u);
            else XB_SPIN(xb_ld(&bar[XB_TOPGEN]) == tg, bar);
            __builtin_amdgcn_fence(__ATOMIC_ACQUIRE, "agent");
            xb_add(&bar[XB_XGEN(b.x)], 1u);
            asm volatile("s_waitcnt vmcnt(0)" ::: "memory");
        } else {
            XB_SPIN(xb_ld(&bar[XB_XGEN(b.x)]) == gen, bar);
            __builtin_amdgcn_fence(__ATOMIC_ACQUIRE, "agent");
            asm volatile("s_waitcnt vmcnt(0)" ::: "memory");
        }
    }
    __syncthreads();
}
struct Args { const float* in[34]; float* out; unsigned char* ws; int ph_lo, ph_hi; };
enum { I_XP = 0, I_XS, I_MEM, I_STATE, I_CGC, I_CSC, I_CSBK, I_CSBV, I_CMK, I_CMV, I_CFC, I_NMIXG, I_WIN, I_GCW, I_ALOG, I_DTB, I_GNG, I_SCW, I_SCG, I_SBG, I_WMIX,
       I_NMEMG, I_MEMING, I_WMQ, I_WMK, I_WMV, I_MQG, I_MKG, I_WMO, I_NFFNG, I_WGATE, I_WUP, I_FCW, I_WDN };
constexpr int CW_BAR = 4096;

typedef unsigned long long u64_t;
constexpr float SSQ_FIX = 1048576.0f;
DI float ssq_ld(const u64_t* ssq, int row) { return (float)ssq[row] * (1.0f / SSQ_FIX); }
DI float row_rstd(const u64_t* ssq, int row) { return rsqrtf(ssq_ld(ssq, row) * (1.0f / DM) + EPS); }
struct EpiScaleBf16 {
    static constexpr bool PERM = true, AFTER_DRAIN = false, ROWMAP = false, STAGE = true;
    bf16_t* O; int ldc; const u64_t* ssq; int tk, tv; float* fkp; float* fks; float* fvp; float* fvs;
    DI u32x2 st_issue(const pg8::Unit& n, int tid) const { return *(const u32x2*)(ssq + n.pm * 256 + (tid & 255)); }
    DI void st_commit(u32x2 raw, const pg8::Unit&, LAS float* RSn, int tid) const {
        const u64_t v = ((u64_t)raw.y << 32) | raw.x; if (tid < 256) RSn[tid] = rsqrtf((float)v * (1.0f / (SSQ_FIX * DM)) + EPS); }
    DI void operator()(const f32x4 (&acc)[2][2][4][2], const pg8::Unit& u, int wr, int wc, int fr, int fq, const LAS float* RS) const {
        const int row0 = u.pm * 256 + wr * 64 + fr, col0 = u.pn * 256 + wc * 32 + 8 * fq;
        const bool side = (u.pn == tk) || (u.pn == tv);
#pragma unroll
        for (int ai = 0; ai < 2; ++ai)
#pragma unroll
            for (int m = 0; m < 4; ++m) {
                const int row = row0 + ai * 128 + m * 16;
                const float rs = RS[wr * 64 + ai * 128 + m * 16 + fr];
                bf16_t* rowp = O + (size_t)row * ldc + col0;
#pragma unroll
                for (int bj = 0; bj < 2; ++bj) {
                    const f32x4 v0 = acc[ai][bj][m][0] * rs, v1 = acc[ai][bj][m][1] * rs;
                    u32x4 w; w.x = pk2(v0[0], v0[1]); w.y = pk2(v0[2], v0[3]); w.z = pk2(v1[0], v1[1]); w.w = pk2(v1[2], v1[3]);
                    *(u32x4*)(rowp + bj * 128) = w;
                    if (side) {
                        float* f = (u.pn == tk) ? (row < MP ? fkp + (size_t)row * 256 : fks + (size_t)(row - MP) * 256) : (row < MP ? fvp + (size_t)row * 256 : fvs + (size_t)(row - MP) * 256);
                        f += wc * 32 + 8 * fq + bj * 128;
                        *(f32x4*)f = v0; *(f32x4*)(f + 4) = v1;
                    }
                }
            }
    }
};
struct EpiScaleF32 {
    static constexpr bool PERM = true, AFTER_DRAIN = false, ROWMAP = false, STAGE = false;
    float* O; int ldc; const float* ssq1;
    DI void operator()(const f32x4 (&acc)[2][2][4][2], const pg8::Unit& u, int wr, int wc, int fr, int fq) const {
        const int row0 = u.pm * 256 + wr * 64 + fr, col0 = u.pn * 256 + wc * 32 + 8 * fq;
#pragma unroll
        for (int ai = 0; ai < 2; ++ai)
#pragma unroll
            for (int m = 0; m < 4; ++m) {
                const int row = row0 + ai * 128 + m * 16;
                const float rs = rsqrtf(ssq1[row] * (1.0f / DM) + EPS);
                float* rowp = O + (size_t)row * ldc + col0;
#pragma unroll
                for (int bj = 0; bj < 2; ++bj) { *(f32x4*)(rowp + bj * 128) = acc[ai][bj][m][0] * rs; *(f32x4*)(rowp + bj * 128 + 4) = acc[ai][bj][m][1] * rs; }
            }
    }
};
struct EpiResid {
    static constexpr bool PERM = true, AFTER_DRAIN = false, ROWMAP = false, STAGE = false;
    float* XF; bf16_t* XB; u64_t* ssq; int fin;
    DI void operator()(const f32x4 (&acc)[2][2][4][2], const pg8::Unit& u, int wr, int wc, int fr, int fq) const {
        const int row0 = u.pm * 256 + wr * 64 + fr, col0 = u.pn * 256 + wc * 32 + 8 * fq;
        u32x4 rv[4][2];
#pragma unroll
        for (int i = 0; i < 4; ++i) { const bf16_t* rp = XB + (size_t)(row0 + i * 16) * DM + col0; rv[i][0] = *(const u32x4*)rp; rv[i][1] = *(const u32x4*)(rp + 128); }
#pragma unroll
        for (int i = 0; i < 8; ++i) {
            const int ai = i >> 2, m = i & 3, row = row0 + ai * 128 + m * 16;
            const u32x4 r0 = rv[i & 3][0], r1 = rv[i & 3][1];
            if (i + 4 < 8) { const bf16_t* rp = XB + (size_t)(row0 + 128 + (i & 3) * 16) * DM + col0; rv[i & 3][0] = *(const u32x4*)rp; rv[i & 3][1] = *(const u32x4*)(rp + 128); }
            float* xo = XF + (size_t)row * DM + col0; bf16_t* xb = XB + (size_t)row * DM + col0;
            float s = 0.f;
#pragma unroll
            for (int bj = 0; bj < 2; ++bj) {
                float r8[8]; unpk8(bj == 0 ? r0 : r1, r8);
                const f32x4 v0 = acc[ai][bj][m][0] + (f32x4){r8[0], r8[1], r8[2], r8[3]}, v1 = acc[ai][bj][m][1] + (f32x4){r8[4], r8[5], r8[6], r8[7]};
                if (fin) { *(f32x4*)(xo + bj * 128) = v0; *(f32x4*)(xo + bj * 128 + 4) = v1; }
                else { u32x4 w; w.x = pk2(v0[0], v0[1]); w.y = pk2(v0[2], v0[3]); w.z = pk2(v1[0], v1[1]); w.w = pk2(v1[2], v1[3]);
                    *(u32x4*)(xb + bj * 128) = w; }
                s += (v0[0] * v0[0] + v0[1] * v0[1]) + (v0[2] * v0[2] + v0[3] * v0[3]) + (v1[0] * v1[0] + v1[1] * v1[1]) + (v1[2] * v1[2] + v1[3] * v1[3]);
            }
            s += __shfl_xor(s, 16); s += __shfl_xor(s, 32);
            if (fq == 0 && !fin) atomicAdd(ssq + row, (u64_t)(s * SSQ_FIX));
        }
    }
};

DI float dpp_ror1(float v) { return __builtin_bit_cast(float, __builtin_amdgcn_update_dpp(0, __builtin_bit_cast(int, v), 0x121, 0xf, 0xf, false)); }
DI float dpp_ror2(float v) { return __builtin_bit_cast(float, __builtin_amdgcn_update_dpp(0, __builtin_bit_cast(int, v), 0x122, 0xf, 0xf, false)); }
struct EpiAct {
    static constexpr bool PERM = true, AFTER_DRAIN = false, ROWMAP = true, STAGE = true;
    bf16_t* ACT; const u64_t* ssq; const float* cw; const float* cache; float* pfc; float* sfc;
    DI u32x2 st_issue(const pg8::Unit& n, int tid) const {
        int tok = 248 * n.pm + 62 * (tid >> 6) - 2 + (tid & 63); tok = tok < 0 ? 0 : (tok < MALL ? tok : MALL - 1);
        int c = tid - 256; c = c < 0 ? 0 : (c < 192 ? c : 191);
        const unsigned* p = tid < 256 ? (const unsigned*)(ssq + tok) : (const unsigned*)(cw + (c >> 6) * DFF + n.pn * 128 + 2 * (c & 63));
        return *(const u32x2*)p;
    }
    DI void st_commit(u32x2 raw, const pg8::Unit& n, LAS float* RSn, int tid) const {
        if (tid < 256) { const int tok = 248 * n.pm + 62 * (tid >> 6) - 2 + (tid & 63); const u64_t v = ((u64_t)raw.y << 32) | raw.x;
            RSn[tid] = (tok >= 0 && tok < MALL) ? rsqrtf((float)v * (1.0f / (SSQ_FIX * DM)) + EPS) : 0.f; }
        else if (tid < 448) { const int c = tid - 256; *(LAS u32x2*)(RSn + 256 + (c >> 6) * 128 + 2 * (c & 63)) = raw; }
    }
    DI void operator()(f32x4 (&acc)[2][2][4][2], const pg8::Unit& u, int wr, int wc, int fr, int fq, const LAS float* RS) const {
        const int ch0 = u.pn * 128 + wc * 32 + 8 * fq;
        f32x4 w[3][2];
#pragma unroll
        for (int i = 0; i < 3; ++i)
#pragma unroll
            for (int n = 0; n < 2; ++n) w[i][n] = *(const LAS f32x4*)(RS + 256 + i * 128 + wc * 32 + 8 * fq + 4 * n);
#pragma unroll
        for (int ai = 0; ai < 2; ++ai) {
            const int tok0 = 248 * u.pm + 62 * (2 * ai + wr) - 2 + fr;
#pragma unroll
            for (int m = 0; m < 4; ++m) {
                const float rs = RS[(2 * ai + wr) * 64 + 16 * m + fr];
#pragma unroll
                for (int bj = 0; bj < 2; ++bj)
#pragma unroll
                    for (int n = 0; n < 2; ++n) acc[ai][bj][m][n] = acc[ai][bj][m][n] * rs;
            }
            f32x4 p1[2], p2[2];
#pragma unroll
            for (int n = 0; n < 2; ++n) { p1[n] = (f32x4){0.f, 0.f, 0.f, 0.f}; p2[n] = p1[n]; }
#pragma unroll
            for (int m = 0; m < 4; ++m) {
                const int tok = tok0 + 16 * m;
                f32x4 g1[2], g2[2];
#pragma unroll
                for (int n = 0; n < 2; ++n)
#pragma unroll
                    for (int e = 0; e < 4; ++e) {
                        const float a1 = dpp_ror1(acc[ai][0][m][n][e]), a2 = dpp_ror2(acc[ai][0][m][n][e]);
                        g1[n][e] = fr >= 1 ? a1 : p1[n][e]; g2[n][e] = fr >= 2 ? a2 : p2[n][e];
                        p1[n][e] = a1; p2[n][e] = a2;
                    }
                const bool outrow = (16 * m + fr >= 2) && tok < MALL;
                const bool smp = tok >= MP;
                const int t = smp ? ((tok - MP) & (TS - 1)) : (tok & (TP - 1)), bb = smp ? ((tok - MP) >> 4) : (tok >> 12), T = smp ? TS : TP;
                if (outrow && t < 2) {
                    f32x4 h0[2], h1[2];
#pragma unroll
                    for (int n = 0; n < 2; ++n) { h0[n] = (f32x4){0.f, 0.f, 0.f, 0.f}; h1[n] = h0[n]; }
                    if (smp) { const float* cp = cache + (size_t)bb * 2 * DFF + ch0;
#pragma unroll
                        for (int n = 0; n < 2; ++n) { h0[n] = *(const f32x4*)(cp + 4 * n); h1[n] = *(const f32x4*)(cp + DFF + 4 * n); } }
#pragma unroll
                    for (int n = 0; n < 2; ++n) { if (t == 0) { g2[n] = h0[n]; g1[n] = h1[n]; } else g2[n] = h1[n]; }
                }
                if (outrow) {
                    float y[8];
#pragma unroll
                    for (int n = 0; n < 2; ++n)
#pragma unroll
                        for (int e = 0; e < 4; ++e) { const float gt = w[0][n][e] * g2[n][e] + w[1][n][e] * g1[n][e] + w[2][n][e] * acc[ai][0][m][n][e]; y[4 * n + e] = siluf_(gt) * acc[ai][1][m][n][e]; }
                    *(u32x4*)(ACT + (size_t)tok * DFF + ch0) = pk8(y);
                    if (t >= T - 2) { float* dst = (smp ? sfc : pfc) + ((size_t)bb * 2 + (t - (T - 2))) * DFF + ch0; *(f32x4*)dst = acc[ai][0][m][0]; *(f32x4*)(dst + 4) = acc[ai][0][m][1]; }
                }
            }
        }
    }
};

DI void transpose_item(const float* W, int K, int N, int n_src0, const float* gain, bf16_t* WT, int row_dst0, int kb, LAS float* scr, int lane) {
    const int k0 = 64 * kb, q = lane & 15, r4 = lane >> 4;
    f32x4 v[16];
#pragma unroll
    for (int i = 0; i < 16; ++i) v[i] = *(const f32x4*)(W + (size_t)(k0 + 4 * i + r4) * N + n_src0 + 4 * q);
#pragma unroll
    for (int i = 0; i < 16; ++i) { const int kk = 4 * i + r4; const float g = gain ? gain[k0 + kk] : 1.f; LAS float* s = scr + kk * 65 + 4 * q;
        s[0] = v[i][0] * g; s[1] = v[i][1] * g; s[2] = v[i][2] * g; s[3] = v[i][3] * g; }
    LDS_WAIT(); asm volatile("" ::: "memory");
    const int c = lane & 7;
#pragma unroll
    for (int j = 0; j < 8; ++j) { const int n = (lane >> 3) + 8 * j; const LAS float* s = scr + (8 * c) * 65 + n;
        u32x4 o; o.x = pk2(s[0 * 65], s[1 * 65]); o.y = pk2(s[2 * 65], s[3 * 65]); o.z = pk2(s[4 * 65], s[5 * 65]); o.w = pk2(s[6 * 65], s[7 * 65]);
        *(u32x4*)(WT + (size_t)(row_dst0 + n) * K + k0 + 8 * c) = o; }
    LDS_WAIT(); asm volatile("" ::: "memory");
}
DI float row_to_bf16(const float* xrow, bf16_t* orow, int lane) {
    const f32x4* xr = (const f32x4*)xrow + lane; float s = 0.f;
    unsigned long long* o8 = (unsigned long long*)orow + lane;
#pragma unroll
    for (int j = 0; j < 4; ++j) { const f32x4 v = xr[64 * j]; s += (v[0] * v[0] + v[1] * v[1]) + (v[2] * v[2] + v[3] * v[3]);
        o8[64 * j] = (unsigned long long)pk2(v[0], v[1]) | ((unsigned long long)pk2(v[2], v[3]) << 32); }
    return wave_sum(s);
}
DI void transpose_v_tile(const float* src, size_t pitch, bf16_t* dst, LAS unsigned char* lds, int tid) {
    LAS bf16_t* tile = (LAS bf16_t*)lds;
#pragma unroll 4
    for (int i = 0; i < 64; ++i) { const int idx = tid + 512 * i, n = idx >> 7, d = idx & 127; tile[d * 264 + n] = f2bf(src[(size_t)n * pitch + d]); }
    __syncthreads();
#pragma unroll
    for (int i = 0; i < 8; ++i) { const int v = tid + 512 * i, d = v >> 5, n8 = v & 31; *(u32x4*)(dst + (size_t)d * 256 + 8 * n8) = *(const LAS u32x4*)(tile + d * 264 + 8 * n8); }
    __syncthreads();
}

DI void phase_convert(const Args& A, LAS unsigned char* lds) {
    const int tid = otid(), lane = tid & 63, wave = tid >> 6, G = gridDim.x;
    const int gw = blockIdx.x * NWAVES + wave, NGW = G * NWAVES;
    unsigned char* ws = A.ws;
    LAS float* scr = (LAS float*)(lds + wave * 16640);
    constexpr int NI = 3776;
    for (int it = gw; it < NL * NI; it += NGW) {
        const int l = it / NI; int r = it % NI;
        if (r < 896) { const int kb = r / 56, nb = r % 56, nd = 64 * nb; transpose_item(A.in[I_WIN] + (size_t)l * DM * DIN, DM, DIN, nd + (nd >= 2048 ? 8 : 0), A.in[I_NMIXG] + l * DM, (bf16_t*)(ws + WS_WIN + l * SZ_WIN), nd, kb, scr, lane); continue; } r -= 896;
        if (r < 256) { transpose_item(A.in[I_WMIX] + (size_t)l * DM * DM, DM, DM, 64 * (r % 16), nullptr, (bf16_t*)(ws + WS_WMIX + l * SZ_WMIX), 64 * (r % 16), r / 16, scr, lane); continue; } r -= 256;
        if (r < 128) { transpose_item(A.in[I_WMQ] + (size_t)l * DM * 512, DM, 512, 64 * (r % 8), A.in[I_NMEMG] + l * DM, (bf16_t*)(ws + WS_WMQ + l * SZ_WMQ), 64 * (r % 8), r / 8, scr, lane); continue; } r -= 128;
        if (r < 128) { transpose_item(A.in[I_WMK] + (size_t)l * DM * 512, DM, 512, 64 * (r % 8), A.in[I_MEMING] + l * DM, (bf16_t*)(ws + WS_WMKV), l * 1024 + 64 * (r % 8), r / 8, scr, lane); continue; } r -= 128;
        if (r < 128) { transpose_item(A.in[I_WMV] + (size_t)l * DM * 512, DM, 512, 64 * (r % 8), A.in[I_MEMING] + l * DM, (bf16_t*)(ws + WS_WMKV), l * 1024 + 512 + 64 * (r % 8), r / 8, scr, lane); continue; } r -= 128;
        if (r < 128) { transpose_item(A.in[I_WMO] + (size_t)l * 512 * DM, 512, DM, 64 * (r % 16), nullptr, (bf16_t*)(ws + WS_WMO + l * SZ_WMO), 64 * (r % 16), r / 16, scr, lane); continue; } r -= 128;
        if (r < 704) { const int nb = r % 44; transpose_item(A.in[I_WGATE] + (size_t)l * DM * DFF, DM, DFF, 64 * nb, A.in[I_NFFNG] + l * DM, (bf16_t*)(ws + WS_WGU + l * SZ_WGU), 256 * (nb >> 1) + 64 * (nb & 1), r / 44, scr, lane); continue; } r -= 704;
        if (r < 704) { const int nb = r % 44; transpose_item(A.in[I_WUP] + (size_t)l * DM * DFF, DM, DFF, 64 * nb, A.in[I_NFFNG] + l * DM, (bf16_t*)(ws + WS_WGU + l * SZ_WGU), 256 * (nb >> 1) + 128 + 64 * (nb & 1), r / 44, scr, lane); continue; } r -= 704;
        transpose_item(A.in[I_WDN] + (size_t)l * DFF * DM, DFF, DM, 64 * (r % 16), nullptr, (bf16_t*)(ws + WS_WDN + l * SZ_WDN), 64 * (r % 16), r / 16, scr, lane);
    }
    for (int e = blockIdx.x * NTHR + tid; e < NL * 16 * DM; e += G * NTHR) {
        const int l = e / (16 * DM), j = (e / DM) & 15, k = e % DM;
        const float v = j < 8 ? A.in[I_WIN][(size_t)l * DM * DIN + (size_t)k * DIN + 2048 + j] * A.in[I_NMIXG][l * DM + k] : 0.f;
        ((bf16_t*)(ws + WS_WG8 + l * SZ_WG8))[j * DM + k] = f2bf(v);
    }
    bf16_t* XB = (bf16_t*)(ws + WS_XB); u64_t* SSQ = (u64_t*)(ws + WS_SSQ);
    for (int row = gw; row < MALL + 4096; row += NGW) {
        if (row < MALL) {
            const float* src = row < MP ? A.in[I_XP] + (size_t)row * DM : A.in[I_XS] + (size_t)(row - MP) * DM;
            const float s = row_to_bf16(src, XB + (size_t)row * DM, lane);
            if (lane == 0) SSQ[row] = (u64_t)(s * SSQ_FIX);
        } else {
            const int r = row - MALL;
            const float s = row_to_bf16(A.in[I_MEM] + (size_t)r * DM, (bf16_t*)(ws + WS_MEMB) + (size_t)r * DM, lane);
            if (lane == 0) ((float*)(ws + WS_SSQM))[r] = s;
        }
    }
    for (int e = blockIdx.x * NTHR + tid; e < 256 * DM / 8; e += G * NTHR) ((u32x4*)(XB + (size_t)MALL * DM))[e] = (u32x4){0u, 0u, 0u, 0u};
    {
        bf16_t* SMK = (bf16_t*)(ws + WS_SMK);
        const int NV = NL * BS * 4 * 256 * 16;
        for (int v = blockIdx.x * NTHR + tid; v < NV; v += G * NTHR) {
            const int d8 = v & 15, n = (v >> 4) & 255, h = (v >> 12) & 3, sb = (v >> 14) & 31, l = v >> 19;
            const float* src = A.in[I_CMK] + ((((size_t)(l * BS + sb) * 256 + n) * 4 + h) * 128 + 8 * d8);
            const float* g = A.in[I_MQG] + l * 128 + 8 * d8;
            const f32x4 a = *(const f32x4*)src, b = *(const f32x4*)(src + 4), ga = *(const f32x4*)g, gb = *(const f32x4*)(g + 4);
            u32x4 o; o.x = pk2(a[0] * ga[0], a[1] * ga[1]); o.y = pk2(a[2] * ga[2], a[3] * ga[3]); o.z = pk2(b[0] * gb[0], b[1] * gb[1]); o.w = pk2(b[2] * gb[2], b[3] * gb[3]);
            *(u32x4*)(SMK + (size_t)v * 8) = o;
        }
    }
    __syncthreads();
    for (int t = blockIdx.x; t < NL * BS * 4; t += G) {
        const int h = t & 3, sb = (t >> 2) & 31, l = t >> 7;
        transpose_v_tile(A.in[I_CMV] + ((size_t)(l * BS + sb) * 256 * 4 + h) * 128, 512, (bf16_t*)(ws + WS_SMVT) + (size_t)t * 128 * 256, lds, tid);
    }
}

DI void phase_memkv_post(const Args& A, LAS unsigned char* lds) {
    const int tid = otid(), lane = tid & 63, wave = tid >> 6, G = gridDim.x;
    const float* RAW = (const float*)(A.ws + WS_RAWKV);
    for (int u = blockIdx.x; u < NL * BP * 4; u += G) {
        const int h = u & 3, b = (u >> 2) & 15, l = u >> 6;
        const float mkg0 = A.in[I_MKG][l * 128 + 2 * lane], mkg1 = A.in[I_MKG][l * 128 + 2 * lane + 1];
        const float mqg0 = A.in[I_MQG][l * 128 + 2 * lane], mqg1 = A.in[I_MQG][l * 128 + 2 * lane + 1];
        bf16_t* MK = (bf16_t*)(A.ws + WS_MK) + (size_t)((l * BP + b) * 4 + h) * 256 * 128;
        for (int n = wave; n < 256; n += NWAVES) {
            const float* src = RAW + (size_t)(b * 256 + n) * 4096 + l * 1024 + h * 128;
            const f32x2 k = *(const f32x2*)(src + 2 * lane), v = *(const f32x2*)(src + 512 + 2 * lane);
            const float ss = wave_sum(k[0] * k[0] + k[1] * k[1]);
            const float rs = rsqrtf(ss * (1.0f / 128.0f) + EPS);
            const float k0 = k[0] * rs * mkg0, k1 = k[1] * rs * mkg1;
            const size_t oo = (((size_t)(l * BP + b) * 256 + n) * 4 + h) * 128 + 2 * lane;
            *(f32x2*)(A.out + O_PMK + oo) = (f32x2){k0, k1};
            *(f32x2*)(A.out + O_PMV + oo) = v;
            *(unsigned*)(MK + (size_t)n * 128 + 2 * lane) = pk2(k0 * mqg0, k1 * mqg1);
        }
        __syncthreads();
        transpose_v_tile(RAW + (size_t)(b * 256) * 4096 + l * 1024 + 512 + h * 128, 4096, (bf16_t*)(A.ws + WS_MVT) + (size_t)((l * BP + b) * 4 + h) * 128 * 256, lds, tid);
    }
}
constexpr int P_K = 0, P_Q = 17408, P_VB = 34816, P_KB = 52224, P_KD = 69632, P_LD = 87040, P_LB = 91136, P_DI = 100352, P_GR = 102400, P_BETA = 106496, P_GC = 107520,
    P_CW = 108544, P_WST = 114688, P_END = 132096;
DI void prep_load_cw(const float* cw, int h, LAS float* CW, int t0, int nt) {
    for (int v = t0; v < 4 * 3 * 32; v += nt) { const int c4 = v & 31, x = (v >> 5) % 3, i = v / 96; *(LAS f32x4*)(CW + (i * 3 + x) * 128 + 4 * c4) = *(const f32x4*)(cw + i * 1536 + x * 512 + h * 128 + 4 * c4); }
}
DI void prep_unit(const Args& A, LAS unsigned char* lds, int l, int u) {
    const int tid = otid(), lane = tid & 63, wave = __builtin_amdgcn_readfirstlane(tid >> 6), fr = lane & 15, fq = lane >> 4;
    const bool smp = u >= 1024;
    const int b = smp ? (u - 1024) : (u >> 6), c = smp ? 0 : (u & 63);
    const int row0 = smp ? MP + 16 * b : b * TP + 64 * c;
    const int chbase = smp ? 4096 + 4 * b : b * 256 + c, chstep = smp ? 1 : 64;
    const bf16_t* Z = (const bf16_t*)(A.ws + WS_Z); const bf16_t* XB = (const bf16_t*)(A.ws + WS_XB); const u64_t* SSQ = (const u64_t*)(A.ws + WS_SSQ) + (size_t)(3 * l) * MALL;
    bf16_t* PREP = (bf16_t*)(A.ws + WS_PREP); float* EG = (float*)(A.ws + WS_EG);
    LAS bf16_t* Ksh = (LAS bf16_t*)(lds + P_K); LAS bf16_t* Qsh = (LAS bf16_t*)(lds + P_Q); LAS bf16_t* VB = (LAS bf16_t*)(lds + P_VB); LAS bf16_t* KB = (LAS bf16_t*)(lds + P_KB);
    LAS bf16_t* KD = (LAS bf16_t*)(lds + P_KD); LAS float* LD = (LAS float*)(lds + P_LD); LAS bf16_t* LB = (LAS bf16_t*)(lds + P_LB); LAS bf16_t* DI_ = (LAS bf16_t*)(lds + P_DI);
    LAS float* GR = (LAS float*)(lds + P_WST);       LAS float* BETA = (LAS float*)(lds + P_BETA); LAS float* GC = (LAS float*)(lds + P_GC);
    LAS float* CW = (LAS float*)(lds + P_CW); LAS bf16_t* WST = (LAS bf16_t*)(lds + P_WST);
    const float* cw = A.in[I_GCW] + (size_t)l * 4 * 1536;
    {
        const int tw = wave & 3, kh = wave >> 2;
        const bf16_t* wg = (const bf16_t*)(A.ws + WS_WG8 + l * SZ_WG8) + (size_t)fr * DM + 8 * fq + 512 * kh;
        int tr = 16 * tw + fr; if (smp && tr >= 16) tr = 15;
        const bf16_t* xa = XB + (size_t)(row0 + tr) * DM + 8 * fq + 512 * kh;
        f32x4 acc = {0.f, 0.f, 0.f, 0.f};
#pragma unroll
        for (int ks = 0; ks < 16; ++ks) acc = MFMA16(*(const bf16x8*)(xa + 32 * ks), *(const bf16x8*)(wg + 32 * ks), acc);
#pragma unroll
        for (int e = 0; e < 4; ++e) GR[kh * 1024 + (16 * tw + 4 * fq + e) * 16 + fr] = acc[e];
    }
    prep_load_cw(cw, 0, CW, tid, NTHR);
    LBAR();
    if (tid < 256) {
        const int t = tid >> 2, h = tid & 3;
        int tr = t; if (smp && tr >= 16) tr = 15;
        const float rs = row_rstd(SSQ, row0 + tr);
        const float bt = sigmoidf_((GR[t * 16 + h] + GR[1024 + t * 16 + h]) * rs);
        const float a2 = (GR[t * 16 + 4 + h] + GR[1024 + t * 16 + 4 + h]) * rs + A.in[I_DTB][l * 4 + h];
        float g = -__expf(A.in[I_ALOG][l * 4 + h]) * softplusf_(a2);
        const bool pad = smp && t >= 16;
        BETA[h * 64 + t] = pad ? 0.f : bt; GC[h * 64 + t] = pad ? 0.f : g;
    } else if (smp || c == 63) {
        float* dst = smp ? A.out + O_SGC + (size_t)(l * BS + b) * 3 * 1536 : A.out + O_PGC + (size_t)(l * BP + b) * 3 * 1536;
        const int tl = smp ? 13 : 61;
        for (int e = tid - 256; e < 3 * 1536; e += 256) { const int j = e / 1536, col = e % 1536; dst[e] = bf2f(Z[(size_t)(row0 + tl + j) * NZ + col]); }
    }
    LBAR();
    if (wave < 4) {
        float v = GC[wave * 64 + lane];
#pragma unroll
        for (int o = 1; o < 64; o <<= 1) { const float up = __shfl_up(v, o); if (lane >= o) v += up; }
        GC[wave * 64 + lane] = v;
        if (lane == 63) EG[chbase + wave * chstep] = __expf(v);
    }
    LBAR();
    for (int h = 0; h < 4; ++h) {
        bf16_t* P = PREP + (size_t)(chbase + h * chstep) * PCH;
        if (h > 0) { bf16_t* Pp = PREP + (size_t)(chbase + (h - 1) * chstep) * PCH;
#pragma unroll
            for (int i = 0; i < 2; ++i) { const int v = tid + 512 * i, t = v >> 4, d8 = v & 15; *(u32x4*)(Pp + PW + ((((t >> 4) * 4 + (d8 >> 2)) * 64 + (d8 & 3) * 16 + (t & 15)) << 3)) = *(const LAS u32x4*)(WST + t * 136 + 8 * d8); } }
#pragma unroll 1
        for (int pass = 0; pass < 2; ++pass) {
            const int t = (tid >> 4) + 32 * pass, seg = tid & 15, cg = h * 128 + 8 * seg;
            const bool pad = smp && t >= 16;
            u32x4 zr[3][4];
#pragma unroll
            for (int x = 0; x < 3; ++x)
#pragma unroll
                for (int i = 0; i < 4; ++i) {
                    const int tt = t - 3 + i, col = x * 512 + cg;
                    if (tt >= 0 || (!smp && c > 0)) zr[x][i] = *(const u32x4*)(Z + (size_t)(row0 + tt) * NZ + col);
                    else if (smp) { const float* cp = A.in[I_CGC] + ((size_t)(l * BS + b) * 3 + (tt + 3)) * 1536 + col; float f[8];
                        const f32x4 q0 = *(const f32x4*)cp, q1 = *(const f32x4*)(cp + 4); f[0] = q0[0]; f[1] = q0[1]; f[2] = q0[2]; f[3] = q0[3]; f[4] = q1[0]; f[5] = q1[1]; f[6] = q1[2]; f[7] = q1[3]; zr[x][i] = pk8(f); }
                    else zr[x][i] = (u32x4){0u, 0u, 0u, 0u};
                }
            const float gct = GC[h * 64 + t], egt = __expf(gct), bt = BETA[h * 64 + t], ed = __expf(GC[h * 64 + 63] - gct);
#pragma unroll
            for (int x = 0; x < 3; ++x) {
                float acc[8];
#pragma unroll
                for (int j = 0; j < 8; ++j) acc[j] = 0.f;
#pragma unroll
                for (int i = 0; i < 4; ++i) {
                    float xv[8]; unpk8(zr[x][i], xv);
                    const f32x4 w0 = *(const LAS f32x4*)(CW + (i * 3 + x) * 128 + 8 * seg), w1 = *(const LAS f32x4*)(CW + (i * 3 + x) * 128 + 8 * seg + 4);
                    acc[0] += w0[0] * xv[0]; acc[1] += w0[1] * xv[1]; acc[2] += w0[2] * xv[2]; acc[3] += w0[3] * xv[3];
                    acc[4] += w1[0] * xv[4]; acc[5] += w1[1] * xv[5]; acc[6] += w1[2] * xv[6]; acc[7] += w1[3] * xv[7];
                }
                float ssum = 0.f;
#pragma unroll
                for (int j = 0; j < 8; ++j) { acc[j] = pad ? 0.f : siluf_(acc[j]); ssum += acc[j] * acc[j]; }
                ssum += __shfl_xor(ssum, 1); ssum += __shfl_xor(ssum, 2); ssum += __shfl_xor(ssum, 4); ssum += __shfl_xor(ssum, 8);
                const float rn = rsqrtf(ssum + EPS);
                if (x == 0) {
                    float qe[8];
#pragma unroll
                    for (int j = 0; j < 8; ++j) { acc[j] *= rn * 0.08838834764831845f; qe[j] = acc[j] * egt; }
                    *(LAS u32x4*)(Qsh + t * 136 + 8 * seg) = pk8(acc);
                    *(u32x4*)(P + PQE + ((((t >> 4) * 4 + (seg >> 2)) * 64 + (seg & 3) * 16 + (t & 15)) << 3)) = pk8(qe);
                } else if (x == 1) {
                    const float kb = bt * egt; float k1[8], k2[8];
#pragma unroll
                    for (int j = 0; j < 8; ++j) { acc[j] *= rn; k1[j] = acc[j] * kb; k2[j] = acc[j] * ed; }
                    *(LAS u32x4*)(Ksh + t * 136 + 8 * seg) = pk8(acc); *(LAS u32x4*)(KB + t * 136 + 8 * seg) = pk8(k1); *(LAS u32x4*)(KD + t * 136 + 8 * seg) = pk8(k2);
                } else {
#pragma unroll
                    for (int j = 0; j < 8; ++j) acc[j] *= bt;
                    *(LAS u32x4*)(VB + t * 136 + 8 * seg) = pk8(acc);
                }
            }
        }
        LBAR();
        {
#pragma unroll
            for (int i = 0; i < 2; ++i) { const int v = tid + 512 * i, d = v & 127, t8 = v >> 7; unsigned w[4];
#pragma unroll
                for (int j = 0; j < 4; ++j) w[j] = (unsigned)KD[(8 * t8 + 2 * j) * 136 + d] | ((unsigned)KD[(8 * t8 + 2 * j + 1) * 136 + d] << 16);
                *(u32x4*)(P + PKDT + ((((d >> 4) * 2 + (t8 >> 2)) * 64 + (t8 & 3) * 16 + (d & 15)) << 3)) = (u32x4){w[0], w[1], w[2], w[3]}; }
#pragma unroll
            for (int i = 0; i < 4; ++i) {
                const int id = wave + 8 * i, isqk = id >> 4, st = (id >> 2) & 3, tt = id & 3;
                f32x4 acc = {0.f, 0.f, 0.f, 0.f};
                if (st <= tt) {
                    const LAS bf16_t* ap = Ksh + (16 * st + fr) * 136 + 8 * fq;
                    const LAS bf16_t* bp = (isqk ? Qsh : Ksh) + (16 * tt + fr) * 136 + 8 * fq;
#pragma unroll
                    for (int ks = 0; ks < 4; ++ks) acc = MFMA16(*(const LAS bf16x8*)(ap + 32 * ks), *(const LAS bf16x8*)(bp + 32 * ks), acc);
                }
                const int t = 16 * tt + fr; const float gct = GC[h * 64 + t], bt = BETA[h * 64 + t];
                f32x4 o;
#pragma unroll
                for (int e = 0; e < 4; ++e) {
                    const int s = 16 * st + 4 * fq + e;
                    const float dec = __expf(fminf(gct - GC[h * 64 + s], 0.f));
                    if (isqk) o[e] = (s <= t) ? acc[e] * dec : 0.f;
                    else o[e] = (s < t) ? acc[e] * dec * bt : 0.f;
                }
                if (isqk) *(u32x2*)(P + PQK + (((tt * 2 + (st >> 1)) * 64 + (2 * (st & 1) + (fq >> 1)) * 16 + fr) << 3) + 4 * (fq & 1)) = pk4(o);
                else if (st == tt) *(LAS f32x4*)(LD + (st * 16 + fr) * 16 + 4 * fq) = o;
                else if (st < tt) *(LAS u32x2*)(LB + t * 72 + 16 * st + 4 * fq) = pk4(-o);
            }
        }
        LBAR();
        if (wave == 0) {
            const int blk = lane >> 4, cc = lane & 15;
            float x[16];
#pragma unroll
            for (int i = 0; i < 16; ++i) {
                float s = (i == cc) ? 1.f : 0.f;
                const LAS float* lr = LD + (blk * 16 + i) * 16;
#pragma unroll
                for (int j = 0; j < i; ++j) s -= lr[j] * x[j];
                x[i] = s;
            }
#pragma unroll
            for (int i = 0; i < 16; ++i) DI_[(blk * 16 + i) * 16 + cc] = f2bf(x[i]);
        } else if (h < 3) prep_load_cw(cw, h + 1, CW, tid - 64, 448);
        LBAR();
#pragma unroll
        for (int cti = 0; cti < 2; ++cti) {
            const int ct = 2 * wave + cti; const bool isw = ct >= 8; const int d = 16 * (ct & 7) + fr;
            const LAS bf16_t* rhs = (isw ? KB : VB) + d;
            bf16x4 Xb[4];
#pragma unroll
            for (int i = 0; i < 4; ++i) {
                f32x4 acc;
#pragma unroll
                for (int e = 0; e < 4; ++e) acc[e] = bf2f(rhs[(16 * i + 4 * fq + e) * 136]);
#pragma unroll
                for (int k = 0; k < i; ++k) acc = MFMA16K16(*(const LAS bf16x4*)(LB + (16 * i + fr) * 72 + 16 * k + 4 * fq), Xb[k], acc);
                const u32x2 ab = pk4(acc);
                const f32x4 xi = MFMA16K16(*(const LAS bf16x4*)(DI_ + (i * 16 + fr) * 16 + 4 * fq), __builtin_bit_cast(bf16x4, ab), ((f32x4){0.f, 0.f, 0.f, 0.f}));
                const u32x2 xb = pk4(xi); Xb[i] = __builtin_bit_cast(bf16x4, xb);
                if (!isw) *(u32x2*)(P + PUT + ((((ct & 7) * 4 + i) * 64 + fq * 16 + fr) << 2)) = xb;
                else {
                    WST[(16 * i + 4 * fq + 0) * 136 + d] = (bf16_t)(xb.x & 0xffffu); WST[(16 * i + 4 * fq + 1) * 136 + d] = (bf16_t)(xb.x >> 16);
                    WST[(16 * i + 4 * fq + 2) * 136 + d] = (bf16_t)(xb.y & 0xffffu); WST[(16 * i + 4 * fq + 3) * 136 + d] = (bf16_t)(xb.y >> 16);
                }
            }
        }
        LBAR();
    }
    { bf16_t* Pp = PREP + (size_t)(chbase + 3 * chstep) * PCH;
#pragma unroll
        for (int i = 0; i < 2; ++i) { const int v = tid + 512 * i, t = v >> 4, d8 = v & 15; *(u32x4*)(Pp + PW + ((((t >> 4) * 4 + (d8 >> 2)) * 64 + (d8 & 3) * 16 + (t & 15)) << 3)) = *(const LAS u32x4*)(WST + t * 136 + 8 * d8); } }
    LBAR();
}

constexpr int S_ST = 0, S_VN = 34816, S_NP = 53248;
struct ScanOps { bf16x8 Wf[4], QEf[4], QKf[2], KDf[2]; u32x2 Uf[4]; u32x2 gz[4]; float eg; };
template <bool SMP>
DI void scan_load(ScanOps& o, const bf16_t* P, const bf16_t* Z, float egv, int row0, int h, int w, int tt, int dh, int fr, int fq, bool tok_ok) {
    const unsigned l16 = (unsigned)(fq * 16 + fr) * 16u, l8 = (unsigned)(fq * 16 + fr) * 8u;
    const char* Pb = (const char*)P;
    const char* pw = Pb + (size_t)(PW + tt * 2048) * 2; const char* pqe = Pb + (size_t)(PQE + tt * 2048) * 2; const char* pqk = Pb + (size_t)(PQK + tt * 1024) * 2;
    const char* pkd = Pb + (size_t)(PKDT + w * 1024) * 2; const char* pu = Pb + (size_t)(PUT + (16 * dh * 256 + tt * 256)) * 2;
#pragma unroll
    for (int ks = 0; ks < 4; ++ks) { o.Wf[ks] = *(const bf16x8*)(pw + ks * 1024 + l16); o.QEf[ks] = *(const bf16x8*)(pqe + ks * 1024 + l16); }
#pragma unroll
    for (int ks = 0; ks < 2; ++ks) { o.QKf[ks] = *(const bf16x8*)(pqk + ks * 1024 + l16); o.KDf[ks] = *(const bf16x8*)(pkd + ks * 1024 + l16); }
#pragma unroll
    for (int j = 0; j < 4; ++j) o.Uf[j] = *(const u32x2*)(pu + j * 2048 + l8);
    if (SMP) { int gr = row0 + 16 * tt + fr; gr = gr < MALL ? gr : MALL - 1;
#pragma unroll
        for (int j = 0; j < 4; ++j) o.gz[j] = *(const u32x2*)(Z + (size_t)gr * NZ + ZG + h * 128 + 16 * (4 * dh + j) + 4 * fq); }
    else { const char* zb = (const char*)Z + ((size_t)(row0 + 16 * tt) * NZ + ZG + h * 128 + 64 * dh) * 2; const unsigned lz = (unsigned)(fr * NZ + 4 * fq) * 2u;
#pragma unroll
        for (int j = 0; j < 4; ++j) o.gz[j] = *(const u32x2*)(zb + j * 32 + lz); }
    o.eg = egv;
}
template <bool SMP>
DI void scan_step(const ScanOps& o, f32x4 (&S)[8], LAS bf16_t* ST, LAS bf16_t* VN, LAS float* NP, bf16_t* Y, const f32x4 (&gn4)[4], int row0, int h, int w, int tt, int dh, int fr, int fq, bool tok_ok) {
    f32x4 accO[4];
#pragma unroll
    for (int j = 0; j < 4; ++j) {
        const int dt = 4 * dh + j;
        f32x4 accV = {0.f, 0.f, 0.f, 0.f}; accO[j] = (f32x4){0.f, 0.f, 0.f, 0.f};
#pragma unroll
        for (int ks = 0; ks < 4; ++ks) {
            const bf16x8 B = *(const LAS bf16x8*)(ST + (16 * dt + fr) * 136 + 32 * ks + 8 * fq);
            accV = MFMA16(o.Wf[ks], B, accV); accO[j] = MFMA16(B, o.QEf[ks], accO[j]);
        }
        const f32x4 vn = unpk4(o.Uf[j]) - accV;
        *(LAS u32x2*)(VN + (16 * dt + fr) * 72 + 16 * tt + 4 * fq) = pk4(vn);
    }
    LBAR();
#pragma unroll
    for (int j = 0; j < 4; ++j) {
        const int dt = 4 * dh + j;
#pragma unroll
        for (int ks = 0; ks < 2; ++ks) accO[j] = MFMA16(*(const LAS bf16x8*)(VN + (16 * dt + fr) * 72 + 32 * ks + 8 * fq), o.QKf[ks], accO[j]);
    }
    {
        float p = 0.f;
#pragma unroll
        for (int j = 0; j < 4; ++j) p += (accO[j][0] * accO[j][0] + accO[j][1] * accO[j][1]) + (accO[j][2] * accO[j][2] + accO[j][3] * accO[j][3]);
        p += __shfl_xor(p, 16); p += __shfl_xor(p, 32);
        if (fq == 0) NP[(16 * tt + fr) * 2 + dh] = p;
    }
#pragma unroll
    for (int dt = 0; dt < 8; ++dt) {
        S[dt] = S[dt] * o.eg;
#pragma unroll
        for (int ks = 0; ks < 2; ++ks) S[dt] = MFMA16(o.KDf[ks], *(const LAS bf16x8*)(VN + (16 * dt + fr) * 72 + 32 * ks + 8 * fq), S[dt]);
        *(LAS u32x2*)(ST + (16 * dt + fr) * 136 + 16 * w + 4 * fq) = pk4(S[dt]);
    }
    LBAR();
    if (!SMP || tok_ok) {
        const int t = 16 * tt + fr;
        const float rs = rsqrtf((NP[t * 2] + NP[t * 2 + 1]) * (1.0f / 128.0f) + EPS);
        char* yb = (char*)Y + ((size_t)(row0 + 16 * tt) * DM + h * 128) * 2; const unsigned ly = (unsigned)(fr * DM + 4 * fq) * 2u;
#pragma unroll
        for (int j = 0; j < 4; ++j) {
            const f32x4 g4 = gn4[j]; const f32x4 z4 = unpk4(o.gz[j]);
            f32x4 v;
#pragma unroll
            for (int e = 0; e < 4; ++e) v[e] = accO[j][e] * rs * g4[e] * siluf_(z4[e]);
            *(u32x2*)(yb + 32 * (4 * dh + j) + ly) = pk4(v);
        }
    }
}
DI void scan_item(const Args& A, LAS unsigned char* lds, int l, int item) {
    const int tid = otid(), lane = tid & 63, w = __builtin_amdgcn_readfirstlane(tid >> 6), fr = lane & 15, fq = lane >> 4, tt = w & 3, dh = w >> 2;
    const bool smp = item >= 64;
    const int b = smp ? ((item - 64) >> 2) : (item >> 2), h = item & 3, nsteps = smp ? 1 : 64;
    const bf16_t* Z = (const bf16_t*)(A.ws + WS_Z); bf16_t* Y = (bf16_t*)(A.ws + WS_Y);
    const bf16_t* PREP = (const bf16_t*)(A.ws + WS_PREP); const float* EG = (const float*)(A.ws + WS_EG);
    LAS bf16_t* ST = (LAS bf16_t*)(lds + S_ST); LAS bf16_t* VN = (LAS bf16_t*)(lds + S_VN); LAS float* NP = (LAS float*)(lds + S_NP);
    f32x4 gn4[4];
#pragma unroll
    for (int j = 0; j < 4; ++j) gn4[j] = *(const f32x4*)(A.in[I_GNG] + l * 128 + 16 * (4 * dh + j) + 4 * fq);
    const bool tok_ok = !smp || tt == 0;
    f32x4 S[8];
    if (smp) {
        const float* s0 = A.in[I_STATE] + (size_t)((l * BS + b) * 4 + h) * 128 * 128;
#pragma unroll
        for (int dt = 0; dt < 8; ++dt)
#pragma unroll
            for (int e = 0; e < 4; ++e) S[dt][e] = s0[(size_t)(16 * w + 4 * fq + e) * 128 + 16 * dt + fr];
    } else {
#pragma unroll
        for (int dt = 0; dt < 8; ++dt) S[dt] = (f32x4){0.f, 0.f, 0.f, 0.f};
    }
#pragma unroll
    for (int dt = 0; dt < 8; ++dt) *(LAS u32x2*)(ST + (16 * dt + fr) * 136 + 16 * w + 4 * fq) = pk4(S[dt]);
    const int ch0 = smp ? 4096 + 4 * b + h : (b * 4 + h) * 64;
    const int r00 = smp ? MP + 16 * b : b * TP;
    int zv = 0; asm volatile("" : "+v"(zv));
    const float* EGv = EG + zv;
    ScanOps oa, ob;
    if (smp) {
        scan_load<true>(oa, PREP + (size_t)ch0 * PCH, Z, EGv[ch0], r00, h, w, tt, dh, fr, fq, tok_ok);
        __syncthreads();
        scan_step<true>(oa, S, ST, VN, NP, Y, gn4, r00, h, w, tt, dh, fr, fq, tok_ok);
    } else {
        scan_load<false>(oa, PREP + (size_t)ch0 * PCH, Z, EGv[ch0], r00, h, w, tt, dh, fr, fq, true);
        __syncthreads();
#pragma unroll 1
        for (int c = 0; c < 64; c += 2) {
            scan_load<false>(ob, PREP + (size_t)(ch0 + (c + 1)) * PCH, Z, EGv[ch0 + (c + 1)], r00 + 64 * (c + 1), h, w, tt, dh, fr, fq, true);
            scan_step<false>(oa, S, ST, VN, NP, Y, gn4, r00 + 64 * c, h, w, tt, dh, fr, fq, true);
            const int cn = c + 2 < 64 ? c + 2 : 63;
            scan_load<false>(oa, PREP + (size_t)(ch0 + cn) * PCH, Z, EGv[ch0 + cn], r00 + 64 * cn, h, w, tt, dh, fr, fq, true);
            scan_step<false>(ob, S, ST, VN, NP, Y, gn4, r00 + 64 * (c + 1), h, w, tt, dh, fr, fq, true);
        }
    }
    float* so = (smp ? A.out + O_SGS + (size_t)((l * BS + b) * 4 + h) * 128 * 128 : A.out + O_PGS + (size_t)((l * BP + b) * 4 + h) * 128 * 128);
#pragma unroll
    for (int dt = 0; dt < 8; ++dt)
#pragma unroll
        for (int e = 0; e < 4; ++e) so[(size_t)(16 * w + 4 * fq + e) * 128 + 16 * dt + fr] = S[dt][e];
    __syncthreads();
}
constexpr float SB_CUT = 50.0f;
DI float neg_softplus(float z) {
    const float e = __builtin_amdgcn_exp2f(-fabsf(z) * 1.4426950408889634f);
    return -(fmaxf(z, 0.f) + __builtin_amdgcn_logf(1.0f + e) * 0.6931471805599453f);
}
template <bool SMP>
DI void sb_wave_unit(const Args& A, int l, int idx, int lane) {
    const int qi = lane & 31, hi = lane >> 5;
    const bf16_t* Z = (const bf16_t*)(A.ws + WS_Z); bf16_t* Y = (bf16_t*)(A.ws + WS_Y);
    int h, qrow, t0, b;
    bool qvalid = true;
    if (SMP) { b = idx >> 2; h = idx & 3; t0 = 0; qvalid = qi < TS; qrow = MP + TS * b + (qvalid ? qi : TS - 1); }
    else { h = idx & 3; const int qt = (idx >> 2) & 127; b = idx >> 9; t0 = 32 * qt; qrow = b * TP + t0 + qi; }
    bf16x8 Qf[4];
#pragma unroll
    for (int s = 0; s < 4; ++s) Qf[s] = *(const bf16x8*)(Z + (size_t)qrow * NZ + ZCQ + h * 64 + 16 * s + 8 * hi);
    f32x16 o0, o1;
#pragma unroll
    for (int r = 0; r < 16; ++r) { o0[r] = 0.f; o1[r] = 0.f; }
    float R = 0.f;
    const int nblk = SMP ? 1 + PAST / 32 : (t0 >> 5) + 1;
    const float* ck = SMP ? A.in[I_CSBK] + (size_t)(l * BS + b) * PAST * 256 + h * 64 : nullptr;
    const float* cv = SMP ? A.in[I_CSBV] + (size_t)(l * BS + b) * PAST * 256 + h * 64 : nullptr;
    for (int blk = 0; blk < nblk; ++blk) {
        const bool first = blk == 0;
        const bool from_z = !SMP || first;
        const int kbase = SMP ? (first ? 0 : PAST - 32 * blk) : t0 - 32 * blk;
        f32x16 acc;
#pragma unroll
        for (int r = 0; r < 16; ++r) acc[r] = 0.f;
        if (from_z) {
            int kr = kbase + qi; if (SMP && kr >= TS) kr = TS - 1;
            const bf16_t* kp = Z + (size_t)((SMP ? MP + TS * b : b * TP) + kr) * NZ + ZCK + h * 64 + 8 * hi;
#pragma unroll
            for (int s = 0; s < 4; ++s) acc = MFMA32(*(const bf16x8*)(kp + 16 * s), Qf[s], acc);
        } else {
            const float* kp = ck + (size_t)(kbase + qi) * 256 + 8 * hi;
#pragma unroll
            for (int s = 0; s < 4; ++s) { const f32x4 a = *(const f32x4*)(kp + 16 * s), c4 = *(const f32x4*)(kp + 16 * s + 4);
                u32x4 kf; kf.x = pk2(a[0], a[1]); kf.y = pk2(a[2], a[3]); kf.z = pk2(c4[0], c4[1]); kf.w = pk2(c4[2], c4[3]);
                acc = MFMA32(__builtin_bit_cast(bf16x8, kf), Qf[s], acc); }
        }
        float lb[16]; float gs[4];
#pragma unroll
        for (int r = 0; r < 16; ++r) {
            const int kl = (r & 3) + 8 * (r >> 2) + 4 * hi;
            const bool valid = first ? (SMP ? (kl < qi && kl < TS) : (kl < qi)) : true;
            acc[r] *= 0.125f;
            lb[r] = valid ? neg_softplus(acc[r]) : 0.f;
        }
#pragma unroll
        for (int g = 0; g < 4; ++g) gs[g] = (lb[4 * g] + lb[4 * g + 1]) + (lb[4 * g + 2] + lb[4 * g + 3]);
        float og[4];
#pragma unroll
        for (int g = 0; g < 4; ++g) og[g] = __shfl_xor(gs[g], 32);
        float off[4]; float run = 0.f;
#pragma unroll
        for (int g = 3; g >= 0; --g) {
            if (hi == 0) { run += og[g]; off[g] = run; run += gs[g]; }
            else { off[g] = run; run += gs[g] + og[g]; }
        }
        const float tot = (gs[0] + gs[1]) + (gs[2] + gs[3]) + (og[0] + og[1]) + (og[2] + og[3]);
        float p[16];
#pragma unroll
        for (int g = 0; g < 4; ++g) {
            float c = R + off[g];
#pragma unroll
            for (int e = 3; e >= 0; --e) {
                const int r = 4 * g + e; const int kl = (r & 3) + 8 * (r >> 2) + 4 * hi;
                const bool valid = first ? (SMP ? (kl < qi && kl < TS) : (kl < qi)) : true;
                p[r] = valid ? __builtin_amdgcn_exp2f((acc[r] + lb[r] + c) * 1.4426950408889634f) : 0.f;
                c += lb[r];
            }
        }
        R += tot;
#pragma unroll
        for (int s = 0; s < 2; ++s) {
            u32x4 pf; pf.x = pk2(p[8 * s], p[8 * s + 1]); pf.y = pk2(p[8 * s + 2], p[8 * s + 3]); pf.z = pk2(p[8 * s + 4], p[8 * s + 5]); pf.w = pk2(p[8 * s + 6], p[8 * s + 7]);
            const bf16x8 pb = __builtin_bit_cast(bf16x8, pf);
#pragma unroll
            for (int dt = 0; dt < 2; ++dt) {
                float vv[8];
#pragma unroll
                for (int j = 0; j < 8; ++j) {
                    const int kl = 16 * s + 8 * (j >> 2) + 4 * hi + (j & 3);
                    if (from_z) { int kr = kbase + kl; if (SMP && kr >= TS) kr = TS - 1;
                        vv[j] = bf2f(Z[(size_t)((SMP ? MP + TS * b : b * TP) + kr) * NZ + ZCV + h * 64 + 32 * dt + qi]); }
                    else vv[j] = cv[(size_t)(kbase + kl) * 256 + 32 * dt + qi];
                }
                const u32x4 vf = pk8(vv);
                if (dt == 0) o0 = MFMA32(__builtin_bit_cast(bf16x8, vf), pb, o0); else o1 = MFMA32(__builtin_bit_cast(bf16x8, vf), pb, o1);
            }
        }
        if (__all(R < -SB_CUT)) break;
    }
    float ss = 0.f;
#pragma unroll
    for (int r = 0; r < 16; ++r) ss += o0[r] * o0[r] + o1[r] * o1[r];
    ss += __shfl_xor(ss, 32);
    const float rs = rsqrtf(ss * (1.0f / 64.0f) + EPS);
    if (qvalid) {
        const float* g = A.in[I_SBG] + l * 256 + h * 64;
        bf16_t* yp = Y + (size_t)qrow * DM + 768 + h * 64;
#pragma unroll
        for (int dt = 0; dt < 2; ++dt)
#pragma unroll
            for (int g4 = 0; g4 < 4; ++g4) {
                const int d = 32 * dt + 8 * g4 + 4 * hi;
                const f32x4 gg = *(const f32x4*)(g + d);
                f32x4 v;
#pragma unroll
                for (int e = 0; e < 4; ++e) v[e] = (dt == 0 ? o0[4 * g4 + e] : o1[4 * g4 + e]) * rs * gg[e];
                *(u32x2*)(yp + d) = pk4(v);
            }
    }
}

DI void sc_task(const Args& A, int l, int task) {
    const int cgi = task & 31, seg = task >> 5, r0 = 16 * seg, c0 = 8 * cgi;
    const bf16_t* Z = (const bf16_t*)(A.ws + WS_Z); bf16_t* Y = (bf16_t*)(A.ws + WS_Y);
    const bool smp = r0 >= MP; const int t0 = smp ? 0 : (r0 & (TP - 1)), T = smp ? TS : TP, bb = smp ? (r0 - MP) / TS : r0 / TP;
    float w0[8], w1[8], w2[8], gn[8], p2[8], p1[8];
    const float* cw = A.in[I_SCW] + (size_t)l * 3 * 256 + c0;
#pragma unroll
    for (int j = 0; j < 8; ++j) { w0[j] = cw[j]; w1[j] = cw[256 + j]; w2[j] = cw[512 + j]; gn[j] = A.in[I_SCG][l * 256 + c0 + j]; }
    if (t0 == 0) {
        if (smp) { const float* cp = A.in[I_CSC] + (size_t)(l * BS + bb) * 2 * 256 + c0;
#pragma unroll
            for (int j = 0; j < 8; ++j) { p2[j] = cp[j]; p1[j] = cp[256 + j]; } }
        else {
#pragma unroll
            for (int j = 0; j < 8; ++j) { p2[j] = 0.f; p1[j] = 0.f; } }
    } else {
        float a[8], c[8];
        unpk8(*(const u32x4*)(Z + (size_t)(r0 - 2) * NZ + ZSC + c0), a); unpk8(*(const u32x4*)(Z + (size_t)(r0 - 2) * NZ + ZSX + c0), c);
#pragma unroll
        for (int j = 0; j < 8; ++j) p2[j] = a[j] * c[j];
        unpk8(*(const u32x4*)(Z + (size_t)(r0 - 1) * NZ + ZSC + c0), a); unpk8(*(const u32x4*)(Z + (size_t)(r0 - 1) * NZ + ZSX + c0), c);
#pragma unroll
        for (int j = 0; j < 8; ++j) p1[j] = a[j] * c[j];
    }
    for (int i = 0; i < 16; ++i) {
        const bf16_t* zr = Z + (size_t)(r0 + i) * NZ;
        float sb[8], sc[8], sx[8], y[8];
        unpk8(*(const u32x4*)(zr + ZSB + c0), sb); unpk8(*(const u32x4*)(zr + ZSC + c0), sc); unpk8(*(const u32x4*)(zr + ZSX + c0), sx);
        float ss = 0.f;
#pragma unroll
        for (int j = 0; j < 8; ++j) { const float xs = sc[j] * sx[j]; const float uu = w0[j] * p2[j] + w1[j] * p1[j] + w2[j] * xs; p2[j] = p1[j]; p1[j] = xs; y[j] = sb[j] * uu; ss += y[j] * y[j]; }
        ss += __shfl_xor(ss, 1); ss += __shfl_xor(ss, 2); ss += __shfl_xor(ss, 4);
        const float rs = rsqrtf(ss * (1.0f / 64.0f) + EPS);
#pragma unroll
        for (int j = 0; j < 8; ++j) y[j] *= rs * gn[j];
        *(u32x4*)(Y + (size_t)(r0 + i) * DM + 512 + c0) = pk8(y);
    }
    if (t0 + 16 == T) {
        float* dst = smp ? A.out + O_SSC + (size_t)(l * BS + bb) * 2 * 256 + c0 : A.out + O_PSC + (size_t)(l * BP + bb) * 2 * 256 + c0;
#pragma unroll
        for (int j = 0; j < 8; ++j) { dst[j] = p2[j]; dst[256 + j] = p1[j]; }
    }
}

constexpr int MA_K = 0, MA_VT = 69632;
DI void memattn_load_kv(const bf16_t* K, const bf16_t* VT, LAS unsigned char* lds, int tid) {
    LAS bf16_t* Ks = (LAS bf16_t*)(lds + MA_K); LAS bf16_t* Vs = (LAS bf16_t*)(lds + MA_VT);
#pragma unroll
    for (int i = 0; i < 8; ++i) { const int v = tid + 512 * i, n = v >> 4, d8 = v & 15; *(LAS u32x4*)(Ks + n * 136 + 8 * d8) = *(const u32x4*)(K + (size_t)n * 128 + 8 * d8); }
#pragma unroll
    for (int i = 0; i < 8; ++i) { const int v = tid + 512 * i, d = v >> 5, n8 = v & 31; *(LAS u32x4*)(Vs + d * 264 + 8 * n8) = *(const u32x4*)(VT + (size_t)d * 256 + 8 * n8); }
}
DI void memattn_wave(const bf16_t* QM, bf16_t* OM, int qrow, bool qvalid, int h, LAS unsigned char* lds, int lane) {
    const int ql = lane & 31, hi = lane >> 5;
    const LAS bf16_t* Ks = (const LAS bf16_t*)(lds + MA_K); const LAS bf16_t* Vs = (const LAS bf16_t*)(lds + MA_VT);
    bf16x8 Qf[8]; float ssq = 0.f;
#pragma unroll
    for (int s = 0; s < 8; ++s) { const u32x4 q = *(const u32x4*)(QM + (size_t)qrow * 512 + h * 128 + 16 * s + 8 * hi); Qf[s] = __builtin_bit_cast(bf16x8, q);
        float f[8]; unpk8(q, f);
#pragma unroll
        for (int j = 0; j < 8; ++j) ssq += f[j] * f[j]; }
    ssq += __shfl_xor(ssq, 32);
    const float sc2 = rsqrtf(ssq * (1.0f / 128.0f) + EPS) * 0.08838834764831845f * 1.4426950408889634f;
    float mx = -3.0e38f;
#pragma unroll 2
    for (int mt = 0; mt < 8; ++mt) {
        f32x16 s1;
#pragma unroll
        for (int r = 0; r < 16; ++r) s1[r] = 0.f;
#pragma unroll
        for (int s = 0; s < 8; ++s) s1 = MFMA32(*(const LAS bf16x8*)(Ks + (32 * mt + ql) * 136 + 16 * s + 8 * hi), Qf[s], s1);
#pragma unroll
        for (int r = 0; r < 16; ++r) mx = fmaxf(mx, s1[r]);
    }
    mx = fmaxf(mx, __shfl_xor(mx, 32));
    float sum = 0.f;
    f32x16 o[4];
#pragma unroll
    for (int dt = 0; dt < 4; ++dt)
#pragma unroll
        for (int r = 0; r < 16; ++r) o[dt][r] = 0.f;
#pragma unroll 1
    for (int mt = 0; mt < 8; ++mt) {
        f32x16 s1;
#pragma unroll
        for (int r = 0; r < 16; ++r) s1[r] = 0.f;
#pragma unroll
        for (int s = 0; s < 8; ++s) s1 = MFMA32(*(const LAS bf16x8*)(Ks + (32 * mt + ql) * 136 + 16 * s + 8 * hi), Qf[s], s1);
#pragma unroll
        for (int r = 0; r < 16; ++r) { s1[r] = __builtin_amdgcn_exp2f((s1[r] - mx) * sc2); sum += s1[r]; }
#pragma unroll
        for (int s = 0; s < 2; ++s) {
            u32x4 pf; pf.x = pk2(s1[8 * s], s1[8 * s + 1]); pf.y = pk2(s1[8 * s + 2], s1[8 * s + 3]); pf.z = pk2(s1[8 * s + 4], s1[8 * s + 5]); pf.w = pk2(s1[8 * s + 6], s1[8 * s + 7]);
            const bf16x8 pb = __builtin_bit_cast(bf16x8, pf);
#pragma unroll
            for (int dt = 0; dt < 4; ++dt) {
                const LAS bf16_t* vp = Vs + (32 * dt + ql) * 264 + 32 * mt + 16 * s + 4 * hi;
                u32x4 vf; const u32x2 a = *(const LAS u32x2*)vp, c = *(const LAS u32x2*)(vp + 8); vf.x = a.x; vf.y = a.y; vf.z = c.x; vf.w = c.y;
                o[dt] = MFMA32(__builtin_bit_cast(bf16x8, vf), pb, o[dt]);
            }
        }
    }
    sum += __shfl_xor(sum, 32);
    const float inv = 1.0f / sum;
    if (qvalid) {
        bf16_t* op = OM + (size_t)qrow * 512 + h * 128;
#pragma unroll
        for (int dt = 0; dt < 4; ++dt)
#pragma unroll
            for (int g4 = 0; g4 < 4; ++g4) {
                f32x4 v;
#pragma unroll
                for (int e = 0; e < 4; ++e) v[e] = o[dt][4 * g4 + e] * inv;
                *(u32x2*)(op + 32 * dt + 8 * g4 + 4 * hi) = pk4(v);
            }
    }
}
DI void phase_memattn(const Args& A, LAS unsigned char* lds, int l) {
    const int tid = otid(), lane = tid & 63, wave = tid >> 6, G = gridDim.x;
    const bf16_t* QM = (const bf16_t*)(A.ws + WS_QM); bf16_t* OM = (bf16_t*)(A.ws + WS_OM);
    for (int u = blockIdx.x; u < BS * 4; u += G) {
        const int sb = u >> 2, h = u & 3;
        __syncthreads();
        memattn_load_kv((const bf16_t*)(A.ws + WS_SMK) + (size_t)((l * BS + sb) * 4 + h) * 256 * 128, (const bf16_t*)(A.ws + WS_SMVT) + (size_t)((l * BS + sb) * 4 + h) * 128 * 256, lds, tid);
        __syncthreads();
        if (wave == 0) { const int ql = lane & 31; const bool ok = ql < TS; memattn_wave(QM, OM, MP + TS * sb + (ok ? ql : TS - 1), ok, h, lds, lane); }
    }
    const int NU = BP * 4 * 16, per = (NU + G - 1) / G;
    int cur = -1;
    for (int u = blockIdx.x * per; u < NU && u < (blockIdx.x + 1) * per; ++u) {
        const int qt = u & 15, bh = u >> 4, b = bh >> 2, h = bh & 3;
        if (bh != cur) {
            __syncthreads();
            memattn_load_kv((const bf16_t*)(A.ws + WS_MK) + (size_t)((l * BP + b) * 4 + h) * 256 * 128, (const bf16_t*)(A.ws + WS_MVT) + (size_t)((l * BP + b) * 4 + h) * 128 * 256, lds, tid);
            __syncthreads();
            cur = bh;
        }
        memattn_wave(QM, OM, b * TP + 256 * qt + 32 * wave + (lane & 31), true, h, lds, lane);
    }
    __syncthreads();
}

DI void act_task(const Args& A, int l, int task) {
    const int cgi = task % 352, seg = task / 352, r0 = 16 * seg, c0 = 8 * cgi;
    const bf16_t* GU = (const bf16_t*)(A.ws + WS_GU); bf16_t* ACT = (bf16_t*)(A.ws + WS_ACT);
    const bool smp = r0 >= MP; const int t0 = smp ? 0 : (r0 & (TP - 1)), T = smp ? TS : TP, bb = smp ? (r0 - MP) / TS : r0 / TP;
    float w0[8], w1[8], w2[8], p2[8], p1[8];
    const float* cw = A.in[I_FCW] + (size_t)l * 3 * DFF + c0;
#pragma unroll
    for (int j = 0; j < 8; ++j) { w0[j] = cw[j]; w1[j] = cw[DFF + j]; w2[j] = cw[2 * DFF + j]; }
    if (t0 == 0) {
        if (smp) { const float* cp = A.in[I_CFC] + (size_t)(l * BS + bb) * 2 * DFF + c0;
#pragma unroll
            for (int j = 0; j < 8; ++j) { p2[j] = cp[j]; p1[j] = cp[DFF + j]; } }
        else {
#pragma unroll
            for (int j = 0; j < 8; ++j) { p2[j] = 0.f; p1[j] = 0.f; } }
    } else { unpk8(*(const u32x4*)(GU + (size_t)(r0 - 2) * NGU + c0), p2); unpk8(*(const u32x4*)(GU + (size_t)(r0 - 1) * NGU + c0), p1); }
#pragma unroll 4
    for (int i = 0; i < 16; ++i) {
        const bf16_t* gr = GU + (size_t)(r0 + i) * NGU + c0;
        float g[8], up[8], y[8];
        unpk8(*(const u32x4*)gr, g); unpk8(*(const u32x4*)(gr + DFF), up);
#pragma unroll
        for (int j = 0; j < 8; ++j) { const float gt = w0[j] * p2[j] + w1[j] * p1[j] + w2[j] * g[j]; p2[j] = p1[j]; p1[j] = g[j]; y[j] = siluf_(gt) * up[j]; }
        *(u32x4*)(ACT + (size_t)(r0 + i) * DFF + c0) = pk8(y);
    }
    if (t0 + 16 == T) {
        float* dst = smp ? A.out + O_SFC + (size_t)(l * BS + bb) * 2 * DFF + c0 : A.out + O_PFC + (size_t)(l * BP + bb) * 2 * DFF + c0;
#pragma unroll
        for (int j = 0; j < 8; ++j) { dst[j] = p2[j]; dst[DFF + j] = p1[j]; }
    }
}
#ifndef MK_ONE_LAUNCH
#define MK_ONE_LAUNCH 1
#endif
constexpr int NPH = 3 + 9 * NL;
#ifndef PHMASK
#define PHMASK 0xFFFF
#endif
#define PHX(k) (((PHMASK) >> (k)) & 1)
#ifndef DUP_KIND
#define DUP_KIND -1
#endif
#define REPS(k) ((DUP_KIND == (k)) ? 2 : 1)
__global__ void __launch_bounds__(NTHR, 2) hse_fwd(Args A) {
    extern __shared__ __attribute__((aligned(16))) unsigned char smem[];
    LAS unsigned char* lds = (LAS unsigned char*)smem;
    volatile LAS unsigned* MISC = (volatile LAS unsigned*)(lds + MISC_OFF);
    const int tid0 = threadIdx.x, G = gridDim.x;
    for (int u = tid0; u < (LDS_BYTES - MISC_OFF) / 4; u += NTHR) ((LAS unsigned*)(lds + MISC_OFF))[u] = 0u;
    __syncthreads();
    unsigned* ctl = (unsigned*)(A.ws + WS_CTL);
    XcdBarrier bar; bar.bar = ctl + CW_BAR; bar.x = 0; bar.st = nullptr;
    const int lo = A.ph_lo, hi = A.ph_hi;
    if (hi - lo > 1) bar = xcd_barrier_post(ctl + CW_BAR, MISC + 8);
#define IN(k) (lo <= (k) && (k) < hi)
#define SEAM(k) do { if (IN(k) && IN((k) + 1)) xcd_barrier(bar); } while (0)
    unsigned char* ws = A.ws;
    bf16_t* XB = (bf16_t*)(ws + WS_XB); u64_t* SSQ0 = (u64_t*)(ws + WS_SSQ);

    if (PHX(0) && IN(0)) { for (int rep = 0; rep < REPS(0); ++rep) { phase_convert(A, lds); __syncthreads(); } }
    SEAM(0);
    if (PHX(1) && IN(1)) { for (int rep = 0; rep < REPS(1); ++rep) {
        pg8::Gemm g{(const bf16_t*)(ws + WS_MEMB), (const bf16_t*)(ws + WS_WMKV), 4096, 4096, DM}; pg8::StaticOrder S; S.init(4096, 4096, ogrid(), obid());
        EpiScaleF32 E{(float*)(ws + WS_RAWKV), 4096, (const float*)(ws + WS_SSQM)};
        pg8::gemm_phase<EpiScaleF32, pg8::StaticOrder, true, true>(lds, g, S, E);
        __syncthreads(); } }
    SEAM(1);
    if (PHX(2) && IN(2)) { for (int rep = 0; rep < REPS(2); ++rep) { phase_memkv_post(A, lds); __syncthreads(); } }
    SEAM(2);

    for (int l = 0; l < NL; ++l) {
        const int pb = 3 + 9 * l;
        u64_t* SSQ = SSQ0 + (size_t)(3 * l) * MALL;
        if (PHX(3) && IN(pb + 0)) { for (int rep = 0; rep < REPS(3); ++rep) {
            pg8::Gemm g{XB, (const bf16_t*)(ws + WS_WIN + l * SZ_WIN), MALL, NZ, DM}; pg8::StaticOrder S; S.init(MALL, NZ, ogrid(), obid());
            EpiScaleBf16 E{(bf16_t*)(ws + WS_Z), NZ, SSQ, 12, 13, A.out + O_PSK + (size_t)l * MP * 256, A.out + O_SSK + (size_t)l * MS * 256, A.out + O_PSV + (size_t)l * MP * 256, A.out + O_SSV + (size_t)l * MS * 256};
            pg8::gemm_phase<EpiScaleBf16, pg8::StaticOrder, true, true>(lds, g, S, E);
            __syncthreads(); } }
        SEAM(pb + 0);
        if (PHX(4) && IN(pb + 1)) { for (int rep = 0; rep < REPS(4); ++rep) {
            unsigned* cnt = ctl + 2048 + 64 * l;
            for (;;) {
                if (threadIdx.x == 0) MISC[12] = atomicAdd(cnt, 1u);
                __syncthreads();
                const int u = (int)MISC[12];
                __syncthreads();
                if (u >= 1024) break;
                prep_unit(A, lds, l, u);
            }
            __syncthreads(); } }
        SEAM(pb + 1);
        if (PHX(5) && IN(pb + 2)) { for (int rep = 0; rep < REPS(5); ++rep) {
            for (int r2 = 0; r2 < REPS(14); ++r2) for (int it = blockIdx.x; it < 64 + BS; it += G) {
                if (it < 64) scan_item(A, lds, l, it);
                else { prep_unit(A, lds, l, 1024 + (it - 64)); __threadfence_block(); VM_WAIT(); __syncthreads();
                       for (int hh = 0; hh < 4; ++hh) scan_item(A, lds, l, 64 + 4 * (it - 64) + hh); }
            }
            const int nhead = G > 128 ? 64 : 0;
            if ((int)blockIdx.x >= nhead) {
                const int tid = otid(), lane = tid & 63, wave = __builtin_amdgcn_readfirstlane(tid >> 6);
                const int wb = blockIdx.x - nhead, NWB = G - nhead;
                for (int r2 = 0; r2 < REPS(13); ++r2) {
                for (int i = wb * NWAVES + wave; i < BS * 4; i += NWB * NWAVES) sb_wave_unit<true>(A, l, i, lane);
                for (int i = wb * NWAVES + wave; i < BP * 128 * 4; i += NWB * NWAVES) sb_wave_unit<false>(A, l, i, lane);
                for (int t = wb * NTHR + tid; t < (MALL / 16) * 32; t += NWB * NTHR) sc_task(A, l, t);
                }
            }
            __syncthreads(); } }
        SEAM(pb + 2);
        if (PHX(6) && IN(pb + 3)) { for (int rep = 0; rep < REPS(6); ++rep) {
            pg8::Gemm g{(const bf16_t*)(ws + WS_Y), (const bf16_t*)(ws + WS_WMIX + l * SZ_WMIX), MALL, DM, DM}; pg8::StaticOrder S; S.init(MALL, DM, ogrid(), obid());
            EpiResid E{A.out, XB, SSQ + MALL, 0};
            pg8::gemm_phase<EpiResid, pg8::StaticOrder, true, true>(lds, g, S, E);
            __syncthreads(); } }
        SEAM(pb + 3);
        if (PHX(7) && IN(pb + 4)) { for (int rep = 0; rep < REPS(7); ++rep) {
            pg8::Gemm g{XB, (const bf16_t*)(ws + WS_WMQ + l * SZ_WMQ), MALL, 512, DM}; pg8::StaticOrder S; S.init(MALL, 512, ogrid(), obid());
            EpiScaleBf16 E{(bf16_t*)(ws + WS_QM), 512, SSQ + MALL, -1, -1, nullptr, nullptr, nullptr, nullptr};
            pg8::gemm_phase<EpiScaleBf16, pg8::StaticOrder, true, true>(lds, g, S, E);
            __syncthreads(); } }
        SEAM(pb + 4);
        if (PHX(8) && IN(pb + 5)) { for (int rep = 0; rep < REPS(8); ++rep) { phase_memattn(A, lds, l); __syncthreads(); } }
        SEAM(pb + 5);
        if (PHX(9) && IN(pb + 6)) { for (int rep = 0; rep < REPS(9); ++rep) {
            pg8::Gemm g{(const bf16_t*)(ws + WS_OM), (const bf16_t*)(ws + WS_WMO + l * SZ_WMO), MALL, DM, 512}; pg8::StaticOrder S; S.init(MALL, DM, ogrid(), obid());
            EpiResid E{A.out, XB, SSQ + 2 * MALL, 0};
            pg8::gemm_phase<EpiResid, pg8::StaticOrder, true, true>(lds, g, S, E);
            __syncthreads(); } }
        SEAM(pb + 6);
        if (PHX(10) && IN(pb + 7)) {
            pg8::Gemm g{XB, (const bf16_t*)(ws + WS_WGU + l * SZ_WGU), MALL, NGU, DM}; pg8::StaticOrder S; S.init_tiles((MALL + 247) / 248, NGU / 256, ogrid(), obid());
            EpiAct E{(bf16_t*)(ws + WS_ACT), SSQ + 2 * MALL, A.in[I_FCW] + (size_t)l * 3 * DFF, A.in[I_CFC] + (size_t)l * BS * 2 * DFF, A.out + O_PFC + (size_t)l * BP * 2 * DFF, A.out + O_SFC + (size_t)l * BS * 2 * DFF};
            pg8::gemm_phase<EpiAct, pg8::StaticOrder, true, true>(lds, g, S, E);
        }
        SEAM(pb + 7);
        if (PHX(12) && IN(pb + 8)) { for (int rep = 0; rep < REPS(12); ++rep) {
            pg8::Gemm g{(const bf16_t*)(ws + WS_ACT), (const bf16_t*)(ws + WS_WDN + l * SZ_WDN), MALL, DM, DFF}; pg8::StaticOrder S; S.init(MALL, DM, ogrid(), obid());
            EpiResid E{A.out, XB, SSQ + 3 * (size_t)MALL, l == NL - 1 ? 1 : 0};
            pg8::gemm_phase<EpiResid, pg8::StaticOrder, true, true>(lds, g, S, E);
            __syncthreads(); } }
        if (l + 1 < NL) SEAM(pb + 8);
    }
#undef IN
#undef SEAM
}

extern "C" void kernel_launch(void* const* d_in, const int* in_sizes, int n_in, void* d_out, int out_size, void* d_ws, size_t ws_size, hipStream_t stream) {
    static int grid = 0;
    if (grid == 0) {
        if (n_in != 34 || (size_t)out_size != O_END || ws_size < WS_END) { fprintf(stderr, "kernel_launch: unexpected problem (n_in %d, out %d, ws %zu; need 34, %zu, >= %zu); nothing launched\n", n_in, out_size, ws_size, (size_t)O_END, (size_t)WS_END); grid = -1; return; }
        int dev = 0, cus = 0, per_cu = 0;
        if (hipGetDevice(&dev) != hipSuccess || hipDeviceGetAttribute(&cus, hipDeviceAttributeMultiprocessorCount, dev) != hipSuccess) { grid = -1; return; }
        if (hipFuncSetAttribute((const void*)hse_fwd, hipFuncAttributeMaxDynamicSharedMemorySize, LDS_BYTES) != hipSuccess) { fprintf(stderr, "kernel_launch: hipFuncSetAttribute failed\n"); grid = -1; return; }
        if (hipOccupancyMaxActiveBlocksPerMultiprocessor(&per_cu, (const void*)hse_fwd, NTHR, LDS_BYTES) != hipSuccess || per_cu < 1) { fprintf(stderr, "kernel_launch: occupancy query reports %d blocks per CU\n", per_cu); }
        (void)hipGetLastError();
        grid = cus;
    }
    if (grid < 0) return;
    (void)hipMemsetAsync((char*)d_ws + WS_CTL, 0, CTL_BYTES, stream);
    (void)hipMemsetAsync((char*)d_ws + WS_SSQ, 0, (size_t)(3 * NL + 1) * MALL * 8, stream);
    Args a{};
    for (int i = 0; i < 34; ++i) a.in[i] = (const float*)d_in[i];
    a.out = (float*)d_out; a.ws = (unsigned char*)d_ws;
#if MK_ONE_LAUNCH
    a.ph_lo = 0; a.ph_hi = NPH;
    hipLaunchKernelGGL(hse_fwd, dim3(grid), dim3(NTHR), LDS_BYTES, stream, a);
#else
    for (int p = 0; p < NPH; ++p) { a.ph_lo = p; a.ph_hi = p + 1; hipLaunchKernelGGL(hse_fwd, dim3(grid), dim3(NTHR), LDS_BYTES, stream, a); }
#endif
    const hipError_t le = hipPeekAtLastError();
    if (le != hipSuccess) fprintf(stderr, "kernel_launch: launch failed: %s\n", hipGetErrorName(le));
}
```

```cpp
#include <hip/hip_runtime.h>
#include <cstdio>
#include <cstdint>

#define DI __device__ __forceinline__
#define GAS __attribute__((address_space(1)))
#define LAS __attribute__((address_space(3)))

typedef unsigned short bf16_t;
typedef short bf16x8 __attribute__((ext_vector_type(8)));
typedef short bf16x4 __attribute__((ext_vector_type(4)));
typedef float f32x4 __attribute__((ext_vector_type(4)));
typedef float f32x2 __attribute__((ext_vector_type(2)));
typedef float f32x16 __attribute__((ext_vector_type(16)));
typedef unsigned u32x4 __attribute__((ext_vector_type(4)));
typedef unsigned u32x2 __attribute__((ext_vector_type(2)));
typedef __bf16 bf16x2_t __attribute__((ext_vector_type(2)));

constexpr int DM = 1024, BP = 16, TP = 4096, NL = 4, BS = 32, TS = 16, PAST = 4096, NMEM = 256;
constexpr int MP = BP * TP, MS = BS * TS, MALL = MP + MS;
constexpr int NZ = 3584;
constexpr int ZQ = 0, ZK = 512, ZV = 1024, ZG = 1536, ZSB = 2048, ZSC = 2304, ZSX = 2560, ZCQ = 2816, ZCK = 3072, ZCV = 3328;
constexpr int DFF = 2816, NGU = 2 * DFF;
constexpr int DIN = 3592;
constexpr float EPS = 1e-6f;
constexpr int NCH = BP * 64 * 4 + BS * 4;
constexpr int PCH = 36864;
constexpr int PW = 0, PQE = 8192, PUT = 16384, PKDT = 24576, PQK = 32768;

constexpr size_t O_YP = 0, O_YS = O_YP + (size_t)MP * DM, O_PGS = O_YS + (size_t)MS * DM, O_PGC = O_PGS + (size_t)NL * BP * 4 * 128 * 128,
    O_PSC = O_PGC + (size_t)NL * BP * 3 * 1536, O_PSK = O_PSC + (size_t)NL * BP * 2 * 256, O_PSV = O_PSK + (size_t)NL * MP * 256, O_PMK = O_PSV + (size_t)NL * MP * 256,
    O_PMV = O_PMK + (size_t)NL * BP * NMEM * 512, O_PFC = O_PMV + (size_t)NL * BP * NMEM * 512, O_SGS = O_PFC + (size_t)NL * BP * 2 * DFF,
    O_SGC = O_SGS + (size_t)NL * BS * 4 * 128 * 128, O_SSC = O_SGC + (size_t)NL * BS * 3 * 1536, O_SSK = O_SSC + (size_t)NL * BS * 2 * 256,
    O_SSV = O_SSK + (size_t)NL * MS * 256, O_SFC = O_SSV + (size_t)NL * MS * 256, O_END = O_SFC + (size_t)NL * BS * 2 * DFF;
static_assert(O_END == 234323968ull, "output size");

constexpr size_t al256(size_t x) { return (x + 255) & ~(size_t)255; }
constexpr size_t WS_CTL = 0, CTL_BYTES = 1u << 20;
constexpr size_t SZ_WIN = (size_t)NZ * DM * 2, SZ_WG8 = 16 * DM * 2, SZ_WMIX = (size_t)DM * DM * 2, SZ_WMQ = 512 * DM * 2, SZ_WMO = (size_t)DM * 512 * 2,
    SZ_WGU = (size_t)NGU * DM * 2, SZ_WDN = (size_t)DM * DFF * 2;
constexpr size_t WS_WIN = WS_CTL + CTL_BYTES, WS_WG8 = WS_WIN + NL * SZ_WIN, WS_WMIX = WS_WG8 + NL * SZ_WG8, WS_WMQ = WS_WMIX + NL * SZ_WMIX, WS_WMO = WS_WMQ + NL * SZ_WMQ,
    WS_WGU = WS_WMO + NL * SZ_WMO, WS_WDN = WS_WGU + NL * SZ_WGU, WS_WMKV = WS_WDN + NL * SZ_WDN;
constexpr size_t WS_XB = WS_WMKV + (size_t)4096 * DM * 2;
constexpr size_t WS_SSQ = WS_XB + (size_t)(MALL + 256) * DM * 2;
constexpr size_t WS_MEMB = WS_SSQ + (size_t)MALL * 16 * 8;
constexpr size_t WS_SSQM = WS_MEMB + (size_t)4096 * DM * 2;
constexpr size_t WS_RAWKV = WS_SSQM + 4096 * 4;
constexpr size_t WS_MK = WS_RAWKV + (size_t)4096 * 4096 * 4;
constexpr size_t WS_MVT = WS_MK + (size_t)NL * BP * 4 * 256 * 128 * 2;
constexpr size_t WS_SMK = WS_MVT + (size_t)NL * BP * 4 * 256 * 128 * 2;
constexpr size_t WS_SMVT = WS_SMK + (size_t)NL * BS * 4 * 256 * 128 * 2;
constexpr size_t WS_Z = WS_SMVT + (size_t)NL * BS * 4 * 256 * 128 * 2;
constexpr size_t WS_PREP = WS_Z + (size_t)MALL * NZ * 2;
constexpr size_t WS_GU = WS_Z;
constexpr size_t WS_EG = WS_PREP + (size_t)NCH * PCH * 2;
constexpr size_t WS_Y = al256(WS_EG + (size_t)NCH * 4);
constexpr size_t WS_QM = WS_Y + (size_t)MALL * DM * 2;
constexpr size_t WS_OM = WS_QM + (size_t)MALL * 512 * 2;
constexpr size_t WS_ACT = WS_OM + (size_t)MALL * 512 * 2;
constexpr size_t WS_END = WS_ACT + (size_t)MALL * DFF * 2;
static_assert(WS_GU + (size_t)MALL * NGU * 2 <= WS_EG, "GU overlay fits in Z | PREP");
static_assert(WS_END <= 2147483648ull, "workspace map exceeds the guaranteed 2 GiB");

constexpr int LDS_BYTES = 147456;
constexpr int MISC_OFF = 139264;
constexpr int NWAVES = 8, NTHR = 512;

DI unsigned pk2(float lo, float hi) { f32x2 v = {lo, hi}; bf16x2_t b = __builtin_convertvector(v, bf16x2_t); return __builtin_bit_cast(unsigned, b); }
DI float bflo(unsigned u) { return __uint_as_float(u << 16); }
DI float bfhi(unsigned u) { return __uint_as_float(u & 0xffff0000u); }
DI float bf2f(bf16_t u) { return __uint_as_float((unsigned)u << 16); }
DI bf16_t f2bf(float f) { return (bf16_t)(pk2(f, 0.f) & 0xffffu); }
DI u32x4 pk8(const float* v) { u32x4 r; r.x = pk2(v[0], v[1]); r.y = pk2(v[2], v[3]); r.z = pk2(v[4], v[5]); r.w = pk2(v[6], v[7]); return r; }
DI void unpk8(u32x4 r, float* v) { v[0] = bflo(r.x); v[1] = bfhi(r.x); v[2] = bflo(r.y); v[3] = bfhi(r.y); v[4] = bflo(r.z); v[5] = bfhi(r.z); v[6] = bflo(r.w); v[7] = bfhi(r.w); }
DI u32x2 pk4(f32x4 v) { u32x2 r; r.x = pk2(v[0], v[1]); r.y = pk2(v[2], v[3]); return r; }
DI f32x4 unpk4(u32x2 r) { f32x4 v; v[0] = bflo(r.x); v[1] = bfhi(r.x); v[2] = bflo(r.y); v[3] = bfhi(r.y); return v; }
DI float wave_sum(float v) {
#pragma unroll
    for (int o = 1; o < 64; o <<= 1) v += __shfl_xor(v, o);
    return v;
}
DI float fexp(float x) { return __builtin_amdgcn_exp2f(x * 1.4426950408889634f); }
DI float flog(float x) { return __builtin_amdgcn_logf(x) * 0.6931471805599453f; }
DI float sigmoidf_(float x) { return __builtin_amdgcn_rcpf(1.0f + __builtin_amdgcn_exp2f(-1.4426950408889634f * x)); }
DI float siluf_(float x) { return x * __builtin_amdgcn_rcpf(1.0f + __builtin_amdgcn_exp2f(-1.4426950408889634f * x)); }
DI float softplusf_(float x) { return fmaxf(x, 0.f) + log1pf(__expf(-fabsf(x))); }
#define MFMA16(a, b, c) __builtin_amdgcn_mfma_f32_16x16x32_bf16((a), (b), (c), 0, 0, 0)
#define MFMA16K16(a, b, c) __builtin_amdgcn_mfma_f32_16x16x16bf16_1k((a), (b), (c), 0, 0, 0)
#define MFMA32(a, b, c) __builtin_amdgcn_mfma_f32_32x32x16_bf16((a), (b), (c), 0, 0, 0)
#define LDS_WAIT() asm volatile("s_waitcnt lgkmcnt(0)" ::: "memory")
#define VM_WAIT() asm volatile("s_waitcnt vmcnt(0)" ::: "memory")
DI int otid() { int t = threadIdx.x; asm volatile("" : "+v"(t)); return t; }
DI int obid() { int b = blockIdx.x; asm volatile("" : "+s"(b)); return b; }
DI int ogrid() { int g = gridDim.x; asm volatile("" : "+s"(g)); return g; }
#define LBAR() do { asm volatile("s_waitcnt lgkmcnt(0)" ::: "memory"); __builtin_amdgcn_s_barrier(); asm volatile("" ::: "memory"); } while (0)
#define MK_ONE_LAUNCH 1
namespace pg8 {
#define PG8_LAS __attribute__((address_space(3)))
constexpr int BM = 256, BK = 64, HALF = 128, HTB = HALF * BK * 2  , STAGE_BYTES = 8 * HTB, NXCD = 8, WGM = 4;
__host__ __device__ __forceinline__ int lds_byte(int r, int c) { const int st = (r >> 4) * 2 + (c >> 5), rr = r & 15, cc = c & 31, ob = rr * 64 + cc * 2; return st * 1024 + (ob ^ (((ob >> 9) & 1) << 5)); }
__host__ __device__ __forceinline__ void stage_rc(int b, int& R, int& C) { const int st = b / 1024, sb = b % 1024, swz = sb ^ (((sb >> 9) & 1) << 5); R = (st >> 1) * 16 + swz / 64; C = (st & 1) * 32 + (swz % 64) / 2; }
__host__ __device__ __forceinline__ int perm32(int rho) { const int n = rho >> 4, i = rho & 15; return 8 * (i >> 2) + 4 * n + (i & 3); }

struct Unit { int pm, pn; };
struct Gemm { const bf16_t* A; const bf16_t* Bt; int M, N, K; };

struct StaticOrder {
    int nM, nN, nwg, G, c;
    __host__ __device__ void init(int M, int N, int G_, int c_) { nM = M / BM; nN = N / BM; nwg = nM * nN; G = G_; c = c_; }
    __host__ __device__ void init_tiles(int nM_, int nN_, int G_, int c_) { nM = nM_; nN = nN_; nwg = nM * nN; G = G_; c = c_; }
    __host__ __device__ bool next(int i, Unit& u) const {
        const long L = (long)i * G + c; if (L >= nwg) return false;
        int wgid = (int)L; { const int q = nwg / NXCD, r = nwg % NXCD, xcd = wgid % NXCD, off = wgid / NXCD; wgid = (xcd < r ? xcd * (q + 1) : r * (q + 1) + (xcd - r) * q) + off; }
        const int nig = WGM * nN, gid = wgid / nig, fm = gid * WGM, gsz = (nM - fm) < WGM ? (nM - fm) : WGM;
        u.pm = fm + ((wgid % nig) % gsz); u.pn = (wgid % nig) / gsz; return true;
    }
    __device__ __forceinline__ void a_ready(const Unit&) const {}
    __device__ __forceinline__ void done(const Unit&) const {}
};
template <class Epi, class Sched, bool ALIGN_EPI = false, bool SP2 = false>
__device__ __forceinline__ void gemm_phase(PG8_LAS unsigned char* lds, const Gemm g, const Sched& S, const Epi& E) {
    const int tid = otid(), wid = __builtin_amdgcn_readfirstlane(tid >> 6), lane = tid & 63, wr = wid >> 2, wc = wid & 3, fr = lane & 15, fq = lane >> 4;
    const int K = g.K, nt = K / BK;
    int voffA[2], voffB[2];
#pragma unroll
    for (int i = 0; i < 2; ++i) { int R, C; stage_rc(tid * 16 + i * 8192, R, C); const int Rb = Epi::PERM ? ((R & ~31) + perm32(R & 31)) : R;
        const int Ra = Epi::ROWMAP ? (62 * (R >> 6) - 2 + (R & 63)) : R;
        voffA[i] = (Ra * K + C) * 2; voffB[i] = (Rb * K + C) * 2; }
    const size_t kstep = (size_t)(BK * 2);
    const size_t hstep = (size_t)HALF * K * 2;
    const size_t tstep = 2 * hstep;
    const size_t hstepA = Epi::ROWMAP ? (size_t)124 * K * 2 : hstep, tstepA = 2 * hstepA;
    const unsigned ldsw = (unsigned)wid * 1024u;
    const int aoff = lds_byte(wr * 64 + fr, fq * 8), boff = lds_byte(wc * 32 + fr, fq * 8);
#define PG8_SA(b, h) (((b) * 2 + (h)) * HTB)
#define PG8_SB(b, h) ((4 + (b) * 2 + (h)) * HTB)
#define PG8_STAGE(bufoff, gbase, voff) do { _Pragma("unroll") for (int _i = 0; _i < 2; ++_i) \
        __builtin_amdgcn_global_load_lds((const unsigned*)((const char*)(gbase) + (voff)[_i]), (PG8_LAS unsigned*)(lds + (bufoff) + ldsw + _i * 8192), 16, 0, 0); } while (0)
#define PG8_LDA(dst, b, h) do { _Pragma("unroll") for (int m = 0; m < 4; ++m) _Pragma("unroll") for (int k = 0; k < 2; ++k) dst[m][k] = *(const PG8_LAS bf16x8*)(lds + PG8_SA(b, h) + aoff + m * 2048 + k * 1024); } while (0)
#define PG8_LDB(dst, b, h) do { _Pragma("unroll") for (int n = 0; n < 2; ++n) _Pragma("unroll") for (int k = 0; k < 2; ++k) dst[n][k] = *(const PG8_LAS bf16x8*)(lds + PG8_SB(b, h) + boff + n * 2048 + k * 1024); } while (0)
#define PG8_MMA(ai, bj, At, Bt) do { __builtin_amdgcn_s_setprio(1); _Pragma("unroll") for (int m = 0; m < 4; ++m) _Pragma("unroll") for (int n = 0; n < 2; ++n) _Pragma("unroll") for (int k = 0; k < 2; ++k) \
        acc[ai][bj][m][n] = __builtin_amdgcn_mfma_f32_16x16x32_bf16(Bt[n][k], At[m][k], acc[ai][bj][m][n], 0, 0, 0); __builtin_amdgcn_s_setprio(0); } while (0)
#define PG8_WAIT_V(n) asm volatile("s_waitcnt vmcnt(" #n ")" ::: "memory")
#define PG8_WAIT_L(n) asm volatile("s_waitcnt lgkmcnt(" #n ")" ::: "memory")
#define PG8_BAR __builtin_amdgcn_s_barrier()
#define PG8_SCHED __builtin_amdgcn_sched_barrier(0)
    Unit cur, nxt; int ui = 0;
    if (!S.next(0, cur)) return;
    f32x4 acc[2][2][4][2];
#pragma unroll
    for (int a = 0; a < 2; ++a)
#pragma unroll
        for (int b = 0; b < 2; ++b)
#pragma unroll
            for (int m = 0; m < 4; ++m)
#pragma unroll
                for (int n = 0; n < 2; ++n) acc[a][b][m][n] = (f32x4){0.f, 0.f, 0.f, 0.f};
    bf16x8 At[4][2], B0[2][2], B1[2][2];
    const char* cA = (const char*)g.A + (size_t)cur.pm * tstepA; const char* cB = (const char*)g.Bt + (size_t)cur.pn * tstep;
    S.a_ready(cur);
    PG8_LAS float* RS = (PG8_LAS float*)(lds + MISC_OFF + 1024);
    u32x2 raw0 = {0u, 0u}; if constexpr (Epi::STAGE) raw0 = E.st_issue(cur, tid);
    if constexpr (SP2) {
        PG8_STAGE(PG8_SB(0, 0), cB, voffB); PG8_STAGE(PG8_SB(0, 1), cB + hstep, voffB); PG8_STAGE(PG8_SA(0, 0), cA, voffA); PG8_STAGE(PG8_SA(0, 1), cA + hstepA, voffA);
        if (wr == 1) PG8_BAR;
        PG8_WAIT_V(2); PG8_BAR;
        PG8_STAGE(PG8_SB(1, 0), cB + kstep, voffB); PG8_STAGE(PG8_SA(1, 0), cA + kstep, voffA); PG8_STAGE(PG8_SB(1, 1), cB + hstep + kstep, voffB);
        PG8_WAIT_V(6); PG8_BAR;
    } else {
        PG8_STAGE(PG8_SB(0, 0), cB, voffB); PG8_STAGE(PG8_SA(0, 0), cA, voffA); PG8_STAGE(PG8_SB(0, 1), cB + hstep, voffB); PG8_STAGE(PG8_SA(0, 1), cA + hstepA, voffA);
        if (wr == 1) PG8_BAR;
        PG8_WAIT_V(4); PG8_BAR;
        PG8_STAGE(PG8_SB(1, 0), cB + kstep, voffB); PG8_STAGE(PG8_SA(1, 0), cA + kstep, voffA); PG8_STAGE(PG8_SB(1, 1), cB + hstep + kstep, voffB);
        PG8_WAIT_V(6); PG8_BAR;
    }
    if constexpr (Epi::STAGE) E.st_commit(raw0, cur, RS, tid);
    for (;;) {
        const bool has_next = S.next(ui + 1, nxt);
        const char* nA = has_next ? (const char*)g.A + (size_t)nxt.pm * tstepA : cA; const char* nB = has_next ? (const char*)g.Bt + (size_t)nxt.pn * tstep : cB;
        for (int t = 0; t < nt; t += 2) {
            const bool last = (t == nt - 2);
            const char* a1 = cA + (size_t)(t + 1) * kstep;
            const char* a2 = last ? nA : cA + (size_t)(t + 2) * kstep; const char* b2 = last ? nB : cB + (size_t)(t + 2) * kstep;
            const char* a3 = a2 + kstep; const char* b3 = b2 + kstep;
            if (last && has_next) S.a_ready(nxt);
            if constexpr (SP2) {
            PG8_LDB(B0, 0, 0); PG8_LDB(B1, 0, 1); PG8_SCHED; PG8_LDA(At, 0, 0); PG8_STAGE(PG8_SA(1, 1), a1 + hstepA, voffA);
            PG8_WAIT_V(8); PG8_WAIT_L(0); PG8_BAR; PG8_MMA(0, 0, At, B0); PG8_MMA(0, 1, At, B1); PG8_BAR; PG8_SCHED;
            PG8_LDA(At, 0, 1); PG8_STAGE(PG8_SB(0, 0), b2, voffB); PG8_STAGE(PG8_SB(0, 1), b2 + hstep, voffB); PG8_STAGE(PG8_SA(0, 0), a2, voffA);
            PG8_WAIT_V(8); PG8_WAIT_L(0); PG8_BAR; PG8_MMA(1, 0, At, B0); PG8_MMA(1, 1, At, B1); PG8_BAR; PG8_SCHED;
            PG8_LDB(B0, 1, 0); PG8_LDB(B1, 1, 1); PG8_SCHED; PG8_LDA(At, 1, 0); PG8_STAGE(PG8_SA(0, 1), a2 + hstepA, voffA);
            PG8_WAIT_V(8); PG8_WAIT_L(0); PG8_BAR; PG8_MMA(0, 0, At, B0); PG8_MMA(0, 1, At, B1); PG8_BAR; PG8_SCHED;
            PG8_LDA(At, 1, 1); PG8_STAGE(PG8_SB(1, 0), b3, voffB); PG8_STAGE(PG8_SB(1, 1), b3 + hstep, voffB); PG8_STAGE(PG8_SA(1, 0), a3, voffA);
            PG8_WAIT_V(8); PG8_WAIT_L(0); PG8_BAR; PG8_MMA(1, 0, At, B0); PG8_MMA(1, 1, At, B1); PG8_BAR; PG8_SCHED;
            } else {
            PG8_LDB(B0, 0, 0); PG8_SCHED; PG8_LDA(At, 0, 0); PG8_STAGE(PG8_SA(1, 1), a1 + hstepA, voffA);
            PG8_WAIT_L(8); PG8_BAR; PG8_WAIT_L(0); PG8_MMA(0, 0, At, B0); PG8_BAR; PG8_SCHED;
            PG8_LDB(B1, 0, 1); PG8_STAGE(PG8_SB(0, 0), b2, voffB);
            PG8_BAR; PG8_WAIT_L(0); PG8_MMA(0, 1, At, B1); PG8_BAR;
            PG8_LDA(At, 0, 1); PG8_STAGE(PG8_SA(0, 0), a2, voffA);
            PG8_BAR; PG8_WAIT_L(0); PG8_MMA(1, 0, At, B0); PG8_BAR; PG8_SCHED;
            PG8_STAGE(PG8_SB(0, 1), b2 + hstep, voffB);
            PG8_WAIT_V(6); PG8_BAR; PG8_MMA(1, 1, At, B1); PG8_BAR;
            PG8_LDB(B0, 1, 0); PG8_SCHED; PG8_LDA(At, 1, 0); PG8_STAGE(PG8_SA(0, 1), a2 + hstepA, voffA);
            PG8_WAIT_L(8); PG8_BAR; PG8_WAIT_L(0); PG8_MMA(0, 0, At, B0); PG8_BAR; PG8_SCHED;
            PG8_LDB(B1, 1, 1); PG8_STAGE(PG8_SB(1, 0), b3, voffB);
            PG8_BAR; PG8_WAIT_L(0); PG8_MMA(0, 1, At, B1); PG8_BAR;
            PG8_LDA(At, 1, 1); PG8_STAGE(PG8_SA(1, 0), a3, voffA);
            PG8_BAR; PG8_WAIT_L(0); PG8_MMA(1, 0, At, B0); PG8_BAR; PG8_SCHED;
            PG8_STAGE(PG8_SB(1, 1), b3 + hstep, voffB);
            PG8_WAIT_V(6); PG8_BAR; PG8_MMA(1, 1, At, B1); PG8_BAR;
            }
        }
        if constexpr (ALIGN_EPI) { if (wr == 0) PG8_BAR; }
        if constexpr (!Epi::AFTER_DRAIN) {
            if constexpr (Epi::STAGE) {
                const Unit& nu = has_next ? nxt : cur; const u32x2 raw = E.st_issue(nu, tid);
                E(acc, cur, wr, wc, fr, fq, RS + (ui & 1) * 640);
                E.st_commit(raw, nu, RS + ((ui + 1) & 1) * 640, tid);
            } else E(acc, cur, wr, wc, fr, fq);
            S.done(cur); }
        if (!has_next) break;
#pragma unroll
        for (int a = 0; a < 2; ++a)
#pragma unroll
            for (int b = 0; b < 2; ++b)
#pragma unroll
                for (int m = 0; m < 4; ++m)
#pragma unroll
                    for (int n = 0; n < 2; ++n) acc[a][b][m][n] = (f32x4){0.f, 0.f, 0.f, 0.f};
        cur = nxt; cA = nA; cB = nB; ++ui;
        if constexpr (ALIGN_EPI) { if (wr == 1) PG8_BAR; }
    }
    PG8_WAIT_V(0);
    if constexpr (!ALIGN_EPI) { if (wr == 0) PG8_BAR; }
    PG8_BAR;
    if constexpr (Epi::AFTER_DRAIN) { E.fused(acc, cur, wr, wc, fr, fq, lds, wid, lane); S.done(cur); }
#undef PG8_SA
#undef PG8_SB
#undef PG8_STAGE
#undef PG8_LDA
#undef PG8_LDB
#undef PG8_MMA
#undef PG8_WAIT_V
#undef PG8_WAIT_L
#undef PG8_BAR
#undef PG8_SCHED
}
}
#define XB_TMO      128
#define XB_XCNT(j)  (256  + 64 * (j))
#define XB_XSUB(j)  (1280 + 64 * (j))
#define XB_XGEN(j)  (2304 + 64 * (j))
#define XB_TOP      3328
#define XB_TOPGEN   3392
#define XCD_BAR_WORDS 3456
#define XB_SPIN_CAP (1u << 18)

__device__ __forceinline__ unsigned xb_ld(unsigned* p)              { return __hip_atomic_load(p, __ATOMIC_RELAXED, __HIP_MEMORY_SCOPE_AGENT); }
__device__ __forceinline__ unsigned xb_add(unsigned* p, unsigned v) { return __hip_atomic_fetch_add(p, v, __ATOMIC_RELAXED, __HIP_MEMORY_SCOPE_AGENT); }
__device__ __forceinline__ unsigned xb_xcc_id() { return (unsigned)__builtin_amdgcn_s_getreg((3 << 11) | 20) & 0xFu; }
#define XB_SPIN(cond, bar) do { unsigned _sp = 0; while (cond) { __builtin_amdgcn_s_sleep(16); \
    if ((++_sp & 255u) == 0u) { if (xb_ld(&(bar)[XB_TMO])) break; if (_sp > XB_SPIN_CAP) { atomicAdd(&(bar)[XB_TMO], 1u); break; } } } } while (0)

struct XcdBarrier {
    unsigned* bar; unsigned x;
    volatile LAS unsigned* st;
};

__device__ __forceinline__ XcdBarrier xcd_barrier_post(unsigned* bar, volatile LAS unsigned* st) {
    XcdBarrier b; b.bar = bar; b.x = xb_xcc_id(); b.st = st;
    if (threadIdx.x == 0) (void)xb_add(&bar[XB_XCNT(b.x)], 1u);
    return b;
}
__device__ __forceinline__ void xcd_barrier_complete(unsigned* bar, unsigned x, unsigned& nloc, unsigned& nx) {
    const unsigned G = gridDim.x * gridDim.y * gridDim.z;
    unsigned sum, cnt, mine, sp = 0u;
    for (;;) {
        sum = 0u; cnt = 0u; mine = 0u;
#pragma unroll
        for (unsigned j = 0; j < 16; ++j) { const unsigned c = xb_ld(&bar[XB_XCNT(j)]); sum += c; cnt += (c > 0u) ? 1u : 0u; mine = (j == x) ? c : mine; }
        if (sum == G) break;
        __builtin_amdgcn_s_sleep(1);
        if ((++sp & 255u) == 0u) { if (xb_ld(&bar[XB_TMO])) break; if (sp > XB_SPIN_CAP) { atomicAdd(&bar[XB_TMO], 1u); break; } }
    }
    nloc = mine > 0u ? mine : 1u; nx = cnt > 0u ? cnt : 1u;
}

__device__ __forceinline__ void xcd_barrier(const XcdBarrier& b) {
    asm volatile("s_waitcnt vmcnt(0)" ::: "memory");
    __syncthreads();
    if (threadIdx.x == 0) {
        unsigned* bar = b.bar;
        __builtin_amdgcn_s_waitcnt(0);
        unsigned nloc = b.st[0], nx = b.st[1];
        if (nloc == 0u) { xcd_barrier_complete(bar, b.x, nloc, nx); b.st[0] = nloc; b.st[1] = nx; }
        const unsigned old = xb_add(&bar[XB_XSUB(b.x)], 1u);
        const unsigned gen = old / nloc;
        if (old + 1u == (gen + 1u) * nloc) {
            __builtin_amdgcn_fence(__ATOMIC_RELEASE, "agent");
            asm volatile("s_waitcnt vmcnt(0)" ::: "memory");
            const unsigned og = xb_add(&bar[XB_TOP], 1u);
            const unsigned tg = og / nx;
            if (og + 1u == (tg + 1u) * nx) xb_add(&bar[XB_TOPGEN], 1u);
            else XB_SPIN(xb_ld(&bar[XB_TOPGEN]) == tg, bar);
            __builtin_amdgcn_fence(__ATOMIC_ACQUIRE, "agent");
            xb_add(&bar[XB_XGEN(b.x)], 1u);
            asm volatile("s_waitcnt vmcnt(0)" ::: "memory");
        } else {
            XB_SPIN(xb_ld(&bar[XB_XGEN(b.x)]) == gen, bar);
            __builtin_amdgcn_fence(__ATOMIC_ACQUIRE, "agent");
            asm volatile("s_waitcnt vmcnt(0)" ::: "memory");
        }
    }
    __syncthreads();
}
struct Args { const float* in[34]; float* out; unsigned char* ws; int ph_lo, ph_hi; };
enum { I_XP = 0, I_XS, I_MEM, I_STATE, I_CGC, I_CSC, I_CSBK, I_CSBV, I_CMK, I_CMV, I_CFC, I_NMIXG, I_WIN, I_GCW, I_ALOG, I_DTB, I_GNG, I_SCW, I_SCG, I_SBG, I_WMIX,
       I_NMEMG, I_MEMING, I_WMQ, I_WMK, I_WMV, I_MQG, I_MKG, I_WMO, I_NFFNG, I_WGATE, I_WUP, I_FCW, I_WDN };
constexpr int CW_BAR = 4096;

typedef unsigned long long u64_t;
constexpr float SSQ_FIX = 1048576.0f;
DI float ssq_ld(const u64_t* ssq, int row) { return (float)ssq[row] * (1.0f / SSQ_FIX); }
DI float row_rstd(const u64_t* ssq, int row) { return rsqrtf(ssq_ld(ssq, row) * (1.0f / DM) + EPS); }
struct EpiScaleBf16 {
    static constexpr bool PERM = true, AFTER_DRAIN = false, ROWMAP = false, STAGE = true;
    bf16_t* O; int ldc; const u64_t* ssq; int tk, tv; float* fkp; float* fks; float* fvp; float* fvs;
    DI u32x2 st_issue(const pg8::Unit& n, int tid) const { return *(const u32x2*)(ssq + n.pm * 256 + (tid & 255)); }
    DI void st_commit(u32x2 raw, const pg8::Unit&, LAS float* RSn, int tid) const {
        const u64_t v = ((u64_t)raw.y << 32) | raw.x; if (tid < 256) RSn[tid] = rsqrtf((float)v * (1.0f / (SSQ_FIX * DM)) + EPS); }
    DI void operator()(const f32x4 (&acc)[2][2][4][2], const pg8::Unit& u, int wr, int wc, int fr, int fq, const LAS float* RS) const {
        const int row0 = u.pm * 256 + wr * 64 + fr, col0 = u.pn * 256 + wc * 32 + 8 * fq;
        const bool side = (u.pn == tk) || (u.pn == tv);
#pragma unroll
        for (int ai = 0; ai < 2; ++ai)
#pragma unroll
            for (int m = 0; m < 4; ++m) {
                const int row = row0 + ai * 128 + m * 16;
                const float rs = RS[wr * 64 + ai * 128 + m * 16 + fr];
                bf16_t* rowp = O + (size_t)row * ldc + col0;
#pragma unroll
                for (int bj = 0; bj < 2; ++bj) {
                    const f32x4 v0 = acc[ai][bj][m][0] * rs, v1 = acc[ai][bj][m][1] * rs;
                    u32x4 w; w.x = pk2(v0[0], v0[1]); w.y = pk2(v0[2], v0[3]); w.z = pk2(v1[0], v1[1]); w.w = pk2(v1[2], v1[3]);
                    *(u32x4*)(rowp + bj * 128) = w;
                    if (side) {
                        float* f = (u.pn == tk) ? (row < MP ? fkp + (size_t)row * 256 : fks + (size_t)(row - MP) * 256) : (row < MP ? fvp + (size_t)row * 256 : fvs + (size_t)(row - MP) * 256);
                        f += wc * 32 + 8 * fq + bj * 128;
                        *(f32x4*)f = v0; *(f32x4*)(f + 4) = v1;
                    }
                }
            }
    }
};
struct EpiScaleF32 {
    static constexpr bool PERM = true, AFTER_DRAIN = false, ROWMAP = false, STAGE = false;
    float* O; int ldc; const float* ssq1;
    DI void operator()(const f32x4 (&acc)[2][2][4][2], const pg8::Unit& u, int wr, int wc, int fr, int fq) const {
        const int row0 = u.pm * 256 + wr * 64 + fr, col0 = u.pn * 256 + wc * 32 + 8 * fq;
#pragma unroll
        for (int ai = 0; ai < 2; ++ai)
#pragma unroll
            for (int m = 0; m < 4; ++m) {
                const int row = row0 + ai * 128 + m * 16;
                const float rs = rsqrtf(ssq1[row] * (1.0f / DM) + EPS);
                float* rowp = O + (size_t)row * ldc + col0;
#pragma unroll
                for (int bj = 0; bj < 2; ++bj) { *(f32x4*)(rowp + bj * 128) = acc[ai][bj][m][0] * rs; *(f32x4*)(rowp + bj * 128 + 4) = acc[ai][bj][m][1] * rs; }
            }
    }
};
struct EpiResid {
    static constexpr bool PERM = true, AFTER_DRAIN = false, ROWMAP = false, STAGE = false;
    float* XF; bf16_t* XB; u64_t* ssq; int fin;
    DI void operator()(const f32x4 (&acc)[2][2][4][2], const pg8::Unit& u, int wr, int wc, int fr, int fq) const {
        const int row0 = u.pm * 256 + wr * 64 + fr, col0 = u.pn * 256 + wc * 32 + 8 * fq;
        u32x4 rv[4][2];
#pragma unroll
        for (int i = 0; i < 4; ++i) { const bf16_t* rp = XB + (size_t)(row0 + i * 16) * DM + col0; rv[i][0] = *(const u32x4*)rp; rv[i][1] = *(const u32x4*)(rp + 128); }
#pragma unroll
        for (int i = 0; i < 8; ++i) {
            const int ai = i >> 2, m = i & 3, row = row0 + ai * 128 + m * 16;
            const u32x4 r0 = rv[i & 3][0], r1 = rv[i & 3][1];
            if (i + 4 < 8) { const bf16_t* rp = XB + (size_t)(row0 + 128 + (i & 3) * 16) * DM + col0; rv[i & 3][0] = *(const u32x4*)rp; rv[i & 3][1] = *(const u32x4*)(rp + 128); }
            float* xo = XF + (size_t)row * DM + col0; bf16_t* xb = XB + (size_t)row * DM + col0;
            float s = 0.f;
#pragma unroll
            for (int bj = 0; bj < 2; ++bj) {
                float r8[8]; unpk8(bj == 0 ? r0 : r1, r8);
                const f32x4 v0 = acc[ai][bj][m][0] + (f32x4){r8[0], r8[1], r8[2], r8[3]}, v1 = acc[ai][bj][m][1] + (f32x4){r8[4], r8[5], r8[6], r8[7]};
                if (fin) { *(f32x4*)(xo + bj * 128) = v0; *(f32x4*)(xo + bj * 128 + 4) = v1; }
                else { u32x4 w; w.x = pk2(v0[0], v0[1]); w.y = pk2(v0[2], v0[3]); w.z = pk2(v1[0], v1[1]); w.w = pk2(v1[2], v1[3]);
                    *(u32x4*)(xb + bj * 128) = w; }
                s += (v0[0] * v0[0] + v0[1] * v0[1]) + (v0[2] * v0[2] + v0[3] * v0[3]) + (v1[0] * v1[0] + v1[1] * v1[1]) + (v1[2] * v1[2] + v1[3] * v1[3]);
            }
            s += __shfl_xor(s, 16); s += __shfl_xor(s, 32);
            if (fq == 0 && !fin) atomicAdd(ssq + row, (u64_t)(s * SSQ_FIX));
        }
    }
};

DI float dpp_ror1(float v) { return __builtin_bit_cast(float, __builtin_amdgcn_update_dpp(0, __builtin_bit_cast(int, v), 0x121, 0xf, 0xf, false)); }
DI float dpp_ror2(float v) { return __builtin_bit_cast(float, __builtin_amdgcn_update_dpp(0, __builtin_bit_cast(int, v), 0x122, 0xf, 0xf, false)); }
struct EpiAct {
    static constexpr bool PERM = true, AFTER_DRAIN = false, ROWMAP = true, STAGE = true;
    bf16_t* ACT; const u64_t* ssq; const float* cw; const float* cache; float* pfc; float* sfc;
    DI u32x2 st_issue(const pg8::Unit& n, int tid) const {
        int tok = 248 * n.pm + 62 * (tid >> 6) - 2 + (tid & 63); tok = tok < 0 ? 0 : (tok < MALL ? tok : MALL - 1);
        int c = tid - 256; c = c < 0 ? 0 : (c < 192 ? c : 191);
        const unsigned* p = tid < 256 ? (const unsigned*)(ssq + tok) : (const unsigned*)(cw + (c >> 6) * DFF + n.pn * 128 + 2 * (c & 63));
        return *(const u32x2*)p;
    }
    DI void st_commit(u32x2 raw, const pg8::Unit& n, LAS float* RSn, int tid) const {
        if (tid < 256) { const int tok = 248 * n.pm + 62 * (tid >> 6) - 2 + (tid & 63); const u64_t v = ((u64_t)raw.y << 32) | raw.x;
            RSn[tid] = (tok >= 0 && tok < MALL) ? rsqrtf((float)v * (1.0f / (SSQ_FIX * DM)) + EPS) : 0.f; }
        else if (tid < 448) { const int c = tid - 256; *(LAS u32x2*)(RSn + 256 + (c >> 6) * 128 + 2 * (c & 63)) = raw; }
    }
    DI void operator()(f32x4 (&acc)[2][2][4][2], const pg8::Unit& u, int wr, int wc, int fr, int fq, const LAS float* RS) const {
        const int ch0 = u.pn * 128 + wc * 32 + 8 * fq;
        f32x4 w[3][2];
#pragma unroll
        for (int i = 0; i < 3; ++i)
#pragma unroll
            for (int n = 0; n < 2; ++n) w[i][n] = *(const LAS f32x4*)(RS + 256 + i * 128 + wc * 32 + 8 * fq + 4 * n);
#pragma unroll
        for (int ai = 0; ai < 2; ++ai) {
            const int tok0 = 248 * u.pm + 62 * (2 * ai + wr) - 2 + fr;
#pragma unroll
            for (int m = 0; m < 4; ++m) {
                const float rs = RS[(2 * ai + wr) * 64 + 16 * m + fr];
#pragma unroll
                for (int bj = 0; bj < 2; ++bj)
#pragma unroll
                    for (int n = 0; n < 2; ++n) acc[ai][bj][m][n] = acc[ai][bj][m][n] * rs;
            }
            f32x4 p1[2], p2[2];
#pragma unroll
            for (int n = 0; n < 2; ++n) { p1[n] = (f32x4){0.f, 0.f, 0.f, 0.f}; p2[n] = p1[n]; }
#pragma unroll
            for (int m = 0; m < 4; ++m) {
                const int tok = tok0 + 16 * m;
                f32x4 g1[2], g2[2];
#pragma unroll
                for (int n = 0; n < 2; ++n)
#pragma unroll
                    for (int e = 0; e < 4; ++e) {
                        const float a1 = dpp_ror1(acc[ai][0][m][n][e]), a2 = dpp_ror2(acc[ai][0][m][n][e]);
                        g1[n][e] = fr >= 1 ? a1 : p1[n][e]; g2[n][e] = fr >= 2 ? a2 : p2[n][e];
                        p1[n][e] = a1; p2[n][e] = a2;
                    }
                const bool outrow = (16 * m + fr >= 2) && tok < MALL;
                const bool smp = tok >= MP;
                const int t = smp ? ((tok - MP) & (TS - 1)) : (tok & (TP - 1)), bb = smp ? ((tok - MP) >> 4) : (tok >> 12), T = smp ? TS : TP;
                if (outrow && t < 2) {
                    f32x4 h0[2], h1[2];
#pragma unroll
                    for (int n = 0; n < 2; ++n) { h0[n] = (f32x4){0.f, 0.f, 0.f, 0.f}; h1[n] = h0[n]; }
                    if (smp) { const float* cp = cache + (size_t)bb * 2 * DFF + ch0;
#pragma unroll
                        for (int n = 0; n < 2; ++n) { h0[n] = *(const f32x4*)(cp + 4 * n); h1[n] = *(const f32x4*)(cp + DFF + 4 * n); } }
#pragma unroll
                    for (int n = 0; n < 2; ++n) { if (t == 0) { g2[n] = h0[n]; g1[n] = h1[n]; } else g2[n] = h1[n]; }
                }
                if (outrow) {
                    float y[8];
#pragma unroll
                    for (int n = 0; n < 2; ++n)
#pragma unroll
                        for (int e = 0; e < 4; ++e) { const float gt = w[0][n][e] * g2[n][e] + w[1][n][e] * g1[n][e] + w[2][n][e] * acc[ai][0][m][n][e]; y[4 * n + e] = siluf_(gt) * acc[ai][1][m][n][e]; }
                    *(u32x4*)(ACT + (size_t)tok * DFF + ch0) = pk8(y);
                    if (t >= T - 2) { float* dst = (smp ? sfc : pfc) + ((size_t)bb * 2 + (t - (T - 2))) * DFF + ch0; *(f32x4*)dst = acc[ai][0][m][0]; *(f32x4*)(dst + 4) = acc[ai][0][m][1]; }
                }
            }
        }
    }
};

DI void transpose_item(const float* W, int K, int N, int n_src0, const float* gain, bf16_t* WT, int row_dst0, int kb, LAS float* scr, int lane) {
    const int k0 = 64 * kb, q = lane & 15, r4 = lane >> 4;
    f32x4 v[16];
#pragma unroll
    for (int i = 0; i < 16; ++i) v[i] = *(const f32x4*)(W + (size_t)(k0 + 4 * i + r4) * N + n_src0 + 4 * q);
#pragma unroll
    for (int i = 0; i < 16; ++i) { const int kk = 4 * i + r4; const float g = gain ? gain[k0 + kk] : 1.f; LAS float* s = scr + kk * 65 + 4 * q;
        s[0] = v[i][0] * g; s[1] = v[i][1] * g; s[2] = v[i][2] * g; s[3] = v[i][3] * g; }
    LDS_WAIT(); asm volatile("" ::: "memory");
    const int c = lane & 7;
#pragma unroll
    for (int j = 0; j < 8; ++j) { const int n = (lane >> 3) + 8 * j; const LAS float* s = scr + (8 * c) * 65 + n;
        u32x4 o; o.x = pk2(s[0 * 65], s[1 * 65]); o.y = pk2(s[2 * 65], s[3 * 65]); o.z = pk2(s[4 * 65], s[5 * 65]); o.w = pk2(s[6 * 65], s[7 * 65]);
        *(u32x4*)(WT + (size_t)(row_dst0 + n) * K + k0 + 8 * c) = o; }
    LDS_WAIT(); asm volatile("" ::: "memory");
}
DI float row_to_bf16(const float* xrow, bf16_t* orow, int lane) {
    const f32x4* xr = (const f32x4*)xrow + lane; float s = 0.f;
    unsigned long long* o8 = (unsigned long long*)orow + lane;
#pragma unroll
    for (int j = 0; j < 4; ++j) { const f32x4 v = xr[64 * j]; s += (v[0] * v[0] + v[1] * v[1]) + (v[2] * v[2] + v[3] * v[3]);
        o8[64 * j] = (unsigned long long)pk2(v[0], v[1]) | ((unsigned long long)pk2(v[2], v[3]) << 32); }
    return wave_sum(s);
}
DI void transpose_v_tile(const float* src, size_t pitch, bf16_t* dst, LAS unsigned char* lds, int tid) {
    LAS bf16_t* tile = (LAS bf16_t*)lds;
#pragma unroll 4
    for (int i = 0; i < 64; ++i) { const int idx = tid + 512 * i, n = idx >> 7, d = idx & 127; tile[d * 264 + n] = f2bf(src[(size_t)n * pitch + d]); }
    __syncthreads();
#pragma unroll
    for (int i = 0; i < 8; ++i) { const int v = tid + 512 * i, d = v >> 5, n8 = v & 31; *(u32x4*)(dst + (size_t)d * 256 + 8 * n8) = *(const LAS u32x4*)(tile + d * 264 + 8 * n8); }
    __syncthreads();
}

DI void phase_convert(const Args& A, LAS unsigned char* lds) {
    const int tid = otid(), lane = tid & 63, wave = tid >> 6, G = gridDim.x;
    const int gw = blockIdx.x * NWAVES + wave, NGW = G * NWAVES;
    unsigned char* ws = A.ws;
    LAS float* scr = (LAS float*)(lds + wave * 16640);
    constexpr int NI = 3776;
    for (int it = gw; it < NL * NI; it += NGW) {
        const int l = it / NI; int r = it % NI;
        if (r < 896) { const int kb = r / 56, nb = r % 56, nd = 64 * nb; transpose_item(A.in[I_WIN] + (size_t)l * DM * DIN, DM, DIN, nd + (nd >= 2048 ? 8 : 0), A.in[I_NMIXG] + l * DM, (bf16_t*)(ws + WS_WIN + l * SZ_WIN), nd, kb, scr, lane); continue; } r -= 896;
        if (r < 256) { transpose_item(A.in[I_WMIX] + (size_t)l * DM * DM, DM, DM, 64 * (r % 16), nullptr, (bf16_t*)(ws + WS_WMIX + l * SZ_WMIX), 64 * (r % 16), r / 16, scr, lane); continue; } r -= 256;
        if (r < 128) { transpose_item(A.in[I_WMQ] + (size_t)l * DM * 512, DM, 512, 64 * (r % 8), A.in[I_NMEMG] + l * DM, (bf16_t*)(ws + WS_WMQ + l * SZ_WMQ), 64 * (r % 8), r / 8, scr, lane); continue; } r -= 128;
        if (r < 128) { transpose_item(A.in[I_WMK] + (size_t)l * DM * 512, DM, 512, 64 * (r % 8), A.in[I_MEMING] + l * DM, (bf16_t*)(ws + WS_WMKV), l * 1024 + 64 * (r % 8), r / 8, scr, lane); continue; } r -= 128;
        if (r < 128) { transpose_item(A.in[I_WMV] + (size_t)l * DM * 512, DM, 512, 64 * (r % 8), A.in[I_MEMING] + l * DM, (bf16_t*)(ws + WS_WMKV), l * 1024 + 512 + 64 * (r % 8), r / 8, scr, lane); continue; } r -= 128;
        if (r < 128) { transpose_item(A.in[I_WMO] + (size_t)l * 512 * DM, 512, DM, 64 * (r % 16), nullptr, (bf16_t*)(ws + WS_WMO + l * SZ_WMO), 64 * (r % 16), r / 16, scr, lane); continue; } r -= 128;
        if (r < 704) { const int nb = r % 44; transpose_item(A.in[I_WGATE] + (size_t)l * DM * DFF, DM, DFF, 64 * nb, A.in[I_NFFNG] + l * DM, (bf16_t*)(ws + WS_WGU + l * SZ_WGU), 256 * (nb >> 1) + 64 * (nb & 1), r / 44, scr, lane); continue; } r -= 704;
        if (r < 704) { const int nb = r % 44; transpose_item(A.in[I_WUP] + (size_t)l * DM * DFF, DM, DFF, 64 * nb, A.in[I_NFFNG] + l * DM, (bf16_t*)(ws + WS_WGU + l * SZ_WGU), 256 * (nb >> 1) + 128 + 64 * (nb & 1), r / 44, scr, lane); continue; } r -= 704;
        transpose_item(A.in[I_WDN] + (size_t)l * DFF * DM, DFF, DM, 64 * (r % 16), nullptr, (bf16_t*)(ws + WS_WDN + l * SZ_WDN), 64 * (r % 16), r / 16, scr, lane);
    }
    for (int e = blockIdx.x * NTHR + tid; e < NL * 16 * DM; e += G * NTHR) {
        const int l = e / (16 * DM), j = (e / DM) & 15, k = e % DM;
        const float v = j < 8 ? A.in[I_WIN][(size_t)l * DM * DIN + (size_t)k * DIN + 2048 + j] * A.in[I_NMIXG][l * DM + k] : 0.f;
        ((bf16_t*)(ws + WS_WG8 + l * SZ_WG8))[j * DM + k] = f2bf(v);
    }
    bf16_t* XB = (bf16_t*)(ws + WS_XB); u64_t* SSQ = (u64_t*)(ws + WS_SSQ);
    for (int row = gw; row < MALL + 4096; row += NGW) {
        if (row < MALL) {
            const float* src = row < MP ? A.in[I_XP] + (size_t)row * DM : A.in[I_XS] + (size_t)(row - MP) * DM;
            const float s = row_to_bf16(src, XB + (size_t)row * DM, lane);
            if (lane == 0) SSQ[row] = (u64_t)(s * SSQ_FIX);
        } else {
            const int r = row - MALL;
            const float s = row_to_bf16(A.in[I_MEM] + (size_t)r * DM, (bf16_t*)(ws + WS_MEMB) + (size_t)r * DM, lane);
            if (lane == 0) ((float*)(ws + WS_SSQM))[r] = s;
        }
    }
    for (int e = blockIdx.x * NTHR + tid; e < 256 * DM / 8; e += G * NTHR) ((u32x4*)(XB + (size_t)MALL * DM))[e] = (u32x4){0u, 0u, 0u, 0u};
    {
        bf16_t* SMK = (bf16_t*)(ws + WS_SMK);
        const int NV = NL * BS * 4 * 256 * 16;
        for (int v = blockIdx.x * NTHR + tid; v < NV; v += G * NTHR) {
            const int d8 = v & 15, n = (v >> 4) & 255, h = (v >> 12) & 3, sb = (v >> 14) & 31, l = v >> 19;
            const float* src = A.in[I_CMK] + ((((size_t)(l * BS + sb) * 256 + n) * 4 + h) * 128 + 8 * d8);
            const float* g = A.in[I_MQG] + l * 128 + 8 * d8;
            const f32x4 a = *(const f32x4*)src, b = *(const f32x4*)(src + 4), ga = *(const f32x4*)g, gb = *(const f32x4*)(g + 4);
            u32x4 o; o.x = pk2(a[0] * ga[0], a[1] * ga[1]); o.y = pk2(a[2] * ga[2], a[3] * ga[3]); o.z = pk2(b[0] * gb[0], b[1] * gb[1]); o.w = pk2(b[2] * gb[2], b[3] * gb[3]);
            *(u32x4*)(SMK + (size_t)v * 8) = o;
        }
    }
    __syncthreads();
    for (int t = blockIdx.x; t < NL * BS * 4; t += G) {
        const int h = t & 3, sb = (t >> 2) & 31, l = t >> 7;
        transpose_v_tile(A.in[I_CMV] + ((size_t)(l * BS + sb) * 256 * 4 + h) * 128, 512, (bf16_t*)(ws + WS_SMVT) + (size_t)t * 128 * 256, lds, tid);
    }
}

DI void phase_memkv_post(const Args& A, LAS unsigned char* lds) {
    const int tid = otid(), lane = tid & 63, wave = tid >> 6, G = gridDim.x;
    const float* RAW = (const float*)(A.ws + WS_RAWKV);
    for (int u = blockIdx.x; u < NL * BP * 4; u += G) {
        const int h = u & 3, b = (u >> 2) & 15, l = u >> 6;
        const float mkg0 = A.in[I_MKG][l * 128 + 2 * lane], mkg1 = A.in[I_MKG][l * 128 + 2 * lane + 1];
        const float mqg0 = A.in[I_MQG][l * 128 + 2 * lane], mqg1 = A.in[I_MQG][l * 128 + 2 * lane + 1];
        bf16_t* MK = (bf16_t*)(A.ws + WS_MK) + (size_t)((l * BP + b) * 4 + h) * 256 * 128;
        for (int n = wave; n < 256; n += NWAVES) {
            const float* src = RAW + (size_t)(b * 256 + n) * 4096 + l * 1024 + h * 128;
            const f32x2 k = *(const f32x2*)(src + 2 * lane), v = *(const f32x2*)(src + 512 + 2 * lane);
            const float ss = wave_sum(k[0] * k[0] + k[1] * k[1]);
            const float rs = rsqrtf(ss * (1.0f / 128.0f) + EPS);
            const float k0 = k[0] * rs * mkg0, k1 = k[1] * rs * mkg1;
            const size_t oo = (((size_t)(l * BP + b) * 256 + n) * 4 + h) * 128 + 2 * lane;
            *(f32x2*)(A.out + O_PMK + oo) = (f32x2){k0, k1};
            *(f32x2*)(A.out + O_PMV + oo) = v;
            *(unsigned*)(MK + (size_t)n * 128 + 2 * lane) = pk2(k0 * mqg0, k1 * mqg1);
        }
        __syncthreads();
        transpose_v_tile(RAW + (size_t)(b * 256) * 4096 + l * 1024 + 512 + h * 128, 4096, (bf16_t*)(A.ws + WS_MVT) + (size_t)((l * BP + b) * 4 + h) * 128 * 256, lds, tid);
    }
}
constexpr int P_K = 0, P_Q = 17408, P_VB = 34816, P_KB = 52224, P_KD = 69632, P_LD = 87040, P_LB = 91136, P_DI = 100352, P_GR = 102400, P_BETA = 106496, P_GC = 107520,
    P_CW = 108544, P_WST = 114688, P_END = 132096;
DI void prep_load_cw(const float* cw, int h, LAS float* CW, int t0, int nt) {
    for (int v = t0; v < 4 * 3 * 32; v += nt) { const int c4 = v & 31, x = (v >> 5) % 3, i = v / 96; *(LAS f32x4*)(CW + (i * 3 + x) * 128 + 4 * c4) = *(const f32x4*)(cw + i * 1536 + x * 512 + h * 128 + 4 * c4); }
}
DI void prep_unit(const Args& A, LAS unsigned char* lds, int l, int u) {
    const int tid = otid(), lane = tid & 63, wave = __builtin_amdgcn_readfirstlane(tid >> 6), fr = lane & 15, fq = lane >> 4;
    const bool smp = u >= 1024;
    const int b = smp ? (u - 1024) : (u >> 6), c = smp ? 0 : (u & 63);
    const int row0 = smp ? MP + 16 * b : b * TP + 64 * c;
    const int chbase = smp ? 4096 + 4 * b : b * 256 + c, chstep = smp ? 1 : 64;
    const bf16_t* Z = (const bf16_t*)(A.ws + WS_Z); const bf16_t* XB = (const bf16_t*)(A.ws + WS_XB); const u64_t* SSQ = (const u64_t*)(A.ws + WS_SSQ) + (size_t)(3 * l) * MALL;
    bf16_t* PREP = (bf16_t*)(A.ws + WS_PREP); float* EG = (float*)(A.ws + WS_EG);
    LAS bf16_t* Ksh = (LAS bf16_t*)(lds + P_K); LAS bf16_t* Qsh = (LAS bf16_t*)(lds + P_Q); LAS bf16_t* VB = (LAS bf16_t*)(lds + P_VB); LAS bf16_t* KB = (LAS bf16_t*)(lds + P_KB);
    LAS bf16_t* KD = (LAS bf16_t*)(lds + P_KD); LAS float* LD = (LAS float*)(lds + P_LD); LAS bf16_t* LB = (LAS bf16_t*)(lds + P_LB); LAS bf16_t* DI_ = (LAS bf16_t*)(lds + P_DI);
    LAS float* GR = (LAS float*)(lds + P_WST);       LAS float* BETA = (LAS float*)(lds + P_BETA); LAS float* GC = (LAS float*)(lds + P_GC);
    LAS float* CW = (LAS float*)(lds + P_CW); LAS bf16_t* WST = (LAS bf16_t*)(lds + P_WST);
    const float* cw = A.in[I_GCW] + (size_t)l * 4 * 1536;
    {
        const int tw = wave & 3, kh = wave >> 2;
        const bf16_t* wg = (const bf16_t*)(A.ws + WS_WG8 + l * SZ_WG8) + (size_t)fr * DM + 8 * fq + 512 * kh;
        int tr = 16 * tw + fr; if (smp && tr >= 16) tr = 15;
        const bf16_t* xa = XB + (size_t)(row0 + tr) * DM + 8 * fq + 512 * kh;
        f32x4 acc = {0.f, 0.f, 0.f, 0.f};
#pragma unroll
        for (int ks = 0; ks < 16; ++ks) acc = MFMA16(*(const bf16x8*)(xa + 32 * ks), *(const bf16x8*)(wg + 32 * ks), acc);
#pragma unroll
        for (int e = 0; e < 4; ++e) GR[kh * 1024 + (16 * tw + 4 * fq + e) * 16 + fr] = acc[e];
    }
    prep_load_cw(cw, 0, CW, tid, NTHR);
    LBAR();
    if (tid < 256) {
        const int t = tid >> 2, h = tid & 3;
        int tr = t; if (smp && tr >= 16) tr = 15;
        const float rs = row_rstd(SSQ, row0 + tr);
        const float bt = sigmoidf_((GR[t * 16 + h] + GR[1024 + t * 16 + h]) * rs);
        const float a2 = (GR[t * 16 + 4 + h] + GR[1024 + t * 16 + 4 + h]) * rs + A.in[I_DTB][l * 4 + h];
        float g = -__expf(A.in[I_ALOG][l * 4 + h]) * softplusf_(a2);
        const bool pad = smp && t >= 16;
        BETA[h * 64 + t] = pad ? 0.f : bt; GC[h * 64 + t] = pad ? 0.f : g;
    } else if (smp || c == 63) {
        float* dst = smp ? A.out + O_SGC + (size_t)(l * BS + b) * 3 * 1536 : A.out + O_PGC + (size_t)(l * BP + b) * 3 * 1536;
        const int tl = smp ? 13 : 61;
        for (int e = tid - 256; e < 3 * 1536; e += 256) { const int j = e / 1536, col = e % 1536; dst[e] = bf2f(Z[(size_t)(row0 + tl + j) * NZ + col]); }
    }
    LBAR();
    if (wave < 4) {
        float v = GC[wave * 64 + lane];
#pragma unroll
        for (int o = 1; o < 64; o <<= 1) { const float up = __shfl_up(v, o); if (lane >= o) v += up; }
        GC[wave * 64 + lane] = v;
        if (lane == 63) EG[chbase + wave * chstep] = __expf(v);
    }
    LBAR();
    for (int h = 0; h < 4; ++h) {
        bf16_t* P = PREP + (size_t)(chbase + h * chstep) * PCH;
        if (h > 0) { bf16_t* Pp = PREP + (size_t)(chbase + (h - 1) * chstep) * PCH;
#pragma unroll
            for (int i = 0; i < 2; ++i) { const int v = tid + 512 * i, t = v >> 4, d8 = v & 15; *(u32x4*)(Pp + PW + ((((t >> 4) * 4 + (d8 >> 2)) * 64 + (d8 & 3) * 16 + (t & 15)) << 3)) = *(const LAS u32x4*)(WST + t * 136 + 8 * d8); } }
#pragma unroll 1
        for (int pass = 0; pass < 2; ++pass) {
            const int t = (tid >> 4) + 32 * pass, seg = tid & 15, cg = h * 128 + 8 * seg;
            const bool pad = smp && t >= 16;
            u32x4 zr[3][4];
#pragma unroll
            for (int x = 0; x < 3; ++x)
#pragma unroll
                for (int i = 0; i < 4; ++i) {
                    const int tt = t - 3 + i, col = x * 512 + cg;
                    if (tt >= 0 || (!smp && c > 0)) zr[x][i] = *(const u32x4*)(Z + (size_t)(row0 + tt) * NZ + col);
                    else if (smp) { const float* cp = A.in[I_CGC] + ((size_t)(l * BS + b) * 3 + (tt + 3)) * 1536 + col; float f[8];
                        const f32x4 q0 = *(const f32x4*)cp, q1 = *(const f32x4*)(cp + 4); f[0] = q0[0]; f[1] = q0[1]; f[2] = q0[2]; f[3] = q0[3]; f[4] = q1[0]; f[5] = q1[1]; f[6] = q1[2]; f[7] = q1[3]; zr[x][i] = pk8(f); }
                    else zr[x][i] = (u32x4){0u, 0u, 0u, 0u};
                }
            const float gct = GC[h * 64 + t], egt = __expf(gct), bt = BETA[h * 64 + t], ed = __expf(GC[h * 64 + 63] - gct);
#pragma unroll
            for (int x = 0; x < 3; ++x) {
                float acc[8];
#pragma unroll
                for (int j = 0; j < 8; ++j) acc[j] = 0.f;
#pragma unroll
                for (int i = 0; i < 4; ++i) {
                    float xv[8]; unpk8(zr[x][i], xv);
                    const f32x4 w0 = *(const LAS f32x4*)(CW + (i * 3 + x) * 128 + 8 * seg), w1 = *(const LAS f32x4*)(CW + (i * 3 + x) * 128 + 8 * seg + 4);
                    acc[0] += w0[0] * xv[0]; acc[1] += w0[1] * xv[1]; acc[2] += w0[2] * xv[2]; acc[3] += w0[3] * xv[3];
                    acc[4] += w1[0] * xv[4]; acc[5] += w1[1] * xv[5]; acc[6] += w1[2] * xv[6]; acc[7] += w1[3] * xv[7];
                }
                float ssum = 0.f;
#pragma unroll
                for (int j = 0; j < 8; ++j) { acc[j] = pad ? 0.f : siluf_(acc[j]); ssum += acc[j] * acc[j]; }
                ssum += __shfl_xor(ssum, 1); ssum += __shfl_xor(ssum, 2); ssum += __shfl_xor(ssum, 4); ssum += __shfl_xor(ssum, 8);
                const float rn = rsqrtf(ssum + EPS);
                if (x == 0) {
                    float qe[8];
#pragma unroll
                    for (int j = 0; j < 8; ++j) { acc[j] *= rn * 0.08838834764831845f; qe[j] = acc[j] * egt; }
                    *(LAS u32x4*)(Qsh + t * 136 + 8 * seg) = pk8(acc);
                    *(u32x4*)(P + PQE + ((((t >> 4) * 4 + (seg >> 2)) * 64 + (seg & 3) * 16 + (t & 15)) << 3)) = pk8(qe);
                } else if (x == 1) {
                    const float kb = bt * egt; float k1[8], k2[8];
#pragma unroll
                    for (int j = 0; j < 8; ++j) { acc[j] *= rn; k1[j] = acc[j] * kb; k2[j] = acc[j] * ed; }
                    *(LAS u32x4*)(Ksh + t * 136 + 8 * seg) = pk8(acc); *(LAS u32x4*)(KB + t * 136 + 8 * seg) = pk8(k1); *(LAS u32x4*)(KD + t * 136 + 8 * seg) = pk8(k2);
                } else {
#pragma unroll
                    for (int j = 0; j < 8; ++j) acc[j] *= bt;
                    *(LAS u32x4*)(VB + t * 136 + 8 * seg) = pk8(acc);
                }
            }
        }
        LBAR();
        {
#pragma unroll
            for (int i = 0; i < 2; ++i) { const int v = tid + 512 * i, d = v & 127, t8 = v >> 7; unsigned w[4];
#pragma unroll
                for (int j = 0; j < 4; ++j) w[j] = (unsigned)KD[(8 * t8 + 2 * j) * 136 + d] | ((unsigned)KD[(8 * t8 + 2 * j + 1) * 136 + d] << 16);
                *(u32x4*)(P + PKDT + ((((d >> 4) * 2 + (t8 >> 2)) * 64 + (t8 & 3) * 16 + (d & 15)) << 3)) = (u32x4){w[0], w[1], w[2], w[3]}; }
#pragma unroll
            for (int i = 0; i < 4; ++i) {
                const int id = wave + 8 * i, isqk = id >> 4, st = (id >> 2) & 3, tt = id & 3;
                f32x4 acc = {0.f, 0.f, 0.f, 0.f};
                if (st <= tt) {
                    const LAS bf16_t* ap = Ksh + (16 * st + fr) * 136 + 8 * fq;
                    const LAS bf16_t* bp = (isqk ? Qsh : Ksh) + (16 * tt + fr) * 136 + 8 * fq;
#pragma unroll
                    for (int ks = 0; ks < 4; ++ks) acc = MFMA16(*(const LAS bf16x8*)(ap + 32 * ks), *(const LAS bf16x8*)(bp + 32 * ks), acc);
                }
                const int t = 16 * tt + fr; const float gct = GC[h * 64 + t], bt = BETA[h * 64 + t];
                f32x4 o;
#pragma unroll
                for (int e = 0; e < 4; ++e) {
                    const int s = 16 * st + 4 * fq + e;
                    const float dec = __expf(fminf(gct - GC[h * 64 + s], 0.f));
                    if (isqk) o[e] = (s <= t) ? acc[e] * dec : 0.f;
                    else o[e] = (s < t) ? acc[e] * dec * bt : 0.f;
                }
                if (isqk) *(u32x2*)(P + PQK + (((tt * 2 + (st >> 1)) * 64 + (2 * (st & 1) + (fq >> 1)) * 16 + fr) << 3) + 4 * (fq & 1)) = pk4(o);
                else if (st == tt) *(LAS f32x4*)(LD + (st * 16 + fr) * 16 + 4 * fq) = o;
                else if (st < tt) *(LAS u32x2*)(LB + t * 72 + 16 * st + 4 * fq) = pk4(-o);
            }
        }
        LBAR();
        if (wave == 0) {
            const int blk = lane >> 4, cc = lane & 15;
            float x[16];
#pragma unroll
            for (int i = 0; i < 16; ++i) {
                float s = (i == cc) ? 1.f : 0.f;
                const LAS float* lr = LD + (blk * 16 + i) * 16;
#pragma unroll
                for (int j = 0; j < i; ++j) s -= lr[j] * x[j];
                x[i] = s;
            }
#pragma unroll
            for (int i = 0; i < 16; ++i) DI_[(blk * 16 + i) * 16 + cc] = f2bf(x[i]);
        } else if (h < 3) prep_load_cw(cw, h + 1, CW, tid - 64, 448);
        LBAR();
#pragma unroll
        for (int cti = 0; cti < 2; ++cti) {
            const int ct = 2 * wave + cti; const bool isw = ct >= 8; const int d = 16 * (ct & 7) + fr;
            const LAS bf16_t* rhs = (isw ? KB : VB) + d;
            bf16x4 Xb[4];
#pragma unroll
            for (int i = 0; i < 4; ++i) {
                f32x4 acc;
#pragma unroll
                for (int e = 0; e < 4; ++e) acc[e] = bf2f(rhs[(16 * i + 4 * fq + e) * 136]);
#pragma unroll
                for (int k = 0; k < i; ++k) acc = MFMA16K16(*(const LAS bf16x4*)(LB + (16 * i + fr) * 72 + 16 * k + 4 * fq), Xb[k], acc);
                const u32x2 ab = pk4(acc);
                const f32x4 xi = MFMA16K16(*(const LAS bf16x4*)(DI_ + (i * 16 + fr) * 16 + 4 * fq), __builtin_bit_cast(bf16x4, ab), ((f32x4){0.f, 0.f, 0.f, 0.f}));
                const u32x2 xb = pk4(xi); Xb[i] = __builtin_bit_cast(bf16x4, xb);
                if (!isw) *(u32x2*)(P + PUT + ((((ct & 7) * 4 + i) * 64 + fq * 16 + fr) << 2)) = xb;
                else {
                    WST[(16 * i + 4 * fq + 0) * 136 + d] = (bf16_t)(xb.x & 0xffffu); WST[(16 * i + 4 * fq + 1) * 136 + d] = (bf16_t)(xb.x >> 16);
                    WST[(16 * i + 4 * fq + 2) * 136 + d] = (bf16_t)(xb.y & 0xffffu); WST[(16 * i + 4 * fq + 3) * 136 + d] = (bf16_t)(xb.y >> 16);
                }
            }
        }
        LBAR();
    }
    { bf16_t* Pp = PREP + (size_t)(chbase + 3 * chstep) * PCH;
#pragma unroll
        for (int i = 0; i < 2; ++i) { const int v = tid + 512 * i, t = v >> 4, d8 = v & 15; *(u32x4*)(Pp + PW + ((((t >> 4) * 4 + (d8 >> 2)) * 64 + (d8 & 3) * 16 + (t & 15)) << 3)) = *(const LAS u32x4*)(WST + t * 136 + 8 * d8); } }
    LBAR();
}

constexpr int S_ST = 0, S_VN = 34816, S_NP = 53248;
struct ScanOps { bf16x8 Wf[4], QEf[4], QKf[2], KDf[2]; u32x2 Uf[4]; u32x2 gz[4]; float eg; };
template <bool SMP>
DI void scan_load(ScanOps& o, const bf16_t* P, const bf16_t* Z, float egv, int row0, int h, int w, int tt, int dh, int fr, int fq, bool tok_ok) {
    const unsigned l16 = (unsigned)(fq * 16 + fr) * 16u, l8 = (unsigned)(fq * 16 + fr) * 8u;
    const char* Pb = (const char*)P;
    const char* pw = Pb + (size_t)(PW + tt * 2048) * 2; const char* pqe = Pb + (size_t)(PQE + tt * 2048) * 2; const char* pqk = Pb + (size_t)(PQK + tt * 1024) * 2;
    const char* pkd = Pb + (size_t)(PKDT + w * 1024) * 2; const char* pu = Pb + (size_t)(PUT + (16 * dh * 256 + tt * 256)) * 2;
#pragma unroll
    for (int ks = 0; ks < 4; ++ks) { o.Wf[ks] = *(const bf16x8*)(pw + ks * 1024 + l16); o.QEf[ks] = *(const bf16x8*)(pqe + ks * 1024 + l16); }
#pragma unroll
    for (int ks = 0; ks < 2; ++ks) { o.QKf[ks] = *(const bf16x8*)(pqk + ks * 1024 + l16); o.KDf[ks] = *(const bf16x8*)(pkd + ks * 1024 + l16); }
#pragma unroll
    for (int j = 0; j < 4; ++j) o.Uf[j] = *(const u32x2*)(pu + j * 2048 + l8);
    if (SMP) { int gr = row0 + 16 * tt + fr; gr = gr < MALL ? gr : MALL - 1;
#pragma unroll
        for (int j = 0; j < 4; ++j) o.gz[j] = *(const u32x2*)(Z + (size_t)gr * NZ + ZG + h * 128 + 16 * (4 * dh + j) + 4 * fq); }
    else { const char* zb = (const char*)Z + ((size_t)(row0 + 16 * tt) * NZ + ZG + h * 128 + 64 * dh) * 2; const unsigned lz = (unsigned)(fr * NZ + 4 * fq) * 2u;
#pragma unroll
        for (int j = 0; j < 4; ++j) o.gz[j] = *(const u32x2*)(zb + j * 32 + lz); }
    o.eg = egv;
}
template <bool SMP>
DI void scan_step(const ScanOps& o, f32x4 (&S)[8], LAS bf16_t* ST, LAS bf16_t* VN, LAS float* NP, bf16_t* Y, const f32x4 (&gn4)[4], int row0, int h, int w, int tt, int dh, int fr, int fq, bool tok_ok) {
    f32x4 accO[4];
#pragma unroll
    for (int j = 0; j < 4; ++j) {
        const int dt = 4 * dh + j;
        f32x4 accV = {0.f, 0.f, 0.f, 0.f}; accO[j] = (f32x4){0.f, 0.f, 0.f, 0.f};
#pragma unroll
        for (int ks = 0; ks < 4; ++ks) {
            const bf16x8 B = *(const LAS bf16x8*)(ST + (16 * dt + fr) * 136 + 32 * ks + 8 * fq);
            accV = MFMA16(o.Wf[ks], B, accV); accO[j] = MFMA16(B, o.QEf[ks], accO[j]);
        }
        const f32x4 vn = unpk4(o.Uf[j]) - accV;
        *(LAS u32x2*)(VN + (16 * dt + fr) * 72 + 16 * tt + 4 * fq) = pk4(vn);
    }
    LBAR();
#pragma unroll
    for (int j = 0; j < 4; ++j) {
        const int dt = 4 * dh + j;
#pragma unroll
        for (int ks = 0; ks < 2; ++ks) accO[j] = MFMA16(*(const LAS bf16x8*)(VN + (16 * dt + fr) * 72 + 32 * ks + 8 * fq), o.QKf[ks], accO[j]);
    }
    {
        float p = 0.f;
#pragma unroll
        for (int j = 0; j < 4; ++j) p += (accO[j][0] * accO[j][0] + accO[j][1] * accO[j][1]) + (accO[j][2] * accO[j][2] + accO[j][3] * accO[j][3]);
        p += __shfl_xor(p, 16); p += __shfl_xor(p, 32);
        if (fq == 0) NP[(16 * tt + fr) * 2 + dh] = p;
    }
#pragma unroll
    for (int dt = 0; dt < 8; ++dt) {
        S[dt] = S[dt] * o.eg;
#pragma unroll
        for (int ks = 0; ks < 2; ++ks) S[dt] = MFMA16(o.KDf[ks], *(const LAS bf16x8*)(VN + (16 * dt + fr) * 72 + 32 * ks + 8 * fq), S[dt]);
        *(LAS u32x2*)(ST + (16 * dt + fr) * 136 + 16 * w + 4 * fq) = pk4(S[dt]);
    }
    LBAR();
    if (!SMP || tok_ok) {
        const int t = 16 * tt + fr;
        const float rs = rsqrtf((NP[t * 2] + NP[t * 2 + 1]) * (1.0f / 128.0f) + EPS);
        char* yb = (char*)Y + ((size_t)(row0 + 16 * tt) * DM + h * 128) * 2; const unsigned ly = (unsigned)(fr * DM + 4 * fq) * 2u;
#pragma unroll
        for (int j = 0; j < 4; ++j) {
            const f32x4 g4 = gn4[j]; const f32x4 z4 = unpk4(o.gz[j]);
            f32x4 v;
#pragma unroll
            for (int e = 0; e < 4; ++e) v[e] = accO[j][e] * rs * g4[e] * siluf_(z4[e]);
            *(u32x2*)(yb + 32 * (4 * dh + j) + ly) = pk4(v);
        }
    }
}
DI void scan_item(const Args& A, LAS unsigned char* lds, int l, int item) {
    const int tid = otid(), lane = tid & 63, w = __builtin_amdgcn_readfirstlane(tid >> 6), fr = lane & 15, fq = lane >> 4, tt = w & 3, dh = w >> 2;
    const bool smp = item >= 64;
    const int b = smp ? ((item - 64) >> 2) : (item >> 2), h = item & 3, nsteps = smp ? 1 : 64;
    const bf16_t* Z = (const bf16_t*)(A.ws + WS_Z); bf16_t* Y = (bf16_t*)(A.ws + WS_Y);
    const bf16_t* PREP = (const bf16_t*)(A.ws + WS_PREP); const float* EG = (const float*)(A.ws + WS_EG);
    LAS bf16_t* ST = (LAS bf16_t*)(lds + S_ST); LAS bf16_t* VN = (LAS bf16_t*)(lds + S_VN); LAS float* NP = (LAS float*)(lds + S_NP);
    f32x4 gn4[4];
#pragma unroll
    for (int j = 0; j < 4; ++j) gn4[j] = *(const f32x4*)(A.in[I_GNG] + l * 128 + 16 * (4 * dh + j) + 4 * fq);
    const bool tok_ok = !smp || tt == 0;
    f32x4 S[8];
    if (smp) {
        const float* s0 = A.in[I_STATE] + (size_t)((l * BS + b) * 4 + h) * 128 * 128;
#pragma unroll
        for (int dt = 0; dt < 8; ++dt)
#pragma unroll
            for (int e = 0; e < 4; ++e) S[dt][e] = s0[(size_t)(16 * w + 4 * fq + e) * 128 + 16 * dt + fr];
    } else {
#pragma unroll
        for (int dt = 0; dt < 8; ++dt) S[dt] = (f32x4){0.f, 0.f, 0.f, 0.f};
    }
#pragma unroll
    for (int dt = 0; dt < 8; ++dt) *(LAS u32x2*)(ST + (16 * dt + fr) * 136 + 16 * w + 4 * fq) = pk4(S[dt]);
    const int ch0 = smp ? 4096 + 4 * b + h : (b * 4 + h) * 64;
    const int r00 = smp ? MP + 16 * b : b * TP;
    int zv = 0; asm volatile("" : "+v"(zv));
    const float* EGv = EG + zv;
    ScanOps oa, ob;
    if (smp) {
        scan_load<true>(oa, PREP + (size_t)ch0 * PCH, Z, EGv[ch0], r00, h, w, tt, dh, fr, fq, tok_ok);
        __syncthreads();
        scan_step<true>(oa, S, ST, VN, NP, Y, gn4, r00, h, w, tt, dh, fr, fq, tok_ok);
    } else {
        scan_load<false>(oa, PREP + (size_t)ch0 * PCH, Z, EGv[ch0], r00, h, w, tt, dh, fr, fq, true);
        __syncthreads();
#pragma unroll 1
        for (int c = 0; c < 64; c += 2) {
            scan_load<false>(ob, PREP + (size_t)(ch0 + (c + 1)) * PCH, Z, EGv[ch0 + (c + 1)], r00 + 64 * (c + 1), h, w, tt, dh, fr, fq, true);
            scan_step<false>(oa, S, ST, VN, NP, Y, gn4, r00 + 64 * c, h, w, tt, dh, fr, fq, true);
            const int cn = c + 2 < 64 ? c + 2 : 63;
            scan_load<false>(oa, PREP + (size_t)(ch0 + cn) * PCH, Z, EGv[ch0 + cn], r00 + 64 * cn, h, w, tt, dh, fr, fq, true);
            scan_step<false>(ob, S, ST, VN, NP, Y, gn4, r00 + 64 * (c + 1), h, w, tt, dh, fr, fq, true);
        }
    }
    float* so = (smp ? A.out + O_SGS + (size_t)((l * BS + b) * 4 + h) * 128 * 128 : A.out + O_PGS + (size_t)((l * BP + b) * 4 + h) * 128 * 128);
#pragma unroll
    for (int dt = 0; dt < 8; ++dt)
#pragma unroll
        for (int e = 0; e < 4; ++e) so[(size_t)(16 * w + 4 * fq + e) * 128 + 16 * dt + fr] = S[dt][e];
    __syncthreads();
}
constexpr float SB_CUT = 50.0f;
DI float neg_softplus(float z) {
    const float e = __builtin_amdgcn_exp2f(-fabsf(z) * 1.4426950408889634f);
    return -(fmaxf(z, 0.f) + __builtin_amdgcn_logf(1.0f + e) * 0.6931471805599453f);
}
template <bool SMP>
DI void sb_wave_unit(const Args& A, int l, int idx, int lane) {
    const int qi = lane & 31, hi = lane >> 5;
    const bf16_t* Z = (const bf16_t*)(A.ws + WS_Z); bf16_t* Y = (bf16_t*)(A.ws + WS_Y);
    int h, qrow, t0, b;
    bool qvalid = true;
    if (SMP) { b = idx >> 2; h = idx & 3; t0 = 0; qvalid = qi < TS; qrow = MP + TS * b + (qvalid ? qi : TS - 1); }
    else { h = idx & 3; const int qt = (idx >> 2) & 127; b = idx >> 9; t0 = 32 * qt; qrow = b * TP + t0 + qi; }
    bf16x8 Qf[4];
#pragma unroll
    for (int s = 0; s < 4; ++s) Qf[s] = *(const bf16x8*)(Z + (size_t)qrow * NZ + ZCQ + h * 64 + 16 * s + 8 * hi);
    f32x16 o0, o1;
#pragma unroll
    for (int r = 0; r < 16; ++r) { o0[r] = 0.f; o1[r] = 0.f; }
    float R = 0.f;
    const int nblk = SMP ? 1 + PAST / 32 : (t0 >> 5) + 1;
    const float* ck = SMP ? A.in[I_CSBK] + (size_t)(l * BS + b) * PAST * 256 + h * 64 : nullptr;
    const float* cv = SMP ? A.in[I_CSBV] + (size_t)(l * BS + b) * PAST * 256 + h * 64 : nullptr;
    for (int blk = 0; blk < nblk; ++blk) {
        const bool first = blk == 0;
        const bool from_z = !SMP || first;
        const int kbase = SMP ? (first ? 0 : PAST - 32 * blk) : t0 - 32 * blk;
        f32x16 acc;
#pragma unroll
        for (int r = 0; r < 16; ++r) acc[r] = 0.f;
        if (from_z) {
            int kr = kbase + qi; if (SMP && kr >= TS) kr = TS - 1;
            const bf16_t* kp = Z + (size_t)((SMP ? MP + TS * b : b * TP) + kr) * NZ + ZCK + h * 64 + 8 * hi;
#pragma unroll
            for (int s = 0; s < 4; ++s) acc = MFMA32(*(const bf16x8*)(kp + 16 * s), Qf[s], acc);
        } else {
            const float* kp = ck + (size_t)(kbase + qi) * 256 + 8 * hi;
#pragma unroll
            for (int s = 0; s < 4; ++s) { const f32x4 a = *(const f32x4*)(kp + 16 * s), c4 = *(const f32x4*)(kp + 16 * s + 4);
                u32x4 kf; kf.x = pk2(a[0], a[1]); kf.y = pk2(a[2], a[3]); kf.z = pk2(c4[0], c4[1]); kf.w = pk2(c4[2], c4[3]);
                acc = MFMA32(__builtin_bit_cast(bf16x8, kf), Qf[s], acc); }
        }
        float lb[16]; float gs[4];
#pragma unroll
        for (int r = 0; r < 16; ++r) {
            const int kl = (r & 3) + 8 * (r >> 2) + 4 * hi;
            const bool valid = first ? (SMP ? (kl < qi && kl < TS) : (kl < qi)) : true;
            acc[r] *= 0.125f;
            lb[r] = valid ? neg_softplus(acc[r]) : 0.f;
        }
#pragma unroll
        for (int g = 0; g < 4; ++g) gs[g] = (lb[4 * g] + lb[4 * g + 1]) + (lb[4 * g + 2] + lb[4 * g + 3]);
        float og[4];
#pragma unroll
        for (int g = 0; g < 4; ++g) og[g] = __shfl_xor(gs[g], 32);
        float off[4]; float run = 0.f;
#pragma unroll
        for (int g = 3; g >= 0; --g) {
            if (hi == 0) { run += og[g]; off[g] = run; run += gs[g]; }
            else { off[g] = run; run += gs[g] + og[g]; }
        }
        const float tot = (gs[0] + gs[1]) + (gs[2] + gs[3]) + (og[0] + og[1]) + (og[2] + og[3]);
        float p[16];
#pragma unroll
        for (int g = 0; g < 4; ++g) {
            float c = R + off[g];
#pragma unroll
            for (int e = 3; e >= 0; --e) {
                const int r = 4 * g + e; const int kl = (r & 3) + 8 * (r >> 2) + 4 * hi;
                const bool valid = first ? (SMP ? (kl < qi && kl < TS) : (kl < qi)) : true;
                p[r] = valid ? __builtin_amdgcn_exp2f((acc[r] + lb[r] + c) * 1.4426950408889634f) : 0.f;
                c += lb[r];
            }
        }
        R += tot;
#pragma unroll
        for (int s = 0; s < 2; ++s) {
            u32x4 pf; pf.x = pk2(p[8 * s], p[8 * s + 1]); pf.y = pk2(p[8 * s + 2], p[8 * s + 3]); pf.z = pk2(p[8 * s + 4], p[8 * s + 5]); pf.w = pk2(p[8 * s + 6], p[8 * s + 7]);
            const bf16x8 pb = __builtin_bit_cast(bf16x8, pf);
#pragma unroll
            for (int dt = 0; dt < 2; ++dt) {
                float vv[8];
#pragma unroll
                for (int j = 0; j < 8; ++j) {
                    const int kl = 16 * s + 8 * (j >> 2) + 4 * hi + (j & 3);
                    if (from_z) { int kr = kbase + kl; if (SMP && kr >= TS) kr = TS - 1;
                        vv[j] = bf2f(Z[(size_t)((SMP ? MP + TS * b : b * TP) + kr) * NZ + ZCV + h * 64 + 32 * dt + qi]); }
                    else vv[j] = cv[(size_t)(kbase + kl) * 256 + 32 * dt + qi];
                }
                const u32x4 vf = pk8(vv);
                if (dt == 0) o0 = MFMA32(__builtin_bit_cast(bf16x8, vf), pb, o0); else o1 = MFMA32(__builtin_bit_cast(bf16x8, vf), pb, o1);
            }
        }
        if (__all(R < -SB_CUT)) break;
    }
    float ss = 0.f;
#pragma unroll
    for (int r = 0; r < 16; ++r) ss += o0[r] * o0[r] + o1[r] * o1[r];
    ss += __shfl_xor(ss, 32);
    const float rs = rsqrtf(ss * (1.0f / 64.0f) + EPS);
    if (qvalid) {
        const float* g = A.in[I_SBG] + l * 256 + h * 64;
        bf16_t* yp = Y + (size_t)qrow * DM + 768 + h * 64;
#pragma unroll
        for (int dt = 0; dt < 2; ++dt)
#pragma unroll
            for (int g4 = 0; g4 < 4; ++g4) {
                const int d = 32 * dt + 8 * g4 + 4 * hi;
                const f32x4 gg = *(const f32x4*)(g + d);
                f32x4 v;
#pragma unroll
                for (int e = 0; e < 4; ++e) v[e] = (dt == 0 ? o0[4 * g4 + e] : o1[4 * g4 + e]) * rs * gg[e];
                *(u32x2*)(yp + d) = pk4(v);
            }
    }
}

DI void sc_task(const Args& A, int l, int task) {
    const int cgi = task & 31, seg = task >> 5, r0 = 16 * seg, c0 = 8 * cgi;
    const bf16_t* Z = (const bf16_t*)(A.ws + WS_Z); bf16_t* Y = (bf16_t*)(A.ws + WS_Y);
    const bool smp = r0 >= MP; const int t0 = smp ? 0 : (r0 & (TP - 1)), T = smp ? TS : TP, bb = smp ? (r0 - MP) / TS : r0 / TP;
    float w0[8], w1[8], w2[8], gn[8], p2[8], p1[8];
    const float* cw = A.in[I_SCW] + (size_t)l * 3 * 256 + c0;
#pragma unroll
    for (int j = 0; j < 8; ++j) { w0[j] = cw[j]; w1[j] = cw[256 + j]; w2[j] = cw[512 + j]; gn[j] = A.in[I_SCG][l * 256 + c0 + j]; }
    if (t0 == 0) {
        if (smp) { const float* cp = A.in[I_CSC] + (size_t)(l * BS + bb) * 2 * 256 + c0;
#pragma unroll
            for (int j = 0; j < 8; ++j) { p2[j] = cp[j]; p1[j] = cp[256 + j]; } }
        else {
#pragma unroll
            for (int j = 0; j < 8; ++j) { p2[j] = 0.f; p1[j] = 0.f; } }
    } else {
        float a[8], c[8];
        unpk8(*(const u32x4*)(Z + (size_t)(r0 - 2) * NZ + ZSC + c0), a); unpk8(*(const u32x4*)(Z + (size_t)(r0 - 2) * NZ + ZSX + c0), c);
#pragma unroll
        for (int j = 0; j < 8; ++j) p2[j] = a[j] * c[j];
        unpk8(*(const u32x4*)(Z + (size_t)(r0 - 1) * NZ + ZSC + c0), a); unpk8(*(const u32x4*)(Z + (size_t)(r0 - 1) * NZ + ZSX + c0), c);
#pragma unroll
        for (int j = 0; j < 8; ++j) p1[j] = a[j] * c[j];
    }
    for (int i = 0; i < 16; ++i) {
        const bf16_t* zr = Z + (size_t)(r0 + i) * NZ;
        float sb[8], sc[8], sx[8], y[8];
        unpk8(*(const u32x4*)(zr + ZSB + c0), sb); unpk8(*(const u32x4*)(zr + ZSC + c0), sc); unpk8(*(const u32x4*)(zr + ZSX + c0), sx);
        float ss = 0.f;
#pragma unroll
        for (int j = 0; j < 8; ++j) { const float xs = sc[j] * sx[j]; const float uu = w0[j] * p2[j] + w1[j] * p1[j] + w2[j] * xs; p2[j] = p1[j]; p1[j] = xs; y[j] = sb[j] * uu; ss += y[j] * y[j]; }
        ss += __shfl_xor(ss, 1); ss += __shfl_xor(ss, 2); ss += __shfl_xor(ss, 4);
        const float rs = rsqrtf(ss * (1.0f / 64.0f) + EPS);
#pragma unroll
        for (int j = 0; j < 8; ++j) y[j] *= rs * gn[j];
        *(u32x4*)(Y + (size_t)(r0 + i) * DM + 512 + c0) = pk8(y);
    }
    if (t0 + 16 == T) {
        float* dst = smp ? A.out + O_SSC + (size_t)(l * BS + bb) * 2 * 256 + c0 : A.out + O_PSC + (size_t)(l * BP + bb) * 2 * 256 + c0;
#pragma unroll
        for (int j = 0; j < 8; ++j) { dst[j] = p2[j]; dst[256 + j] = p1[j]; }
    }
}

constexpr int MA_K = 0, MA_VT = 69632;
DI void memattn_load_kv(const bf16_t* K, const bf16_t* VT, LAS unsigned char* lds, int tid) {
    LAS bf16_t* Ks = (LAS bf16_t*)(lds + MA_K); LAS bf16_t* Vs = (LAS bf16_t*)(lds + MA_VT);
#pragma unroll
    for (int i = 0; i < 8; ++i) { const int v = tid + 512 * i, n = v >> 4, d8 = v & 15; *(LAS u32x4*)(Ks + n * 136 + 8 * d8) = *(const u32x4*)(K + (size_t)n * 128 + 8 * d8); }
#pragma unroll
    for (int i = 0; i < 8; ++i) { const int v = tid + 512 * i, d = v >> 5, n8 = v & 31; *(LAS u32x4*)(Vs + d * 264 + 8 * n8) = *(const u32x4*)(VT + (size_t)d * 256 + 8 * n8); }
}
DI void memattn_wave(const bf16_t* QM, bf16_t* OM, int qrow, bool qvalid, int h, LAS unsigned char* lds, int lane) {
    const int ql = lane & 31, hi = lane >> 5;
    const LAS bf16_t* Ks = (const LAS bf16_t*)(lds + MA_K); const LAS bf16_t* Vs = (const LAS bf16_t*)(lds + MA_VT);
    bf16x8 Qf[8]; float ssq = 0.f;
#pragma unroll
    for (int s = 0; s < 8; ++s) { const u32x4 q = *(const u32x4*)(QM + (size_t)qrow * 512 + h * 128 + 16 * s + 8 * hi); Qf[s] = __builtin_bit_cast(bf16x8, q);
        float f[8]; unpk8(q, f);
#pragma unroll
        for (int j = 0; j < 8; ++j) ssq += f[j] * f[j]; }
    ssq += __shfl_xor(ssq, 32);
    const float sc2 = rsqrtf(ssq * (1.0f / 128.0f) + EPS) * 0.08838834764831845f * 1.4426950408889634f;
    float mx = -3.0e38f;
#pragma unroll 2
    for (int mt = 0; mt < 8; ++mt) {
        f32x16 s1;
#pragma unroll
        for (int r = 0; r < 16; ++r) s1[r] = 0.f;
#pragma unroll
        for (int s = 0; s < 8; ++s) s1 = MFMA32(*(const LAS bf16x8*)(Ks + (32 * mt + ql) * 136 + 16 * s + 8 * hi), Qf[s], s1);
#pragma unroll
        for (int r = 0; r < 16; ++r) mx = fmaxf(mx, s1[r]);
    }
    mx = fmaxf(mx, __shfl_xor(mx, 32));
    float sum = 0.f;
    f32x16 o[4];
#pragma unroll
    for (int dt = 0; dt < 4; ++dt)
#pragma unroll
        for (int r = 0; r < 16; ++r) o[dt][r] = 0.f;
#pragma unroll 1
    for (int mt = 0; mt < 8; ++mt) {
        f32x16 s1;
#pragma unroll
        for (int r = 0; r < 16; ++r) s1[r] = 0.f;
#pragma unroll
        for (int s = 0; s < 8; ++s) s1 = MFMA32(*(const LAS bf16x8*)(Ks + (32 * mt + ql) * 136 + 16 * s + 8 * hi), Qf[s], s1);
#pragma unroll
        for (int r = 0; r < 16; ++r) { s1[r] = __builtin_amdgcn_exp2f((s1[r] - mx) * sc2); sum += s1[r]; }
#pragma unroll
        for (int s = 0; s < 2; ++s) {
            u32x4 pf; pf.x = pk2(s1[8 * s], s1[8 * s + 1]); pf.y = pk2(s1[8 * s + 2], s1[8 * s + 3]); pf.z = pk2(s1[8 * s + 4], s1[8 * s + 5]); pf.w = pk2(s1[8 * s + 6], s1[8 * s + 7]);
            const bf16x8 pb = __builtin_bit_cast(bf16x8, pf);
#pragma unroll
            for (int dt = 0; dt < 4; ++dt) {
                const LAS bf16_t* vp = Vs + (32 * dt + ql) * 264 + 32 * mt + 16 * s + 4 * hi;
                u32x4 vf; const u32x2 a = *(const LAS u32x2*)vp, c = *(const LAS u32x2*)(vp + 8); vf.x = a.x; vf.y = a.y; vf.z = c.x; vf.w = c.y;
                o[dt] = MFMA32(__builtin_bit_cast(bf16x8, vf), pb, o[dt]);
            }
        }
    }
    sum += __shfl_xor(sum, 32);
    const float inv = 1.0f / sum;
    if (qvalid) {
        bf16_t* op = OM + (size_t)qrow * 512 + h * 128;
#pragma unroll
        for (int dt = 0; dt < 4; ++dt)
#pragma unroll
            for (int g4 = 0; g4 < 4; ++g4) {
                f32x4 v;
#pragma unroll
                for (int e = 0; e < 4; ++e) v[e] = o[dt][4 * g4 + e] * inv;
                *(u32x2*)(op + 32 * dt + 8 * g4 + 4 * hi) = pk4(v);
            }
    }
}
DI void phase_memattn(const Args& A, LAS unsigned char* lds, int l) {
    const int tid = otid(), lane = tid & 63, wave = tid >> 6, G = gridDim.x;
    const bf16_t* QM = (const bf16_t*)(A.ws + WS_QM); bf16_t* OM = (bf16_t*)(A.ws + WS_OM);
    for (int u = blockIdx.x; u < BS * 4; u += G) {
        const int sb = u >> 2, h = u & 3;
        __syncthreads();
        memattn_load_kv((const bf16_t*)(A.ws + WS_SMK) + (size_t)((l * BS + sb) * 4 + h) * 256 * 128, (const bf16_t*)(A.ws + WS_SMVT) + (size_t)((l * BS + sb) * 4 + h) * 128 * 256, lds, tid);
        __syncthreads();
        if (wave == 0) { const int ql = lane & 31; const bool ok = ql < TS; memattn_wave(QM, OM, MP + TS * sb + (ok ? ql : TS - 1), ok, h, lds, lane); }
    }
    const int NU = BP * 4 * 16, per = (NU + G - 1) / G;
    int cur = -1;
    for (int u = blockIdx.x * per; u < NU && u < (blockIdx.x + 1) * per; ++u) {
        const int qt = u & 15, bh = u >> 4, b = bh >> 2, h = bh & 3;
        if (bh != cur) {
            __syncthreads();
            memattn_load_kv((const bf16_t*)(A.ws + WS_MK) + (size_t)((l * BP + b) * 4 + h) * 256 * 128, (const bf16_t*)(A.ws + WS_MVT) + (size_t)((l * BP + b) * 4 + h) * 128 * 256, lds, tid);
            __syncthreads();
            cur = bh;
        }
        memattn_wave(QM, OM, b * TP + 256 * qt + 32 * wave + (lane & 31), true, h, lds, lane);
    }
    __syncthreads();
}

DI void act_task(const Args& A, int l, int task) {
    const int cgi = task % 352, seg = task / 352, r0 = 16 * seg, c0 = 8 * cgi;
    const bf16_t* GU = (const bf16_t*)(A.ws + WS_GU); bf16_t* ACT = (bf16_t*)(A.ws + WS_ACT);
    const bool smp = r0 >= MP; const int t0 = smp ? 0 : (r0 & (TP - 1)), T = smp ? TS : TP, bb = smp ? (r0 - MP) / TS : r0 / TP;
    float w0[8], w1[8], w2[8], p2[8], p1[8];
    const float* cw = A.in[I_FCW] + (size_t)l * 3 * DFF + c0;
#pragma unroll
    for (int j = 0; j < 8; ++j) { w0[j] = cw[j]; w1[j] = cw[DFF + j]; w2[j] = cw[2 * DFF + j]; }
    if (t0 == 0) {
        if (smp) { const float* cp = A.in[I_CFC] + (size_t)(l * BS + bb) * 2 * DFF + c0;
#pragma unroll
            for (int j = 0; j < 8; ++j) { p2[j] = cp[j]; p1[j] = cp[DFF + j]; } }
        else {
#pragma unroll
            for (int j = 0; j < 8; ++j) { p2[j] = 0.f; p1[j] = 0.f; } }
    } else { unpk8(*(const u32x4*)(GU + (size_t)(r0 - 2) * NGU + c0), p2); unpk8(*(const u32x4*)(GU + (size_t)(r0 - 1) * NGU + c0), p1); }
#pragma unroll 4
    for (int i = 0; i < 16; ++i) {
        const bf16_t* gr = GU + (size_t)(r0 + i) * NGU + c0;
        float g[8], up[8], y[8];
        unpk8(*(const u32x4*)gr, g); unpk8(*(const u32x4*)(gr + DFF), up);
#pragma unroll
        for (int j = 0; j < 8; ++j) { const float gt = w0[j] * p2[j] + w1[j] * p1[j] + w2[j] * g[j]; p2[j] = p1[j]; p1[j] = g[j]; y[j] = siluf_(gt) * up[j]; }
        *(u32x4*)(ACT + (size_t)(r0 + i) * DFF + c0) = pk8(y);
    }
    if (t0 + 16 == T) {
        float* dst = smp ? A.out + O_SFC + (size_t)(l * BS + bb) * 2 * DFF + c0 : A.out + O_PFC + (size_t)(l * BP + bb) * 2 * DFF + c0;
#pragma unroll
        for (int j = 0; j < 8; ++j) { dst[j] = p2[j]; dst[DFF + j] = p1[j]; }
    }
}
#ifndef MK_ONE_LAUNCH
#define MK_ONE_LAUNCH 1
#endif
constexpr int NPH = 3 + 9 * NL;
#ifndef PHMASK
#define PHMASK 0xFFFF
#endif
#define PHX(k) (((PHMASK) >> (k)) & 1)
#ifndef DUP_KIND
#define DUP_KIND -1
#endif
#define REPS(k) ((DUP_KIND == (k)) ? 2 : 1)
__global__ void __launch_bounds__(NTHR, 2) hse_fwd(Args A) {
    extern __shared__ __attribute__((aligned(16))) unsigned char smem[];
    LAS unsigned char* lds = (LAS unsigned char*)smem;
    volatile LAS unsigned* MISC = (volatile LAS unsigned*)(lds + MISC_OFF);
    const int tid0 = threadIdx.x, G = gridDim.x;
    for (int u = tid0; u < (LDS_BYTES - MISC_OFF) / 4; u += NTHR) ((LAS unsigned*)(lds + MISC_OFF))[u] = 0u;
    __syncthreads();
    unsigned* ctl = (unsigned*)(A.ws + WS_CTL);
    XcdBarrier bar; bar.bar = ctl + CW_BAR; bar.x = 0; bar.st = nullptr;
    const int lo = A.ph_lo, hi = A.ph_hi;
    if (hi - lo > 1) bar = xcd_barrier_post(ctl + CW_BAR, MISC + 8);
#define IN(k) (lo <= (k) && (k) < hi)
#define SEAM(k) do { if (IN(k) && IN((k) + 1)) xcd_barrier(bar); } while (0)
    unsigned char* ws = A.ws;
    bf16_t* XB = (bf16_t*)(ws + WS_XB); u64_t* SSQ0 = (u64_t*)(ws + WS_SSQ);

    if (PHX(0) && IN(0)) { for (int rep = 0; rep < REPS(0); ++rep) { phase_convert(A, lds); __syncthreads(); } }
    SEAM(0);
    if (PHX(1) && IN(1)) { for (int rep = 0; rep < REPS(1); ++rep) {
        pg8::Gemm g{(const bf16_t*)(ws + WS_MEMB), (const bf16_t*)(ws + WS_WMKV), 4096, 4096, DM}; pg8::StaticOrder S; S.init(4096, 4096, ogrid(), obid());
        EpiScaleF32 E{(float*)(ws + WS_RAWKV), 4096, (const float*)(ws + WS_SSQM)};
        pg8::gemm_phase<EpiScaleF32, pg8::StaticOrder, true, true>(lds, g, S, E);
        __syncthreads(); } }
    SEAM(1);
    if (PHX(2) && IN(2)) { for (int rep = 0; rep < REPS(2); ++rep) { phase_memkv_post(A, lds); __syncthreads(); } }
    SEAM(2);

    for (int l = 0; l < NL; ++l) {
        const int pb = 3 + 9 * l;
        u64_t* SSQ = SSQ0 + (size_t)(3 * l) * MALL;
        if (PHX(3) && IN(pb + 0)) { for (int rep = 0; rep < REPS(3); ++rep) {
            pg8::Gemm g{XB, (const bf16_t*)(ws + WS_WIN + l * SZ_WIN), MALL, NZ, DM}; pg8::StaticOrder S; S.init(MALL, NZ, ogrid(), obid());
            EpiScaleBf16 E{(bf16_t*)(ws + WS_Z), NZ, SSQ, 12, 13, A.out + O_PSK + (size_t)l * MP * 256, A.out + O_SSK + (size_t)l * MS * 256, A.out + O_PSV + (size_t)l * MP * 256, A.out + O_SSV + (size_t)l * MS * 256};
            pg8::gemm_phase<EpiScaleBf16, pg8::StaticOrder, true, true>(lds, g, S, E);
            __syncthreads(); } }
        SEAM(pb + 0);
        if (PHX(4) && IN(pb + 1)) { for (int rep = 0; rep < REPS(4); ++rep) {
            unsigned* cnt = ctl + 2048 + 64 * l;
            for (;;) {
                if (threadIdx.x == 0) MISC[12] = atomicAdd(cnt, 1u);
                __syncthreads();
                const int u = (int)MISC[12];
                __syncthreads();
                if (u >= 1024) break;
                prep_unit(A, lds, l, u);
            }
            __syncthreads(); } }
        SEAM(pb + 1);
        if (PHX(5) && IN(pb + 2)) { for (int rep = 0; rep < REPS(5); ++rep) {
            for (int r2 = 0; r2 < REPS(14); ++r2) for (int it = blockIdx.x; it < 64 + BS; it += G) {
                if (it < 64) scan_item(A, lds, l, it);
                else { prep_unit(A, lds, l, 1024 + (it - 64)); __threadfence_block(); VM_WAIT(); __syncthreads();
                       for (int hh = 0; hh < 4; ++hh) scan_item(A, lds, l, 64 + 4 * (it - 64) + hh); }
            }
            const int nhead = G > 192 ? 128 : (G > 128 ? 64 : 0);
            if ((int)blockIdx.x >= nhead) {
                const int tid = otid(), lane = tid & 63, wave = __builtin_amdgcn_readfirstlane(tid >> 6);
                const int wb = blockIdx.x - nhead, NWB = G - nhead;
                for (int r2 = 0; r2 < REPS(13); ++r2) {
                for (int i = wb * NWAVES + wave; i < BS * 4; i += NWB * NWAVES) sb_wave_unit<true>(A, l, i, lane);
                for (int i = wb * NWAVES + wave; i < BP * 128 * 4; i += NWB * NWAVES) sb_wave_unit<false>(A, l, i, lane);
                for (int t = wb * NTHR + tid; t < (MALL / 16) * 32; t += NWB * NTHR) sc_task(A, l, t);
                }
            }
            __syncthreads(); } }
        SEAM(pb + 2);
        if (PHX(6) && IN(pb + 3)) { for (int rep = 0; rep < REPS(6); ++rep) {
            pg8::Gemm g{(const bf16_t*)(ws + WS_Y), (const bf16_t*)(ws + WS_WMIX + l * SZ_WMIX), MALL, DM, DM}; pg8::StaticOrder S; S.init(MALL, DM, ogrid(), obid());
            EpiResid E{A.out, XB, SSQ + MALL, 0};
            pg8::gemm_phase<EpiResid, pg8::StaticOrder, true, true>(lds, g, S, E);
            __syncthreads(); } }
        SEAM(pb + 3);
        if (PHX(7) && IN(pb + 4)) { for (int rep = 0; rep < REPS(7); ++rep) {
            pg8::Gemm g{XB, (const bf16_t*)(ws + WS_WMQ + l * SZ_WMQ), MALL, 512, DM}; pg8::StaticOrder S; S.init(MALL, 512, ogrid(), obid());
            EpiScaleBf16 E{(bf16_t*)(ws + WS_QM), 512, SSQ + MALL, -1, -1, nullptr, nullptr, nullptr, nullptr};
            pg8::gemm_phase<EpiScaleBf16, pg8::StaticOrder, true, true>(lds, g, S, E);
            __syncthreads(); } }
        SEAM(pb + 4);
        if (PHX(8) && IN(pb + 5)) { for (int rep = 0; rep < REPS(8); ++rep) { phase_memattn(A, lds, l); __syncthreads(); } }
        SEAM(pb + 5);
        if (PHX(9) && IN(pb + 6)) { for (int rep = 0; rep < REPS(9); ++rep) {
            pg8::Gemm g{(const bf16_t*)(ws + WS_OM), (const bf16_t*)(ws + WS_WMO + l * SZ_WMO), MALL, DM, 512}; pg8::StaticOrder S; S.init(MALL, DM, ogrid(), obid());
            EpiResid E{A.out, XB, SSQ + 2 * MALL, 0};
            pg8::gemm_phase<EpiResid, pg8::StaticOrder, true, true>(lds, g, S, E);
            __syncthreads(); } }
        SEAM(pb + 6);
        if (PHX(10) && IN(pb + 7)) {
            pg8::Gemm g{XB, (const bf16_t*)(ws + WS_WGU + l * SZ_WGU), MALL, NGU, DM}; pg8::StaticOrder S; S.init_tiles((MALL + 247) / 248, NGU / 256, ogrid(), obid());
            EpiAct E{(bf16_t*)(ws + WS_ACT), SSQ + 2 * MALL, A.in[I_FCW] + (size_t)l * 3 * DFF, A.in[I_CFC] + (size_t)l * BS * 2 * DFF, A.out + O_PFC + (size_t)l * BP * 2 * DFF, A.out + O_SFC + (size_t)l * BS * 2 * DFF};
            pg8::gemm_phase<EpiAct, pg8::StaticOrder, true, true>(lds, g, S, E);
        }
        SEAM(pb + 7);
        if (PHX(12) && IN(pb + 8)) { for (int rep = 0; rep < REPS(12); ++rep) {
            pg8::Gemm g{(const bf16_t*)(ws + WS_ACT), (const bf16_t*)(ws + WS_WDN + l * SZ_WDN), MALL, DM, DFF}; pg8::StaticOrder S; S.init(MALL, DM, ogrid(), obid());
            EpiResid E{A.out, XB, SSQ + 3 * (size_t)MALL, l == NL - 1 ? 1 : 0};
            pg8::gemm_phase<EpiResid, pg8::StaticOrder, true, true>(lds, g, S, E);
            __syncthreads(); } }
        if (l + 1 < NL) SEAM(pb + 8);
    }
#undef IN
#undef SEAM
}

extern "C" void kernel_launch(void* const* d_in, const int* in_sizes, int n_in, void* d_out, int out_size, void* d_ws, size_t ws_size, hipStream_t stream) {
    static int grid = 0;
    if (grid == 0) {
        if (n_in != 34 || (size_t)out_size != O_END || ws_size < WS_END) { fprintf(stderr, "kernel_launch: unexpected problem (n_in %d, out %d, ws %zu; need 34, %zu, >= %zu); nothing launched\n", n_in, out_size, ws_size, (size_t)O_END, (size_t)WS_END); grid = -1; return; }
        int dev = 0, cus = 0, per_cu = 0;
        if (hipGetDevice(&dev) != hipSuccess || hipDeviceGetAttribute(&cus, hipDeviceAttributeMultiprocessorCount, dev) != hipSuccess) { grid = -1; return; }
        if (hipFuncSetAttribute((const void*)hse_fwd, hipFuncAttributeMaxDynamicSharedMemorySize, LDS_BYTES) != hipSuccess) { fprintf(stderr, "kernel_launch: hipFuncSetAttribute failed\n"); grid = -1; return; }
        if (hipOccupancyMaxActiveBlocksPerMultiprocessor(&per_cu, (const void*)hse_fwd, NTHR, LDS_BYTES) != hipSuccess || per_cu < 1) { fprintf(stderr, "kernel_launch: occupancy query reports %d blocks per CU\n", per_cu); }
        (void)hipGetLastError();
        grid = cus;
    }
    if (grid < 0) return;
    (void)hipMemsetAsync((char*)d_ws + WS_CTL, 0, CTL_BYTES, stream);
    (void)hipMemsetAsync((char*)d_ws + WS_SSQ, 0, (size_t)(3 * NL + 1) * MALL * 8, stream);
    Args a{};
    for (int i = 0; i < 34; ++i) a.in[i] = (const float*)d_in[i];
    a.out = (float*)d_out; a.ws = (unsigned char*)d_ws;
#if MK_ONE_LAUNCH
    a.ph_lo = 0; a.ph_hi = NPH;
    hipLaunchKernelGGL(hse_fwd, dim3(grid), dim3(NTHR), LDS_BYTES, stream, a);
#else
    for (int p = 0; p < NPH; ++p) { a.ph_lo = p; a.ph_hi = p + 1; hipLaunchKernelGGL(hse_fwd, dim3(grid), dim3(NTHR), LDS_BYTES, stream, a); }
#endif
    const hipError_t le = hipPeekAtLastError();
    if (le != hipSuccess) fprintf(stderr, "kernel_launch: launch failed: %s\n", hipGetErrorName(le));
}
```
